# Optimizing an MI355X kernel written in HIP

```python
import math
import jax, jax.numpy as jnp
from jax import lax
import numpy as np

D_MODEL = 1024
BATCH = 32
SEQ = 2048
DEPTH = 1

N_META = 16
N_HEADS = 8
HEAD_DIM = 64
V_HEAD_DIM = 2 * HEAD_DIM
ATTN_WIDTH = N_HEADS * V_HEAD_DIM
Q_COLS = 2 * N_HEADS * HEAD_DIM
K_COLS = 2 * N_HEADS * HEAD_DIM
V_COLS = ATTN_WIDTH
CONV_WIDTH = D_MODEL
CONV_K = 3
GATE_COLS = 2 * D_MODEL
IN_COLS = Q_COLS + K_COLS + V_COLS + 3 * CONV_WIDTH + GATE_COLS
D_FF = ((8 * D_MODEL // 3 + 255) // 256) * 256
ROPE_THETA = 10000.0
NORM_EPS = 1e-5
Q_BLOCK = 128

kernel_name = "hybrid_diffattn_shortconv_gated_block"


def _rmsnorm(x, w):
    xf = x.astype(jnp.float32)
    y = xf * lax.rsqrt(jnp.mean(xf * xf, axis=-1, keepdims=True) + NORM_EPS)
    return (y * w.astype(jnp.float32)).astype(x.dtype)


def _rope_tables(T, dim):
    inv_freq = 1.0 / (ROPE_THETA ** (jnp.arange(0, dim, 2, dtype=jnp.float32) / dim))
    ang = jnp.arange(T, dtype=jnp.float32)[:, None] * inv_freq[None, :]
    ang = jnp.concatenate([ang, ang], axis=-1)
    return jnp.cos(ang), jnp.sin(ang)


def _apply_rope(x, cos, sin):
    half = x.shape[-1] // 2
    rot = jnp.concatenate([-x[..., half:], x[..., :half]], axis=-1)
    c = cos[None, :, None, None, :].astype(x.dtype)
    s = sin[None, :, None, None, :].astype(x.dtype)
    return x * c + rot * s


def _diff_attention(q, k, v, lam):
    T = q.shape[1]
    q = q * (HEAD_DIM ** -0.5)
    outs = []
    for start in range(0, T, Q_BLOCK):
        end = min(start + Q_BLOCK, T)
        qb = q[:, start:end]
        kb = k[:, :end]
        s = jnp.einsum('bqhmd,bkhmd->bhmqk', qb, kb).astype(jnp.float32)
        mask = jnp.arange(start, end)[:, None] >= jnp.arange(end)[None, :]
        s = jnp.where(mask[None, None, None], s, -jnp.inf)
        p = jax.nn.softmax(s, axis=-1)
        a = p[:, :, 0] - lam.astype(jnp.float32) * p[:, :, 1]
        outs.append(jnp.einsum('bhqk,bkhe->bqhe', a.astype(v.dtype), v[:, :end]))
    return jnp.concatenate(outs, axis=1)


def _causal_depthwise_conv(u, w):
    T = u.shape[1]
    up = jnp.pad(u, ((0, 0), (CONV_K - 1, 0), (0, 0)))
    return sum(up[:, j:j + T] * w[j].astype(u.dtype) for j in range(CONV_K))


def setup_inputs(seed: int = 0) -> dict:
    key = jax.random.key(seed)
    ks = jax.random.split(key, 17)
    f32 = jnp.float32
    nrm = lambda k, shape, scale: (jax.random.normal(k, shape, f32) * scale)
    return {
        "x": nrm(ks[0], (BATCH, SEQ, D_MODEL), 1.0),
        "meta_tokens": nrm(ks[1], (N_META, D_MODEL), 1.0),
        "norm_mix_w": 1.0 + nrm(ks[2], (DEPTH, D_MODEL), 0.02),
        "w_in": nrm(ks[3], (DEPTH, D_MODEL, IN_COLS), D_MODEL ** -0.5),
        "lambda_q1": nrm(ks[4], (DEPTH, HEAD_DIM), 0.1),
        "lambda_k1": nrm(ks[5], (DEPTH, HEAD_DIM), 0.1),
        "lambda_q2": nrm(ks[6], (DEPTH, HEAD_DIM), 0.1),
        "lambda_k2": nrm(ks[7], (DEPTH, HEAD_DIM), 0.1),
        "subln_w": 1.0 + nrm(ks[8], (DEPTH, V_HEAD_DIM), 0.02),
        "conv_w": nrm(ks[9], (DEPTH, CONV_K, CONV_WIDTH), CONV_K ** -0.5),
        "w_proj_attn": nrm(ks[10], (DEPTH, ATTN_WIDTH, D_MODEL), ATTN_WIDTH ** -0.5),
        "w_proj_conv": nrm(ks[11], (DEPTH, CONV_WIDTH, D_MODEL), CONV_WIDTH ** -0.5),
        "w_out": nrm(ks[12], (DEPTH, D_MODEL, D_MODEL), D_MODEL ** -0.5),
        "norm_ffn_w": 1.0 + nrm(ks[13], (DEPTH, D_MODEL), 0.02),
        "w_gate_up": nrm(ks[14], (DEPTH, D_MODEL, 2 * D_FF), D_MODEL ** -0.5),
        "w_down": nrm(ks[15], (DEPTH, D_FF, D_MODEL), D_FF ** -0.5),
        "norm_final_w": 1.0 + nrm(ks[16], (D_MODEL,), 0.02),
    }


def reference(x, meta_tokens, norm_mix_w, w_in, lambda_q1, lambda_k1, lambda_q2, lambda_k2,
              subln_w, conv_w, w_proj_attn, w_proj_conv, w_out, norm_ffn_w, w_gate_up,
              w_down, norm_final_w):
    B = x.shape[0]
    meta = jnp.broadcast_to(meta_tokens.astype(x.dtype)[None], (B, N_META, D_MODEL))
    h = jnp.concatenate([meta, x], axis=1)
    T = h.shape[1]
    cos, sin = _rope_tables(T, HEAD_DIM)
    split_at = np.cumsum([Q_COLS, K_COLS, V_COLS, CONV_WIDTH, CONV_WIDTH, CONV_WIDTH, D_MODEL])

    for l in range(DEPTH):
        lambda_init = 0.8 - 0.6 * math.exp(-0.3 * l)
        hn = _rmsnorm(h, norm_mix_w[l])
        proj = jnp.einsum('btd,dc->btc', hn, w_in[l])
        q, k, v, cb, cc, cx, ga, gb = jnp.split(proj, split_at, axis=-1)

        q = _apply_rope(q.reshape(B, T, N_HEADS, 2, HEAD_DIM), cos, sin)
        k = _apply_rope(k.reshape(B, T, N_HEADS, 2, HEAD_DIM), cos, sin)
        v = v.reshape(B, T, N_HEADS, V_HEAD_DIM)
        lam = (jnp.exp(jnp.sum(lambda_q1[l] * lambda_k1[l]))
               - jnp.exp(jnp.sum(lambda_q2[l] * lambda_k2[l])) + lambda_init)
        oa = _diff_attention(q, k, v, lam)
        oa = _rmsnorm(oa, subln_w[l]) * (1.0 - lambda_init)
        ya = jnp.einsum('btc,cd->btd', oa.reshape(B, T, ATTN_WIDTH), w_proj_attn[l])

        ob = cb * _causal_depthwise_conv(cc * cx, conv_w[l])
        yb = jnp.einsum('btc,cd->btd', ob, w_proj_conv[l])

        merged = jax.nn.sigmoid(ga) * ya + jax.nn.sigmoid(gb) * yb
        h = h + jnp.einsum('btd,de->bte', merged, w_out[l])

        hn = _rmsnorm(h, norm_ffn_w[l])
        g, u = jnp.split(jnp.einsum('btd,df->btf', hn, w_gate_up[l]), 2, axis=-1)
        h = h + jnp.einsum('btf,fd->btd', jax.nn.silu(g) * u, w_down[l])

    return _rmsnorm(h[:, N_META:], norm_final_w)
```

```cpp
#include <hip/hip_runtime.h>
#include <hip/hip_cooperative_groups.h>
#include <hip/hip_bf16.h>
#include <cstdio>
#include <cstdint>
#include <cmath>
namespace pg8 {
#define PG8_LAS __attribute__((address_space(3)))
typedef unsigned short bf16_t;
typedef short bf16x8 __attribute__((ext_vector_type(8)));
typedef float f32x4 __attribute__((ext_vector_type(4)));
typedef unsigned u32x4 __attribute__((ext_vector_type(4)));
constexpr int BM = 256, BK = 64, HALF = 128, HTB = HALF * BK * 2  , STAGE_BYTES = 8 * HTB, NXCD = 8, WGM = 8;

__host__ __device__ __forceinline__ int lds_byte(int r, int c) { const int st = (r >> 4) * 2 + (c >> 5), rr = r & 15, cc = c & 31, ob = rr * 64 + cc * 2; return st * 1024 + (ob ^ (((ob >> 9) & 1) << 5)); }
__host__ __device__ __forceinline__ void stage_rc(int b, int& R, int& C) { const int st = b / 1024, sb = b % 1024, swz = sb ^ (((sb >> 9) & 1) << 5); R = (st >> 1) * 16 + swz / 64; C = (st & 1) * 32 + (swz % 64) / 2; }
__host__ __device__ __forceinline__ int perm32(int rho) { const int n = rho >> 4, i = rho & 15; return 8 * (i >> 2) + 4 * n + (i & 3); }

struct Unit { int pm, pn; };
struct Gemm { const bf16_t* A; const bf16_t* A2; const bf16_t* Bt; int lda, K, ks; };

struct StaticOrder {
    int nM, nN, nwg, G, c;
    __host__ __device__ void init(int M, int N, int G_, int c_) { nM = M / BM; nN = N / BM; nwg = nM * nN; G = G_; c = c_; }
    __host__ __device__ bool next(int i, Unit& u) const {
        const long L = (long)i * G + c; if (L >= nwg) return false;
        int wgid = (int)L; { const int q = nwg / NXCD, r = nwg % NXCD, xcd = wgid % NXCD, off = wgid / NXCD; wgid = (xcd < r ? xcd * (q + 1) : r * (q + 1) + (xcd - r) * q) + off; }
        const int nig = WGM * nN, gid = wgid / nig, fm = gid * WGM, gsz = (nM - fm) < WGM ? (nM - fm) : WGM;
        u.pm = fm + ((wgid % nig) % gsz); u.pn = (wgid % nig) / gsz; return true;
    }
    __device__ __forceinline__ void a_ready(const Unit&) const {}
    __device__ __forceinline__ void done(const Unit&) const {}
};

typedef float cvt_f32x2_t __attribute__((ext_vector_type(2))); typedef __bf16 cvt_bf16x2_t __attribute__((ext_vector_type(2)));
__device__ __forceinline__ unsigned cvt_pk_bf16(float lo, float hi) { const cvt_f32x2_t v = {lo, hi}; const cvt_bf16x2_t b = __builtin_convertvector(v, cvt_bf16x2_t); return __builtin_bit_cast(unsigned, b); }
template <class Epi, class Sched, bool ALIGN_EPI = false, bool SP2 = false>
__device__ __forceinline__ void gemm_phase(PG8_LAS unsigned char* lds, const Gemm g, const Sched& S, const Epi& E) {
    int tid_ = threadIdx.x; asm volatile("" : "+v"(tid_));
    const int tid = tid_, wid = __builtin_amdgcn_readfirstlane(tid >> 6), lane = tid & 63, wr = wid >> 2, wc = wid & 3, fr = lane & 15, fq = lane >> 4;
    const int K = g.K, nt = K / BK, ks = g.ks, lda = g.lda;
    unsigned voffA[2], voffB[2];
#pragma unroll
    for (int i = 0; i < 2; ++i) { int R, C; stage_rc(tid * 16 + i * 8192, R, C); const int Rb = Epi::PERM ? ((R & ~31) + perm32(R & 31)) : R;
        voffA[i] = (unsigned)(R * lda + C) * 2u; voffB[i] = (unsigned)(Rb * K + C) * 2u; }
    const size_t kstep = (size_t)(BK * 2);
    const size_t hstepA = (size_t)HALF * lda * 2, hstepB = (size_t)HALF * K * 2;
    const size_t tstepA = 2 * hstepA, tstepB = 2 * hstepB;
    const unsigned ldsw = (unsigned)wid * 1024u;
    const int aoff = lds_byte(wr * 64 + fr, fq * 8), boff = lds_byte(wc * 32 + fr, fq * 8);
#define PG8_SA(b, h) (((b) * 2 + (h)) * HTB)
#define PG8_SB(b, h) ((4 + (b) * 2 + (h)) * HTB)
#define PG8_STAGE(bufoff, gbase, voff) do { _Pragma("unroll") for (int _i = 0; _i < 2; ++_i) \
        __builtin_amdgcn_global_load_lds((const unsigned*)((const char*)(gbase) + (voff)[_i]), (PG8_LAS unsigned*)(lds + (bufoff) + ldsw + _i * 8192), 16, 0, 0); } while (0)
#define PG8_LDA(dst, b, h) do { _Pragma("unroll") for (int m = 0; m < 4; ++m) _Pragma("unroll") for (int k = 0; k < 2; ++k) dst[m][k] = *(const PG8_LAS bf16x8*)(lds + PG8_SA(b, h) + aoff + m * 2048 + k * 1024); } while (0)
#define PG8_LDB(dst, b, h) do { _Pragma("unroll") for (int n = 0; n < 2; ++n) _Pragma("unroll") for (int k = 0; k < 2; ++k) dst[n][k] = *(const PG8_LAS bf16x8*)(lds + PG8_SB(b, h) + boff + n * 2048 + k * 1024); } while (0)
#define PG8_MMA(ai, bj, At, Bt) do { __builtin_amdgcn_s_setprio(1); _Pragma("unroll") for (int m = 0; m < 4; ++m) _Pragma("unroll") for (int n = 0; n < 2; ++n) _Pragma("unroll") for (int k = 0; k < 2; ++k) \
        acc[ai][bj][m][n] = __builtin_amdgcn_mfma_f32_16x16x32_bf16(Bt[n][k], At[m][k], acc[ai][bj][m][n], 0, 0, 0); __builtin_amdgcn_s_setprio(0); } while (0)
#define PG8_WAIT_V(n) asm volatile("s_waitcnt vmcnt(" #n ")" ::: "memory")
#define PG8_WAIT_L(n) asm volatile("s_waitcnt lgkmcnt(" #n ")" ::: "memory")
#define PG8_BAR __builtin_amdgcn_s_barrier()
#define PG8_SCHED __builtin_amdgcn_sched_barrier(0)
    Unit cur, nxt; int ui = 0;
    if (!S.next(0, cur)) return;
    f32x4 acc[2][2][4][2];
#pragma unroll
    for (int a = 0; a < 2; ++a)
#pragma unroll
        for (int b = 0; b < 2; ++b)
#pragma unroll
            for (int m = 0; m < 4; ++m)
#pragma unroll
                for (int n = 0; n < 2; ++n) acc[a][b][m][n] = (f32x4){0.f, 0.f, 0.f, 0.f};
    bf16x8 At[4][2], B0[2][2], B1[2][2];
    const char* cA = (const char*)g.A + (size_t)cur.pm * tstepA; const char* cA2 = (const char*)g.A2 + (size_t)cur.pm * tstepA; const char* cB = (const char*)g.Bt + (size_t)cur.pn * tstepB;
    S.a_ready(cur);
    if constexpr (SP2) {
        PG8_STAGE(PG8_SB(0, 0), cB, voffB); PG8_STAGE(PG8_SB(0, 1), cB + hstepB, voffB); PG8_STAGE(PG8_SA(0, 0), cA, voffA); PG8_STAGE(PG8_SA(0, 1), cA + hstepA, voffA);
        if (wr == 1) PG8_BAR;
        PG8_WAIT_V(2); PG8_BAR;
        PG8_STAGE(PG8_SB(1, 0), cB + kstep, voffB); PG8_STAGE(PG8_SA(1, 0), cA + kstep, voffA); PG8_STAGE(PG8_SB(1, 1), cB + hstepB + kstep, voffB);
        PG8_WAIT_V(6); PG8_BAR;
    } else {
        PG8_STAGE(PG8_SB(0, 0), cB, voffB); PG8_STAGE(PG8_SA(0, 0), cA, voffA); PG8_STAGE(PG8_SB(0, 1), cB + hstepB, voffB); PG8_STAGE(PG8_SA(0, 1), cA + hstepA, voffA);
        if (wr == 1) PG8_BAR;
        PG8_WAIT_V(4); PG8_BAR;
        PG8_STAGE(PG8_SB(1, 0), cB + kstep, voffB); PG8_STAGE(PG8_SA(1, 0), cA + kstep, voffA); PG8_STAGE(PG8_SB(1, 1), cB + hstepB + kstep, voffB);
        PG8_WAIT_V(6); PG8_BAR;
    }
    for (;;) {
        const bool has_next = S.next(ui + 1, nxt);
        const char* nA = has_next ? (const char*)g.A + (size_t)nxt.pm * tstepA : cA; const char* nA2 = has_next ? (const char*)g.A2 + (size_t)nxt.pm * tstepA : cA2; const char* nB = has_next ? (const char*)g.Bt + (size_t)nxt.pn * tstepB : cB;
        for (int t = 0; t < nt; t += 2) {
            const bool last = (t == nt - 2);
#define PG8_ATILE(tt) ((tt) < ks ? cA + (size_t)(tt) * kstep : cA2 + (size_t)((tt) - ks) * kstep)
            if constexpr (Epi::MID) { if (t == ks) E.mid(acc, cur, wr, wc, fr, fq); }
            const char* a1 = PG8_ATILE(t + 1);
            const char* a2 = last ? nA : PG8_ATILE(t + 2); const char* b2 = last ? nB : cB + (size_t)(t + 2) * kstep;
            const char* a3 = last ? nA + kstep : PG8_ATILE(t + 3); const char* b3 = b2 + kstep;
            if (last && has_next) S.a_ready(nxt);
            if constexpr (SP2) {
            PG8_LDB(B0, 0, 0); PG8_LDB(B1, 0, 1); PG8_SCHED; PG8_LDA(At, 0, 0); PG8_STAGE(PG8_SA(1, 1), a1 + hstepA, voffA);
            PG8_WAIT_V(8); PG8_WAIT_L(0); PG8_BAR; PG8_MMA(0, 0, At, B0); PG8_MMA(0, 1, At, B1); PG8_BAR; PG8_SCHED;
            PG8_LDA(At, 0, 1); PG8_STAGE(PG8_SB(0, 0), b2, voffB); PG8_STAGE(PG8_SB(0, 1), b2 + hstepB, voffB); PG8_STAGE(PG8_SA(0, 0), a2, voffA);
            PG8_WAIT_V(8); PG8_WAIT_L(0); PG8_BAR; PG8_MMA(1, 0, At, B0); PG8_MMA(1, 1, At, B1); PG8_BAR; PG8_SCHED;
            PG8_LDB(B0, 1, 0); PG8_LDB(B1, 1, 1); PG8_SCHED; PG8_LDA(At, 1, 0); PG8_STAGE(PG8_SA(0, 1), a2 + hstepA, voffA);
            PG8_WAIT_V(8); PG8_WAIT_L(0); PG8_BAR; PG8_MMA(0, 0, At, B0); PG8_MMA(0, 1, At, B1); PG8_BAR; PG8_SCHED;
            PG8_LDA(At, 1, 1); PG8_STAGE(PG8_SB(1, 0), b3, voffB); PG8_STAGE(PG8_SB(1, 1), b3 + hstepB, voffB); PG8_STAGE(PG8_SA(1, 0), a3, voffA);
            PG8_WAIT_V(8); PG8_WAIT_L(0); PG8_BAR; PG8_MMA(1, 0, At, B0); PG8_MMA(1, 1, At, B1); PG8_BAR; PG8_SCHED;
            } else {
            PG8_LDB(B0, 0, 0); PG8_SCHED; PG8_LDA(At, 0, 0); PG8_STAGE(PG8_SA(1, 1), a1 + hstepA, voffA);
            PG8_WAIT_L(8); PG8_BAR; PG8_WAIT_L(0); PG8_MMA(0, 0, At, B0); PG8_BAR; PG8_SCHED;
            PG8_LDB(B1, 0, 1); PG8_STAGE(PG8_SB(0, 0), b2, voffB);
            PG8_BAR; PG8_WAIT_L(0); PG8_MMA(0, 1, At, B1); PG8_BAR;
            PG8_LDA(At, 0, 1); PG8_STAGE(PG8_SA(0, 0), a2, voffA);
            PG8_BAR; PG8_WAIT_L(0); PG8_MMA(1, 0, At, B0); PG8_BAR; PG8_SCHED;
            PG8_STAGE(PG8_SB(0, 1), b2 + hstepB, voffB);
            PG8_WAIT_V(6); PG8_BAR; PG8_MMA(1, 1, At, B1); PG8_BAR;
            PG8_LDB(B0, 1, 0); PG8_SCHED; PG8_LDA(At, 1, 0); PG8_STAGE(PG8_SA(0, 1), a2 + hstepA, voffA);
            PG8_WAIT_L(8); PG8_BAR; PG8_WAIT_L(0); PG8_MMA(0, 0, At, B0); PG8_BAR; PG8_SCHED;
            PG8_LDB(B1, 1, 1); PG8_STAGE(PG8_SB(1, 0), b3, voffB);
            PG8_BAR; PG8_WAIT_L(0); PG8_MMA(0, 1, At, B1); PG8_BAR;
            PG8_LDA(At, 1, 1); PG8_STAGE(PG8_SA(1, 0), a3, voffA);
            PG8_BAR; PG8_WAIT_L(0); PG8_MMA(1, 0, At, B0); PG8_BAR; PG8_SCHED;
            PG8_STAGE(PG8_SB(1, 1), b3 + hstepB, voffB);
            PG8_WAIT_V(6); PG8_BAR; PG8_MMA(1, 1, At, B1); PG8_BAR;
            }
        }
        if constexpr (ALIGN_EPI) { if (wr == 0) PG8_BAR; }
        if constexpr (!Epi::AFTER_DRAIN) { E(acc, cur, wr, wc, fr, fq); S.done(cur); }
        if (!has_next) break;
#pragma unroll
        for (int a = 0; a < 2; ++a)
#pragma unroll
            for (int b = 0; b < 2; ++b)
#pragma unroll
                for (int m = 0; m < 4; ++m)
#pragma unroll
                    for (int n = 0; n < 2; ++n) acc[a][b][m][n] = (f32x4){0.f, 0.f, 0.f, 0.f};
        cur = nxt; cA = nA; cA2 = nA2; cB = nB; ++ui;
        if constexpr (ALIGN_EPI) { if (wr == 1) PG8_BAR; }
    }
    PG8_WAIT_V(0);
    if constexpr (!ALIGN_EPI) { if (wr == 0) PG8_BAR; }
    PG8_BAR;
    if constexpr (Epi::AFTER_DRAIN) { E.fused(acc, cur, wr, wc, fr, fq, lds, wid, lane); S.done(cur); }
#undef PG8_SA
#undef PG8_ATILE
#undef PG8_SB
#undef PG8_STAGE
#undef PG8_LDA
#undef PG8_LDB
#undef PG8_MMA
#undef PG8_WAIT_V
#undef PG8_WAIT_L
#undef PG8_BAR
#undef PG8_SCHED
}
}

namespace attn_body {
using bf16=__hip_bfloat16;
using bf16x8=__attribute__((ext_vector_type(8)))short;
using s16x4=__attribute__((ext_vector_type(4)))short;
using f32x16=__attribute__((ext_vector_type(16)))float;
using u32x4=__attribute__((ext_vector_type(4)))unsigned;
constexpr int D=64,DM=1024;
constexpr int NW=8,QBLK=32,QB=QBLK*NW,KVBLK=64;
constexpr int ATTN_PITCH=DM, ATTN_UNIT_ROWS=QB;
__device__ __forceinline__ int crow(int r,int hi){return (r&3)+8*(r>>2)+4*hi;}
#define SBAR() __builtin_amdgcn_sched_barrier(0)
__device__ __forceinline__ void cmask(f32x16&p0,f32x16&p1,int jb,int qrel,int hi){
  const float NEG=-INFINITY; int kb=64*jb+4*hi;
  #pragma unroll
  for(int r=0;r<16;++r){int kv=kb+(r&3)+8*(r>>2); if(kv>qrel)p0[r]=NEG; if(kv+32>qrel)p1[r]=NEG;}
}

constexpr int NSLOT=3, SLOTB=8192;
constexpr int LDS_K=0, LDS_V=NSLOT*SLOTB, LDS_WS=LDS_V+2*NSLOT*SLOTB, LDS_H=LDS_WS+NW*64*4, LDS_BYTES=LDS_H+NW*8192;
constexpr float C2=0.125f*1.4426950408889634f;
__device__ __forceinline__ void glds16(const void*gsrc,unsigned lds_dst){unsigned keep;
  asm volatile("s_mov_b32 %0, m0\n\ts_mov_b32 m0, %2\n\ts_nop 0\n\tglobal_load_lds_dwordx4 %1, off\n\ts_mov_b32 m0, %0":"=&s"(keep):"v"(gsrc),"s"(lds_dst):"memory");}
__device__ __forceinline__ void glds16s(const void*sbase,unsigned voff,unsigned lds_dst){unsigned keep;
  asm volatile("s_nop 4\n\ts_mov_b32 %0, m0\n\ts_mov_b32 m0, %2\n\ts_nop 0\n\tglobal_load_lds_dwordx4 %1, %3\n\ts_mov_b32 m0, %0":"=&s"(keep):"v"(voff),"s"(lds_dst),"s"(sbase):"memory");}
__device__ __forceinline__ float max3f(float a,float b,float c){float r;asm("v_max3_f32 %0, %1, %2, %3":"=v"(r):"v"(a),"v"(b),"v"(c));return r;}
__device__ __forceinline__ float max2f(float a,float b){float r;asm("v_max_f32_e32 %0, %1, %2":"=v"(r):"v"(a),"v"(b));return r;}
__device__ __forceinline__ float fadd_s(float a,float b){float r;asm("v_add_f32_e32 %0, %1, %2":"=v"(r):"v"(a),"v"(b));return r;}
__device__ __forceinline__ float fsub_s(float a,float b){float r;asm("v_sub_f32_e32 %0, %1, %2":"=v"(r):"v"(a),"v"(b));return r;}
typedef float f32x2_t __attribute__((ext_vector_type(2))); typedef __bf16 bf16x2_t __attribute__((ext_vector_type(2)));
__device__ __forceinline__ unsigned cvtpk_s(float lo,float hi){f32x2_t v={lo,hi};bf16x2_t b=__builtin_convertvector(v,bf16x2_t);return __builtin_bit_cast(unsigned,b);}
#define WAIT_BAR(N) asm volatile("s_waitcnt vmcnt(" #N ") lgkmcnt(0)\n\ts_barrier":::"memory")

__device__ __forceinline__ void qkt(f32x16&p0,f32x16&p1,const char*Kslot,const bf16x8*qr,int r32,int hi){ const f32x16 zc=f32x16{};
  const char*kb=Kslot+hi*1024+r32*16;
  #pragma unroll
  for(int d0=0;d0<4;++d0){
    const bf16x8 b0=*reinterpret_cast<const bf16x8*>(kb+d0*2048);
    const bf16x8 b1=*reinterpret_cast<const bf16x8*>(kb+d0*2048+512);
    if(d0==0){p0=__builtin_amdgcn_mfma_f32_32x32x16_bf16(b0,qr[0],zc,0,0,0);p1=__builtin_amdgcn_mfma_f32_32x32x16_bf16(b1,qr[0],zc,0,0,0);}
    else{p0=__builtin_amdgcn_mfma_f32_32x32x16_bf16(b0,qr[d0],p0,0,0,0);p1=__builtin_amdgcn_mfma_f32_32x32x16_bf16(b1,qr[d0],p1,0,0,0);}}
}
typedef __attribute__((address_space(3))) const char* lds_cptr;
typedef short v4i16_t __attribute__((ext_vector_type(4)));
__device__ __forceinline__ void kload8(bf16x8*kf,lds_cptr kp){
  kf[0]=*(const __attribute__((address_space(3))) bf16x8*)(kp);      kf[1]=*(const __attribute__((address_space(3))) bf16x8*)(kp+512);
  kf[2]=*(const __attribute__((address_space(3))) bf16x8*)(kp+2048); kf[3]=*(const __attribute__((address_space(3))) bf16x8*)(kp+2560);
  kf[4]=*(const __attribute__((address_space(3))) bf16x8*)(kp+4096); kf[5]=*(const __attribute__((address_space(3))) bf16x8*)(kp+4608);
  kf[6]=*(const __attribute__((address_space(3))) bf16x8*)(kp+6144); kf[7]=*(const __attribute__((address_space(3))) bf16x8*)(kp+6656);
}
__device__ __forceinline__ void kload2(bf16x8*kf,lds_cptr kp,int j){ kf[2*j]=*(const __attribute__((address_space(3))) bf16x8*)(kp+j*2048); kf[2*j+1]=*(const __attribute__((address_space(3))) bf16x8*)(kp+j*2048+512); }
__device__ __forceinline__ s16x4 vtr(lds_cptr p){ return __builtin_bit_cast(s16x4,__builtin_amdgcn_ds_read_tr16_b64_v4i16((__attribute__((address_space(3))) v4i16_t*)p)); }
__device__ __forceinline__ float rowmax(const f32x16&p0,const f32x16&p1){
  float a=max3f(p0[0],p0[1],p1[0]),b=max3f(p0[2],p0[3],p1[1]);a=max3f(a,p1[2],p1[3]);
  #pragma unroll
  for(int r=4;r<16;r+=4){a=max3f(a,p0[r],p0[r+1]);b=max3f(b,p0[r+2],p0[r+3]);a=max3f(a,p1[r],p1[r+1]);b=max3f(b,p1[r+2],p1[r+3]);}
  const float m=max2f(a,b);
  auto rr=__builtin_amdgcn_permlane32_swap(__float_as_uint(m),__float_as_uint(m),false,false);
  return max2f(__uint_as_float(rr[0]),__uint_as_float(rr[1]));
}
__device__ __forceinline__ void pv(f32x16*o,int vb,bf16x8 pa0,bf16x8 pa1,bf16x8 pa2,bf16x8 pa3){
  #pragma unroll
  for(int d0=0;d0<2;++d0){s16x4 lo[4],hi[4];
    #pragma unroll
    for(int ks=0;ks<4;++ks){
      asm volatile("ds_read_b64_tr_b16 %0,%1 offset:%c2":"=&v"(lo[ks]):"v"(vb),"i"(d0*4096+ks*1024):"memory");
      asm volatile("ds_read_b64_tr_b16 %0,%1 offset:%c2":"=&v"(hi[ks]):"v"(vb),"i"(d0*4096+ks*1024+512):"memory");}
    asm volatile("s_waitcnt lgkmcnt(0)":::"memory");SBAR();
    #define PK(k) (bf16x8){lo[k][0],lo[k][1],lo[k][2],lo[k][3],hi[k][0],hi[k][1],hi[k][2],hi[k][3]}
    o[d0]=__builtin_amdgcn_mfma_f32_32x32x16_bf16(pa0,PK(0),o[d0],0,0,0);
    o[d0]=__builtin_amdgcn_mfma_f32_32x32x16_bf16(pa1,PK(1),o[d0],0,0,0);
    o[d0]=__builtin_amdgcn_mfma_f32_32x32x16_bf16(pa2,PK(2),o[d0],0,0,0);
    o[d0]=__builtin_amdgcn_mfma_f32_32x32x16_bf16(pa3,PK(3),o[d0],0,0,0);
    #undef PK
  }
}

#ifndef ATTN_STORE16
#define ATTN_STORE16(p,v) (*(u32x4*)(p)=(v))
#endif
template<int THRL> __device__ __forceinline__ void attn_pass(const bf16*Qw,const bf16*__restrict__ Kh,const bf16*__restrict__ Vh,int NT,int m_sub,float lam,char*shm,const bf16*Kh_next,bool has_next,bool prefetched){
  const int tid=threadIdx.x; int lane_=tid&63; asm volatile("":"+v"(lane_));
  const int lane=lane_,r32=lane&31,hi=lane>>5; const int wid=__builtin_amdgcn_readfirstlane(tid>>6);
  if(wid>=4)__builtin_amdgcn_s_setprio(1);
  const unsigned lds0=(unsigned)(uintptr_t)shm;
  float*wsf=(float*)(shm+LDS_WS)+wid*64;
  const bf16*ksrc=Kh+wid*8; const unsigned koff=(unsigned)lane*(DM*2);
  const bf16*vsrc=Vh+(long)(16*(wid&3))*DM+(wid>>2)*32; const unsigned voff=(unsigned)(lane>>2)*(DM*2)+(unsigned)(lane&3)*16;
  const unsigned kdst=lds0+LDS_K+wid*1024, vdst=lds0+LDS_V+wid*1024;
  #define DMA_K(t,slot) glds16s(ksrc+(long)(t)*KVBLK*DM,koff,(unsigned)__builtin_amdgcn_readfirstlane(kdst+(slot)))
  #define DMA_V(t,slot) do{ glds16s(vsrc+(long)(t)*KVBLK*DM,voff,(unsigned)__builtin_amdgcn_readfirstlane(vdst+2*(slot))); glds16s(vsrc+(long)(t)*KVBLK*DM+64,voff,(unsigned)__builtin_amdgcn_readfirstlane(vdst+2*(slot)+8192)); }while(0)
  const int vb0=(int)(lds0+LDS_V)+((lane>>4)&1)*32+(lane&3)*8+(4*hi+((lane&15)>>2))*64;
  const char*Kbase=shm+LDS_K; bf16x8 kf[8];
  const lds_cptr shm3=(lds_cptr)shm; const lds_cptr kp0=shm3+LDS_K+hi*1024+r32*16; const lds_cptr vp0=shm3+LDS_V+((lane>>4)&1)*32+(lane&3)*8+(4*hi+((lane&15)>>2))*64;
  if(!prefetched){DMA_K(0,0);DMA_V(0,0);DMA_K(1,SLOTB);}
  bf16x8 qr[4];
  #pragma unroll
  for(int d0=0;d0<4;++d0)qr[d0]=*reinterpret_cast<const bf16x8*>(&Qw[(long)r32*DM+d0*16+hi*8]);
  float mhat=0.f,l_reg=0.f;f32x16 o[4]; { float z_; asm volatile("v_mov_b32 %0, 0":"=v"(z_)); _Pragma("unroll") for(int r=0;r<16;++r){o[0][r]=z_;o[1][r]=z_;o[2][r]=z_;o[3][r]=z_;} }
  const int qrel=wid*QBLK+r32;
  #define CMASK(P0,P1,t) do{int jb_=(t)-(NT-4); if(jb_>=0)cmask(P0,P1,jb_,qrel,hi);}while(0)
  bool resc=false;
  #define START(P0,P1) do{ const float rm=rowmax(P0,P1); resc=false; \
    { const float dl=rm; mhat=fadd_s(mhat,dl); \
      _Pragma("unroll") for(int r=0;r<16;++r){P0[r]=fsub_s(P0[r],dl);P1[r]=fsub_s(P1[r],dl);} \
      } \
    _Pragma("unroll") for(int r=0;r<16;++r)P0[r]=__builtin_amdgcn_exp2f(P0[r]); }while(0)
  #define RESC() do{ if(resc){ asm volatile("s_waitcnt lgkmcnt(0)":::"memory"); \
      _Pragma("unroll") for(int d_=0;d_<4;++d_) _Pragma("unroll") for(int r=0;r<16;++r)o[d_][r]*=wsf[crow(r,hi)]; } }while(0)
  f32x16 pA0,pA1,pB0,pB1;
  int sl_prev=0,sl_cur=0,sl_next=SLOTB;
  #define ROT() do{sl_prev=sl_cur;sl_cur=sl_next;sl_next=(sl_next==(NSLOT-1)*SLOTB)?0:sl_next+SLOTB;}while(0)
  DMA_K(2,2*SLOTB);
  WAIT_BAR(4);
  qkt(pA0,pA1,Kbase,qr,r32,hi);asm volatile("s_nop 15\n\ts_nop 7":"+v"(pA0),"+v"(pA1));
  { _Pragma("unroll") for(int r=8;r<16;++r)pA0[r]=-INFINITY; _Pragma("unroll") for(int r=0;r<16;++r)pA1[r]=-INFINITY; }
  START(pA0,pA1);
  _Pragma("unroll") for(int r=0;r<16;++r)pA1[r]=__builtin_amdgcn_exp2f(pA1[r]);
  WAIT_BAR(0);
  DMA_K(3,0);DMA_V(1,SLOTB);
  ROT();
  kload8(kf,kp0+sl_cur);
  WAIT_BAR(3);
  s16x4 vlo[8],vhi[8]; u32x4 pw0,pw1,pw2,pw3;
  #define PKW(P,B) cvtpk_s(P[B],P[B+1])
  #define PAF(k) __builtin_bit_cast(bf16x8,pw##k)
  #define VFR(i) (bf16x8){vlo[i][0],vlo[i][1],vlo[i][2],vlo[i][3],vhi[i][0],vhi[i][1],vhi[i][2],vhi[i][3]}
  #define PIN(x) asm volatile("":"+v"(x))
  #define MX3(a,b,c) __builtin_fmaxf(__builtin_fmaxf((a),(b)),(c))
  #define GAPA(MF,A0,A1,A2,A3,W0,W1,PW) do{ MF; sacc+=A0; sacc+=A1; sacc+=A2; sacc+=A3; PIN(sacc); W0; W1; PIN(PW); SBAR(); }while(0)
  #define EX(v) __builtin_amdgcn_exp2f(v)
  #define GAPB(MF,X,B) do{ MF; X[B]=EX(X[B]); X[B+1]=EX(X[B+1]); X[B+2]=EX(X[B+2]); X[B+3]=EX(X[B+3]); PIN(X); SBAR(); }while(0)
  #define GAPB2(MF,RD,X,B) do{ MF; RD; X[B]=EX(X[B]); X[B+1]=EX(X[B+1]); PIN(X); SBAR(); }while(0)
  #define VRD2(i) do{ vlo[i]=vtr(vp2_+(((i)>>2)*4096+((i)&3)*1024)); vhi[i]=vtr(vp2_+(((i)>>2)*4096+((i)&3)*1024+512)); }while(0)
  #define VRD(i) do{ vlo[i]=vtr(vp_+(((i)>>2)*4096+((i)&3)*1024)); vhi[i]=vtr(vp_+(((i)>>2)*4096+((i)&3)*1024+512)); }while(0)
  #define KRD(G,j) do{ if(G){ kload2(kf,kp0+sl_next,j); SBAR(); } }while(0)
  #define STEP(C0,C1,P0,P1,t,GK,GV,GL) do{ SBAR(); \
    const lds_cptr vp_=vp0+2*sl_prev; \
    VRD(0); SBAR(); float sacc=(P0[0]+P0[1]); \
    GAPA(C0=__builtin_amdgcn_mfma_f32_32x32x16_bf16(kf[0],qr[0],f32x16{},0,0,0), P0[2],P0[3],P0[4],P0[5],     pw0[0]=PKW(P0,0), pw0[1]=PKW(P0,2), pw0); \
    VRD(4); SBAR(); GAPA(C1=__builtin_amdgcn_mfma_f32_32x32x16_bf16(kf[1],qr[0],f32x16{},0,0,0), P0[6],P0[7],P0[8],P0[9],     pw0[2]=PKW(P0,4), pw0[3]=PKW(P0,6), pw0); \
    VRD(1); SBAR(); GAPA(C0=__builtin_amdgcn_mfma_f32_32x32x16_bf16(kf[2],qr[1],C0,0,0,0),   P0[10],P0[11],P0[12],P0[13], pw1[0]=PKW(P0,8), pw1[1]=PKW(P0,10), pw1); \
    VRD(5); SBAR(); GAPA(C1=__builtin_amdgcn_mfma_f32_32x32x16_bf16(kf[3],qr[1],C1,0,0,0),   P0[14],P0[15],P1[0],P1[1],   pw1[2]=PKW(P0,12),pw1[3]=PKW(P0,14), pw1); \
    VRD(2); SBAR(); GAPA(C0=__builtin_amdgcn_mfma_f32_32x32x16_bf16(kf[4],qr[2],C0,0,0,0),   P1[2],P1[3],P1[4],P1[5],     pw2[0]=PKW(P1,0), pw2[1]=PKW(P1,2), pw2); \
    VRD(6); SBAR(); GAPA(C1=__builtin_amdgcn_mfma_f32_32x32x16_bf16(kf[5],qr[2],C1,0,0,0),   P1[6],P1[7],P1[8],P1[9],     pw2[2]=PKW(P1,4), pw2[3]=PKW(P1,6), pw2); \
    VRD(3); SBAR(); GAPA(C0=__builtin_amdgcn_mfma_f32_32x32x16_bf16(kf[6],qr[3],C0,0,0,0),   P1[10],P1[11],P1[12],P1[13], pw3[0]=PKW(P1,8), pw3[1]=PKW(P1,10), pw3); \
    VRD(7); SBAR(); GAPA(C1=__builtin_amdgcn_mfma_f32_32x32x16_bf16(kf[7],qr[3],C1,0,0,0),   P1[14],P1[15],0.f,0.f,       pw3[2]=PKW(P1,12),pw3[3]=PKW(P1,14), pw3); \
    l_reg+=sacc; \
    _Pragma("unroll") for(int r=0;r<16;++r){C0[r]-=mhat;C1[r]-=mhat;} \
    if(GK){DMA_K((t)+3,sl_cur);} if(GV){DMA_V((t)+1,sl_next);} \
    CMASK(C0,C1,t); \
    { float a=MX3(C0[0],C0[1],C1[0]),b=MX3(C0[2],C0[3],C1[1]); a=MX3(a,C1[2],C1[3]); \
      _Pragma("unroll") for(int r=4;r<16;r+=4){a=MX3(a,C0[r],C0[r+1]);b=MX3(b,C0[r+2],C0[r+3]);a=MX3(a,C1[r],C1[r+1]);b=MX3(b,C1[r+2],C1[r+3]);} \
      float rm=__builtin_fmaxf(a,b); { auto rr=__builtin_amdgcn_permlane32_swap(__float_as_uint(rm),__float_as_uint(rm),false,false); rm=__builtin_fmaxf(__uint_as_float(rr[0]),__uint_as_float(rr[1])); } \
      resc=false; \
      if(__builtin_expect(__any(rm>(float)THRL),0)){ const float dl=__builtin_fmaxf(rm,0.f); mhat+=dl; \
        _Pragma("unroll") for(int r=0;r<16;++r){C0[r]-=dl;C1[r]-=dl;} \
        const float f=__builtin_amdgcn_exp2f(-dl); l_reg*=f; if(hi==0)wsf[r32]=f; resc=true; } } \
    SBAR(); \
    const lds_cptr vp2_=vp0+2*sl_prev+8192; \
    GAPB2(o[0]=__builtin_amdgcn_mfma_f32_32x32x16_bf16(PAF(0),VFR(0),o[0],0,0,0), VRD2(0), C0,0); \
    GAPB2(o[1]=__builtin_amdgcn_mfma_f32_32x32x16_bf16(PAF(0),VFR(4),o[1],0,0,0), VRD2(4), C0,2); \
    GAPB2(o[0]=__builtin_amdgcn_mfma_f32_32x32x16_bf16(PAF(1),VFR(1),o[0],0,0,0), VRD2(1), C0,4); \
    GAPB2(o[1]=__builtin_amdgcn_mfma_f32_32x32x16_bf16(PAF(1),VFR(5),o[1],0,0,0), VRD2(5), C0,6); \
    GAPB2(o[0]=__builtin_amdgcn_mfma_f32_32x32x16_bf16(PAF(2),VFR(2),o[0],0,0,0), VRD2(2), C0,8); \
    GAPB2(o[1]=__builtin_amdgcn_mfma_f32_32x32x16_bf16(PAF(2),VFR(6),o[1],0,0,0), VRD2(6), C0,10); \
    GAPB2(o[0]=__builtin_amdgcn_mfma_f32_32x32x16_bf16(PAF(3),VFR(3),o[0],0,0,0), VRD2(3), C0,12); \
    GAPB2(o[1]=__builtin_amdgcn_mfma_f32_32x32x16_bf16(PAF(3),VFR(7),o[1],0,0,0), VRD2(7), C0,14); \
    KRD(GL,0); GAPB2(o[2]=__builtin_amdgcn_mfma_f32_32x32x16_bf16(PAF(0),VFR(0),o[2],0,0,0), (void)0, C1,0); \
    KRD(GL,1); GAPB2(o[3]=__builtin_amdgcn_mfma_f32_32x32x16_bf16(PAF(0),VFR(4),o[3],0,0,0), (void)0, C1,2); \
    KRD(GL,2); GAPB2(o[2]=__builtin_amdgcn_mfma_f32_32x32x16_bf16(PAF(1),VFR(1),o[2],0,0,0), (void)0, C1,4); \
    KRD(GL,3); GAPB2(o[3]=__builtin_amdgcn_mfma_f32_32x32x16_bf16(PAF(1),VFR(5),o[3],0,0,0), (void)0, C1,6); \
    GAPB2(o[2]=__builtin_amdgcn_mfma_f32_32x32x16_bf16(PAF(2),VFR(2),o[2],0,0,0), (void)0, C1,8); \
    GAPB2(o[3]=__builtin_amdgcn_mfma_f32_32x32x16_bf16(PAF(2),VFR(6),o[3],0,0,0), (void)0, C1,10); \
    GAPB2(o[2]=__builtin_amdgcn_mfma_f32_32x32x16_bf16(PAF(3),VFR(3),o[2],0,0,0), (void)0, C1,12); \
    GAPB2(o[3]=__builtin_amdgcn_mfma_f32_32x32x16_bf16(PAF(3),VFR(7),o[3],0,0,0), (void)0, C1,14); \
    }while(0)
  int t=1;
  #undef CMASK
  #define CMASK(P0,P1,t) do{}while(0)
  for(;t+5<NT;t+=2){
    STEP(pB0,pB1,pA0,pA1,t,true,true,true);     WAIT_BAR(3); RESC(); ROT();
    STEP(pA0,pA1,pB0,pB1,t+1,true,true,true);   WAIT_BAR(3); RESC(); ROT();
  }
  #undef CMASK
  #define CMASK(P0,P1,t) do{int jb_=(t)-(NT-4); if(jb_>=0)cmask(P0,P1,jb_,qrel,hi);}while(0)
  #define ENDW(tt) do{ if((tt)+3<NT){WAIT_BAR(3);} else if((tt)+2<NT){WAIT_BAR(2);} else {WAIT_BAR(0);} }while(0)
  for(;t+3<NT;t+=2){
    STEP(pB0,pB1,pA0,pA1,t,(t+3<NT),(t+1<NT),(t+1<NT));       ENDW(t);   RESC(); ROT();
    STEP(pA0,pA1,pB0,pB1,t+1,(t+4<NT),(t+2<NT),(t+2<NT));     ENDW(t+1); RESC(); ROT();
  }
  STEP(pB0,pB1,pA0,pA1,NT-2,false,true,true);  WAIT_BAR(0); RESC(); ROT();
  STEP(pA0,pA1,pB0,pB1,NT-1,false,false,false); RESC();
  { float sacc=pA0[0]+pA0[1]; _Pragma("unroll") for(int r=2;r<16;++r)sacc+=pA0[r]; _Pragma("unroll") for(int r=0;r<16;++r)sacc+=pA1[r]; l_reg+=sacc;
    pw0=(u32x4){PKW(pA0,0),PKW(pA0,2),PKW(pA0,4),PKW(pA0,6)};pw1=(u32x4){PKW(pA0,8),PKW(pA0,10),PKW(pA0,12),PKW(pA0,14)};pw2=(u32x4){PKW(pA1,0),PKW(pA1,2),PKW(pA1,4),PKW(pA1,6)};pw3=(u32x4){PKW(pA1,8),PKW(pA1,10),PKW(pA1,12),PKW(pA1,14)};
    SBAR(); pv(o,vb0+2*sl_cur,PAF(0),PAF(1),PAF(2),PAF(3)); pv(o+2,vb0+2*sl_cur+8192,PAF(0),PAF(1),PAF(2),PAF(3)); }
  asm volatile("s_waitcnt lgkmcnt(0)\n\ts_barrier":::"memory");
  if(has_next){ const bf16*ksrc_n=Kh_next+wid*8;
    glds16s(ksrc_n,koff,(unsigned)__builtin_amdgcn_readfirstlane(kdst)); DMA_V(0,0); glds16s(ksrc_n+(long)KVBLK*DM,koff,(unsigned)__builtin_amdgcn_readfirstlane(kdst+SLOTB)); }
  #undef PKW
  #undef PAF
  #undef VFR
  #undef PIN
  #undef MX3
  #undef GAPA
  #undef GAPB
  #undef GAPB2
  #undef VRD2
  #undef EX
  #undef VRD
  #undef KRD
  #undef STEP
  #undef ENDW
  {auto rr=__builtin_amdgcn_permlane32_swap(__float_as_uint(l_reg),__float_as_uint(l_reg),false,false);l_reg=__uint_as_float(rr[0])+__uint_as_float(rr[1]);}
  if(hi==0)wsf[32+r32]=l_reg;asm volatile("s_waitcnt lgkmcnt(0)":::"memory");
  float rli[16];
  #pragma unroll
  for(int r=0;r<16;++r)rli[r]=__builtin_amdgcn_rcpf(wsf[32+crow(r,hi)]);
  { typedef __attribute__((address_space(3))) unsigned short* lds_u16p;
    int ln=lane; asm volatile("":"+v"(ln));
    const int r32e=ln&31, hie=ln>>5; const int bc=hie*4+(r32e>>3); const int lb=hie*512+(r32e&7);
    const lds_u16p Hw=(lds_u16p)(shm3+LDS_H+wid*8192);
    #pragma unroll
    for(int r=0;r<16;++r){
      #pragma unroll
      for(int d0=0;d0<4;++d0){ const int idx=lb+((r&3)+8*(r>>2))*128+((bc^(((((r>>2)&1)<<3)|(r&3))^(d0<<2)))<<3);
        float val=o[d0][r]*rli[r];
        if(m_sub){ const float old=__uint_as_float(((unsigned)Hw[idx])<<16); val=old-lam*val; }
        Hw[idx]=(unsigned short)(cvtpk_s(val,0.f)&0xffffu); } } }
  asm volatile("s_waitcnt lgkmcnt(0)":::"memory");
  __builtin_amdgcn_s_setprio(0);
  #undef DMA_K
  #undef DMA_V
  #undef CMASK
  #undef START
  #undef RESC
  #undef ROT
}
constexpr int ATTN_LDS_BYTES=LDS_BYTES;
#undef SBAR
#undef WAIT_BAR
}

namespace cg = cooperative_groups;
#define GAS __attribute__((address_space(1)))
#define LAS __attribute__((address_space(3)))
typedef unsigned short bf16;
typedef unsigned v4u __attribute__((ext_vector_type(4)));
typedef float f32x4 __attribute__((ext_vector_type(4)));

constexpr int NB = 32, SEQ = 2048, DM = 1024, MTOK = NB * SEQ;
constexpr int INC = 8192, DFF = 2816, KROWS = 64 + SEQ;
constexpr float NORM_EPS = 1e-5f, LAMBDA_INIT = 0.2f;
constexpr float QSCALE = 0.125f * 1.4426950408889634f;
constexpr size_t MiB = 1u << 20;
constexpr size_t WS_SS2 = 0, WS_SS3 = 256 * 1024, WS_RS1 = 512 * 1024, WS_PM = 768 * 1024;
constexpr size_t WS_WIN = 2 * MiB, WS_WP = 18 * MiB, WS_WOUT = 22 * MiB, WS_WGU = 24 * MiB, WS_WDN = 35 * MiB;
constexpr size_t WS_QO = 48 * MiB, WS_CB = 176 * MiB, WS_U = 304 * MiB, WS_SGA = 432 * MiB, WS_SGB = 560 * MiB, WS_KB = 688 * MiB, WS_VB = 820 * MiB, WS_END = 952 * MiB;
constexpr size_t WS_MG = WS_KB, WS_H2B = WS_VB, WS_ACT = WS_QO;
static_assert(WS_ACT + (size_t)MTOK * DFF * 2 <= WS_SGA + 128 * MiB && WS_KB + (size_t)NB * KROWS * DM * 2 <= WS_VB && WS_VB + (size_t)NB * KROWS * DM * 2 <= WS_END, "ws map");
constexpr int LDS_BYTES = 147456;
static_assert(attn_body::ATTN_LDS_BYTES <= LDS_BYTES, "attention LDS");
constexpr size_t WS_BAR = 1 * MiB;
constexpr int LDS_BARST = LDS_BYTES - 256;
static_assert(attn_body::ATTN_LDS_BYTES <= LDS_BARST, "attention LDS vs barrier words");
#define RLX_AGENT __ATOMIC_RELAXED, __HIP_MEMORY_SCOPE_AGENT
#define XB_TMO      128
#define XB_XCNT(j)  (256  + 64 * (j))
#define XB_XSUB(j)  (1280 + 64 * (j))
#define XB_XGEN(j)  (2304 + 64 * (j))
#define XB_TOP      3328
#define XB_TOPGEN   3392
#define XCD_BAR_WORDS 3456
#define XB_SPIN_CAP (1u << 18)

__device__ __forceinline__ unsigned xb_ld(unsigned* p)              { return __hip_atomic_load(p, __ATOMIC_RELAXED, __HIP_MEMORY_SCOPE_AGENT); }
__device__ __forceinline__ unsigned xb_add(unsigned* p, unsigned v) { return __hip_atomic_fetch_add(p, v, __ATOMIC_RELAXED, __HIP_MEMORY_SCOPE_AGENT); }
__device__ __forceinline__ unsigned xb_xcc_id() { return (unsigned)__builtin_amdgcn_s_getreg((3 << 11) | 20) & 0xFu; }
#define XB_SPIN(cond, bar) do { unsigned _sp = 0; while (cond) { __builtin_amdgcn_s_sleep(1); \
    if ((++_sp & 255u) == 0u) { if (xb_ld(&(bar)[XB_TMO])) break; if (_sp > XB_SPIN_CAP) { atomicAdd(&(bar)[XB_TMO], 1u); break; } } } } while (0)

struct XcdBarrier {
    unsigned* bar; unsigned x;
    volatile LAS unsigned* st;
};

__device__ __forceinline__ XcdBarrier xcd_barrier_post(unsigned* bar, volatile LAS unsigned* st) {
    XcdBarrier b; b.bar = bar; b.x = xb_xcc_id(); b.st = st;
    if (threadIdx.x == 0) (void)xb_add(&bar[XB_XCNT(b.x)], 1u);
    return b;
}
__device__ __forceinline__ void xcd_barrier_complete(unsigned* bar, unsigned x, unsigned& nloc, unsigned& nx) {
    const unsigned G = gridDim.x * gridDim.y * gridDim.z;
    unsigned sum, cnt, mine, sp = 0u;
    for (;;) {
        sum = 0u; cnt = 0u; mine = 0u;
#pragma unroll
        for (unsigned j = 0; j < 16; ++j) { const unsigned c = xb_ld(&bar[XB_XCNT(j)]); sum += c; cnt += (c > 0u) ? 1u : 0u; mine = (j == x) ? c : mine; }
        if (sum == G) break;
        __builtin_amdgcn_s_sleep(1);
        if ((++sp & 255u) == 0u) { if (xb_ld(&bar[XB_TMO])) break; if (sp > XB_SPIN_CAP) { atomicAdd(&bar[XB_TMO], 1u); break; } }
    }
    nloc = mine > 0u ? mine : 1u; nx = cnt > 0u ? cnt : 1u;
}

__device__ __forceinline__ void xcd_barrier(const XcdBarrier& b) {
    asm volatile("s_waitcnt vmcnt(0)" ::: "memory");
    __syncthreads();
    if (threadIdx.x == 0) {
        unsigned* bar = b.bar;
        __builtin_amdgcn_s_waitcnt(0);
        unsigned nloc = b.st[0], nx = b.st[1];
        if (nloc == 0u) { xcd_barrier_complete(bar, b.x, nloc, nx); b.st[0] = nloc; b.st[1] = nx; }
        const unsigned old = xb_add(&bar[XB_XSUB(b.x)], 1u);
        const unsigned gen = old / nloc;
        if (old + 1u == (gen + 1u) * nloc) {
            __builtin_amdgcn_fence(__ATOMIC_RELEASE, "agent");
            asm volatile("s_waitcnt vmcnt(0)" ::: "memory");
            const unsigned og = xb_add(&bar[XB_TOP], 1u);
            const unsigned tg = og / nx;
            if (og + 1u == (tg + 1u) * nx) xb_add(&bar[XB_TOPGEN], 1u);
            else XB_SPIN(xb_ld(&bar[XB_TOPGEN]) == tg, bar);
            __builtin_amdgcn_fence(__ATOMIC_ACQUIRE, "agent");
            xb_add(&bar[XB_XGEN(b.x)], 1u);
            asm volatile("s_waitcnt vmcnt(0)" ::: "memory");
        } else {
            XB_SPIN(xb_ld(&bar[XB_XGEN(b.x)]) == gen, bar);
            __builtin_amdgcn_fence(__ATOMIC_ACQUIRE, "agent");
            asm volatile("s_waitcnt vmcnt(0)" ::: "memory");
        }
    }
    __syncthreads();
}


template <int K> __device__ __forceinline__ float xor_swz(float v) { return __uint_as_float((unsigned)__builtin_amdgcn_ds_swizzle((int)__float_as_uint(v), (K << 10) | 0x1f)); }
__device__ __forceinline__ float xor32_sum(float v) { auto rr = __builtin_amdgcn_permlane32_swap(__float_as_uint(v), __float_as_uint(v), false, false); return __uint_as_float(rr[0]) + __uint_as_float(rr[1]); }
__device__ __forceinline__ float wave_sum(float v) { v += xor_swz<1>(v); v += xor_swz<2>(v); v += xor_swz<4>(v); v += xor_swz<8>(v); v += xor_swz<16>(v); return xor32_sum(v); }
__device__ __forceinline__ float bf_lo(unsigned w) { return __uint_as_float(w << 16); }
__device__ __forceinline__ float bf_hi(unsigned w) { return __uint_as_float(w & 0xffff0000u); }
__device__ __forceinline__ v4u pack8(f32x4 a, f32x4 b) { v4u w; w.x = pg8::cvt_pk_bf16(a[0], a[1]); w.y = pg8::cvt_pk_bf16(a[2], a[3]); w.z = pg8::cvt_pk_bf16(b[0], b[1]); w.w = pg8::cvt_pk_bf16(b[2], b[3]); return w; }
__device__ __forceinline__ void unpack8(v4u w, f32x4& a, f32x4& b) { a = (f32x4){bf_lo(w.x), bf_hi(w.x), bf_lo(w.y), bf_hi(w.y)}; b = (f32x4){bf_lo(w.z), bf_hi(w.z), bf_lo(w.w), bf_hi(w.w)}; }
__device__ __forceinline__ float sigm(float x) { return __builtin_amdgcn_rcpf(1.f + __builtin_amdgcn_exp2f(-1.4426950408889634f * x)); }
__device__ __forceinline__ float inv_freq(int d) { return exp2f(-(float)d * (13.287712379549449f / 32.f)); }
__device__ __forceinline__ void rope_cs(float pos, float invf, float& c, float& s) {
    const float ang = pos * invf; float rev = ang * 0.15915494309189535f; rev = __builtin_amdgcn_fractf(rev);
    s = __builtin_amdgcn_sinf(rev); c = __builtin_amdgcn_cosf(rev);
}

namespace pg8 {
#define NTST(ptr, val) (*(v4u*)(ptr) = (val))
struct EpiInProj {
    static constexpr bool PERM = true, AFTER_DRAIN = false, MID = false;
    const float* rs1; bf16_t *QO, *KB, *VB, *CB, *U, *SGA, *SGB;
    __device__ __forceinline__ void operator()(const f32x4 (&acc)[2][2][4][2], const Unit& u, int wr, int wc, int fr, int fq) const {
        int frp = fr; asm volatile("" : "+v"(frp)); const int pn = u.pn, row0 = u.pm * BM + wr * 64 + frp;
        const size_t kvshift = (size_t)64 * ((u.pm >> 3) + 1);
        if (pn < 8) {
            const bool isq = pn < 4; bf16_t* base = isq ? QO : KB; const float s0 = isq ? QSCALE : 1.f;
            const int colt = (pn & 3) * 256 + wc * 64 + 8 * fq;
            float invf[8];
#pragma unroll
            for (int k = 0; k < 8; ++k) invf[k] = inv_freq(8 * fq + k);
#pragma unroll
            for (int ai = 0; ai < 2; ++ai)
#pragma unroll
                for (int m = 0; m < 4; ++m) {
                    const int row = row0 + ai * HALF + m * 16; const float pos = (float)(16 + (row & (SEQ - 1))); const float sc = s0;
                    const size_t orow = isq ? (size_t)row : (size_t)row + kvshift;
                    f32x4 lo[2], hi[2], ylo[2], yhi[2];
                    lo[0] = acc[ai][0][m][0] * sc; lo[1] = acc[ai][0][m][1] * sc; hi[0] = acc[ai][1][m][0] * sc; hi[1] = acc[ai][1][m][1] * sc;
#pragma unroll
                    for (int n = 0; n < 2; ++n)
#pragma unroll
                        for (int k = 0; k < 4; ++k) { float c, s; rope_cs(pos, invf[4 * n + k], c, s); ylo[n][k] = lo[n][k] * c - hi[n][k] * s; yhi[n][k] = hi[n][k] * c + lo[n][k] * s; }
                    bf16_t* p = base + orow * DM + colt;
                    NTST(p, pack8(ylo[0], ylo[1])); NTST((p + 32), pack8(yhi[0], yhi[1]));
                }
        } else if (pn < 16) {
            const bool isv = pn < 12; bf16_t* base = isv ? VB : CB; const int colt = (pn & 3) * 256 + wc * 32 + 8 * fq;
#pragma unroll
            for (int ai = 0; ai < 2; ++ai)
#pragma unroll
                for (int m = 0; m < 4; ++m) {
                    const int row = row0 + ai * HALF + m * 16; const float sc = 1.f; const size_t orow = isv ? (size_t)row + kvshift : (size_t)row;
                    bf16_t* p = base + orow * DM + colt;
#pragma unroll
                    for (int bj = 0; bj < 2; ++bj) NTST((p + bj * HALF), pack8(acc[ai][bj][m][0] * sc, acc[ai][bj][m][1] * sc));
                }
        } else if (pn < 24) {
            const int colt = (pn - 16) * 128 + wc * 32 + 8 * fq;
#pragma unroll
            for (int ai = 0; ai < 2; ++ai)
#pragma unroll
                for (int m = 0; m < 4; ++m) {
                    const int row = row0 + ai * HALF + m * 16; const float sc2 = 1.f;
                    NTST((U + (size_t)row * DM + colt), pack8(acc[ai][0][m][0] * acc[ai][1][m][0] * sc2, acc[ai][0][m][1] * acc[ai][1][m][1] * sc2));
                }
        } else {
            const int colt = (pn - 24) * 128 + wc * 32 + 8 * fq;
#pragma unroll
            for (int ai = 0; ai < 2; ++ai)
#pragma unroll
                for (int m = 0; m < 4; ++m) {
                    const int row = row0 + ai * HALF + m * 16; f32x4 ra[2], sb[2];
#pragma unroll
                    for (int n = 0; n < 2; ++n)
#pragma unroll
                        for (int k = 0; k < 4; ++k) { const float ea = __builtin_amdgcn_exp2f(fminf(-1.4426950408889634f * acc[ai][0][m][n][k], 80.f)), eb = __builtin_amdgcn_exp2f(fminf(-1.4426950408889634f * acc[ai][1][m][n][k], 80.f));
                            ra[n][k] = __builtin_amdgcn_rcpf(1.f + ea) * (1.f + eb); sb[n][k] = __builtin_amdgcn_rcpf(1.f + eb); }
                    NTST((SGA + (size_t)row * DM + colt), pack8(ra[0], ra[1])); NTST((SGB + (size_t)row * DM + colt), pack8(sb[0], sb[1]));
                }
        }
    }
};
struct EpiMerge {
    static constexpr bool PERM = true, AFTER_DRAIN = false, MID = true;
    const bf16_t *SGA, *SGB; bf16_t* MG;
    __device__ __forceinline__ void mid(f32x4 (&acc)[2][2][4][2], const Unit& u, int wr, int wc, int fr, int fq) const {
        int frp = fr; asm volatile("" : "+v"(frp)); const int row0 = u.pm * BM + wr * 64 + frp, col0 = u.pn * BM + wc * 32 + 8 * fq;
#pragma unroll
        for (int ai = 0; ai < 2; ++ai)
#pragma unroll
            for (int m = 0; m < 4; ++m) { const size_t off = (size_t)(row0 + ai * HALF + m * 16) * DM + col0;
#pragma unroll
                for (int bj = 0; bj < 2; ++bj) { f32x4 a0, a1; unpack8(__builtin_nontemporal_load((const v4u*)(SGA + off + bj * HALF)), a0, a1);
                    acc[ai][bj][m][0] *= a0; acc[ai][bj][m][1] *= a1; }
                if (m == 3) asm volatile("" ::: "memory"); }
    }
    __device__ __forceinline__ void operator()(const f32x4 (&acc)[2][2][4][2], const Unit& u, int wr, int wc, int fr, int fq) const {
        int frp = fr; asm volatile("" : "+v"(frp)); const int row0 = u.pm * BM + wr * 64 + frp, col0 = u.pn * BM + wc * 32 + 8 * fq;
#pragma unroll
        for (int ai = 0; ai < 2; ++ai)
#pragma unroll
            for (int m = 0; m < 4; ++m) { const size_t off = (size_t)(row0 + ai * HALF + m * 16) * DM + col0;
#pragma unroll
                for (int bj = 0; bj < 2; ++bj) { f32x4 b0, b1; unpack8(__builtin_nontemporal_load((const v4u*)(SGB + off + bj * HALF)), b0, b1);
                    NTST((MG + off + bj * HALF), pack8(acc[ai][bj][m][0] * b0, acc[ai][bj][m][1] * b1)); } }
    }
};
template <bool IN_BF16> struct EpiResid {
    static constexpr bool PERM = true, AFTER_DRAIN = false, MID = false;
    const void* hin; bf16_t* hb; float* ss; const float* rsn;
    __device__ __forceinline__ void operator()(const f32x4 (&acc)[2][2][4][2], const Unit& u, int wr, int wc, int fr, int fq) const {
        int frp = fr; asm volatile("" : "+v"(frp)); const int row0 = u.pm * BM + wr * 64 + frp, col0 = u.pn * BM + wc * 32 + 8 * fq;
#pragma unroll
        for (int ai = 0; ai < 2; ++ai)
#pragma unroll
            for (int m = 0; m < 4; ++m) { const int row = row0 + ai * HALF + m * 16; const size_t off = (size_t)row * DM + col0; float s = 0.f; const float rinv = rsn ? __builtin_amdgcn_rcpf(rsn[row]) : 1.f;
#pragma unroll
                for (int bj = 0; bj < 2; ++bj) { f32x4 h0, h1;
                    if (IN_BF16) unpack8(__builtin_nontemporal_load((const v4u*)((const bf16_t*)hin + off + bj * HALF)), h0, h1);
                    else { h0 = *(const f32x4*)((const float*)hin + off + bj * HALF); h1 = *(const f32x4*)((const float*)hin + off + bj * HALF + 4); }
                    if (rsn) { h0 = h0 * rinv; h1 = h1 * rinv; }
                    h0 += acc[ai][bj][m][0]; h1 += acc[ai][bj][m][1];
                    NTST((hb + off + bj * HALF), pack8(h0, h1));
                    s += (h0[0] * h0[0] + h0[1] * h0[1]) + (h0[2] * h0[2] + h0[3] * h0[3]) + (h1[0] * h1[0] + h1[1] * h1[1]) + (h1[2] * h1[2] + h1[3] * h1[3]); }
                s += xor_swz<16>(s); s = xor32_sum(s);
                if (fq == 0) (void)__hip_atomic_fetch_add(ss + row, s, __ATOMIC_RELAXED, __HIP_MEMORY_SCOPE_AGENT); }
    }
};
struct EpiGateUp {
    static constexpr bool PERM = true, AFTER_DRAIN = false, MID = false;
    const float* ss2; bf16_t* ACT;
    __device__ __forceinline__ void operator()(const f32x4 (&acc)[2][2][4][2], const Unit& u, int wr, int wc, int fr, int fq) const {
        int frp = fr; asm volatile("" : "+v"(frp)); const int row0 = u.pm * BM + wr * 64 + frp, col0 = u.pn * HALF + wc * 32 + 8 * fq;
#pragma unroll
        for (int ai = 0; ai < 2; ++ai)
#pragma unroll
            for (int m = 0; m < 4; ++m) { const int row = row0 + ai * HALF + m * 16; const float r2 = __builtin_amdgcn_rsqf(ss2[row] * (1.f / DM) + NORM_EPS);
                f32x4 o[2];
#pragma unroll
                for (int n = 0; n < 2; ++n) { const f32x4 g = acc[ai][0][m][n] * r2, uu = acc[ai][1][m][n] * r2;
#pragma unroll
                    for (int k = 0; k < 4; ++k) o[n][k] = g[k] * sigm(g[k]) * uu[k]; }
                NTST((ACT + (size_t)row * DFF + col0), pack8(o[0], o[1])); }
    }
};
}

__device__ __forceinline__ void transpose_item(const float* W, int N, int k0, int n0src, const float* ksc, bf16* WT, int ldk, int drow0, int dk0, LAS float* scr, int lane) {
#pragma unroll
    for (int i = 0; i < 32; ++i) { const int kk = 2 * i + (lane >> 5); float v = W[(size_t)(k0 + kk) * N + n0src + (lane & 31)]; if (ksc) v *= ksc[k0 + kk]; scr[kk * 33 + (lane & 31)] = v; }
    asm volatile("s_waitcnt lgkmcnt(0)" ::: "memory");
    const int c = lane & 7;
#pragma unroll
    for (int j = 0; j < 4; ++j) { const int n = (lane >> 3) + 8 * j; const LAS float* s = scr + (8 * c) * 33 + n;
        v4u o; o.x = pg8::cvt_pk_bf16(s[0 * 33], s[1 * 33]); o.y = pg8::cvt_pk_bf16(s[2 * 33], s[3 * 33]); o.z = pg8::cvt_pk_bf16(s[4 * 33], s[5 * 33]); o.w = pg8::cvt_pk_bf16(s[6 * 33], s[7 * 33]);
        *(v4u*)(WT + (size_t)(drow0 + n) * ldk + dk0 + 8 * c) = o; }
    asm volatile("s_waitcnt lgkmcnt(0)" ::: "memory");
}
__device__ __forceinline__ int win_src_col(int rb) {
    const int pn = rb >> 3, sb = rb & 7, bj = sb >> 2, wc = sb & 3;
    if (pn < 8) return pn * 256 + 64 * wc + 32 * bj;
    if (pn < 16) return pn * 256 + sb * 32;
    if (pn < 24) return (bj ? 5120 : 4096) + 128 * (pn - 16) + 32 * wc;
    return (bj ? 7168 : 6144) + 128 * (pn - 24) + 32 * wc;
}

#ifndef REPMASK
#define REPMASK 0
#endif
#ifndef PHMASK
#define PHMASK 0xFF
#endif
struct Args { const float* in[17]; float* out; unsigned char* ws; };

__global__ void __launch_bounds__(512, 2) fwd_kernel(Args a) {
    extern __shared__ __attribute__((aligned(16))) unsigned char lds[];
    cg::grid_group grid = cg::this_grid();
    const int wave = __builtin_amdgcn_readfirstlane((int)threadIdx.x >> 6);
#define PIN_TID() int tid_ = threadIdx.x; asm volatile("" : "+v"(tid_)); const int tid = tid_, lane = tid & 63, gtid = bx * 512 + tid; (void)lane; (void)gtid
    const int G = gridDim.x, bx = blockIdx.x;
    const int vcu = (G % 8 == 0) ? (bx % 8) * (G / 8) + bx / 8 : bx;
    LAS unsigned char* L = (LAS unsigned char*)lds;
    unsigned char* ws = a.ws;
    const float* x = a.in[0]; const float* w_in = a.in[3];
#define Win_t ((bf16*)(ws + WS_WIN))
#define Wp_t ((bf16*)(ws + WS_WP))
#define Wout_t ((bf16*)(ws + WS_WOUT))
#define Wgu_t ((bf16*)(ws + WS_WGU))
#define Wdn_t ((bf16*)(ws + WS_WDN))
#define QO ((bf16*)(ws + WS_QO))
#define CB ((bf16*)(ws + WS_CB))
#define U ((bf16*)(ws + WS_U))
#define SGA ((bf16*)(ws + WS_SGA))
#define SGB ((bf16*)(ws + WS_SGB))
#define KB ((bf16*)(ws + WS_KB))
#define VB ((bf16*)(ws + WS_VB))
#define MG ((bf16*)(ws + WS_MG))
#define H2B ((bf16*)(ws + WS_H2B))
#define ACT ((bf16*)(ws + WS_ACT))
#define H3B ((bf16*)(ws + WS_SGA))
#define ss2 ((float*)(ws + WS_SS2))
#define ss3 ((float*)(ws + WS_SS3))
#define rs1 ((float*)(ws + WS_RS1))
#define PM ((float*)(ws + WS_PM))
    bf16* HB = (bf16*)a.out;
    { volatile LAS unsigned* st0 = (volatile LAS unsigned*)(L + LDS_BARST); if (threadIdx.x < 2) st0[threadIdx.x] = 0u; __syncthreads(); }
#define XSYNC() xcd_barrier(xbar)
#define GSYNC() do { asm volatile("s_waitcnt vmcnt(0)" ::: "memory"); __syncthreads(); grid.sync(); \
    if (threadIdx.x == 0) { __builtin_amdgcn_fence(__ATOMIC_ACQUIRE, "agent"); asm volatile("s_waitcnt vmcnt(0)" ::: "memory"); } __syncthreads(); } while (0)
    const int GT = G * 512;

    for (int rep_ = 0; rep_ < 1 + ((REPMASK >> 0) & 1); ++rep_) if ((PHMASK >> 0) & 1) {
        PIN_TID();
        const int gw = vcu * 8 + wave, NGW = G * 8;
        for (int i = gtid; i < 2 * MTOK / 4; i += GT) ((f32x4*)ss2)[i] = (f32x4){0.f, 0.f, 0.f, 0.f};
        for (int i = gtid; i < XCD_BAR_WORDS; i += GT) ((unsigned*)(ws + WS_BAR))[i] = 0u;
        for (int i = gtid; i < 2 * NB * 6144; i += GT) { const int buf = i / (NB * 6144), r = i % (NB * 6144), b = r / 6144, o = r % 6144;
            ((v4u*)((buf ? VB : KB) + ((size_t)b * KROWS + 16) * DM))[o] = (v4u){0u, 0u, 0u, 0u}; }
        LAS float* scr = (LAS float*)(L + wave * 16384);
        constexpr int I_IN = 16 * 256, I_P = 16 * 32, I_GU = 16 * 176, I_DN = 44 * 32, NITEMS = I_IN + 3 * I_P + I_GU + I_DN;
        for (int it = gw; it < NITEMS; it += NGW) {
            int r = it;
            if (r < I_IN) { const int kb = r >> 8, rb = r & 255; transpose_item(w_in, INC, kb * 64, win_src_col(rb), a.in[2], Win_t, DM, rb * 32, kb * 64, scr, lane); continue; } r -= I_IN;
            if (r < I_P) { const int kb = r >> 5, rb = r & 31; transpose_item(a.in[10], DM, kb * 64, rb * 32, nullptr, Wp_t, 2 * DM, rb * 32, kb * 64, scr, lane); continue; } r -= I_P;
            if (r < I_P) { const int kb = r >> 5, rb = r & 31; transpose_item(a.in[11], DM, kb * 64, rb * 32, nullptr, Wp_t, 2 * DM, rb * 32, DM + kb * 64, scr, lane); continue; } r -= I_P;
            if (r < I_P) { const int kb = r >> 5, rb = r & 31; transpose_item(a.in[12], DM, kb * 64, rb * 32, nullptr, Wout_t, DM, rb * 32, kb * 64, scr, lane); continue; } r -= I_P;
            if (r < I_GU) { const int kb = r / 176, rb = r % 176, pn = rb >> 3, sb = rb & 7;
                transpose_item(a.in[14], 2 * DFF, kb * 64, ((sb >> 2) ? DFF : 0) + 128 * pn + 32 * (sb & 3), a.in[13], Wgu_t, DM, rb * 32, kb * 64, scr, lane); continue; } r -= I_GU;
            { const int kb = r >> 5, rb = r & 31; transpose_item(a.in[15], DM, kb * 64, rb * 32, nullptr, Wdn_t, DFF, rb * 32, kb * 64, scr, lane); }
        }
        for (int m0 = gw * 4; m0 < MTOK; m0 += NGW * 4) {
            f32x4 v[4][4]; float s[4];
#pragma unroll
            for (int r = 0; r < 4; ++r) { const f32x4* xr = (const f32x4*)(x + (size_t)(m0 + r) * DM) + lane;
#pragma unroll
                for (int j = 0; j < 4; ++j) v[r][j] = __builtin_nontemporal_load(&xr[64 * j]); }
#pragma unroll
            for (int r = 0; r < 4; ++r) { s[r] = 0.f;
#pragma unroll
                for (int j = 0; j < 4; ++j) s[r] += (v[r][j][0] * v[r][j][0] + v[r][j][1] * v[r][j][1]) + (v[r][j][2] * v[r][j][2] + v[r][j][3] * v[r][j][3]);
                s[r] = wave_sum(s[r]); }
            if (lane < 4) rs1[m0 + lane] = __builtin_amdgcn_rsqf((lane == 0 ? s[0] : lane == 1 ? s[1] : lane == 2 ? s[2] : s[3]) * (1.f / DM) + NORM_EPS);
#pragma unroll
            for (int r = 0; r < 4; ++r) { unsigned long long* o8 = (unsigned long long*)(HB + (size_t)(m0 + r) * DM) + lane; const float rsr = __builtin_amdgcn_rsqf(s[r] * (1.f / DM) + NORM_EPS);
#pragma unroll
                for (int j = 0; j < 4; ++j) { const f32x4 q = v[r][j] * rsr; o8[64 * j] = (unsigned long long)pg8::cvt_pk_bf16(q[0], q[1]) | ((unsigned long long)pg8::cvt_pk_bf16(q[2], q[3]) << 32); } }
        }
        for (int job = bx; job < 256; job += G) {
            LAS float* hm = (LAS float*)L; LAS float* red = (LAS float*)(L + 65536);
            __syncthreads();
#pragma unroll
            for (int rr = 0; rr < 2; ++rr) { const int r = wave * 2 + rr; const f32x4* mr = (const f32x4*)(a.in[1] + (size_t)r * DM) + lane; f32x4 v[4]; float s = 0.f;
#pragma unroll
                for (int j = 0; j < 4; ++j) { v[j] = mr[64 * j]; s += (v[j][0] * v[j][0] + v[j][1] * v[j][1]) + (v[j][2] * v[j][2] + v[j][3] * v[j][3]); }
                const float rs = __builtin_amdgcn_rsqf(wave_sum(s) * (1.f / DM) + NORM_EPS);
#pragma unroll
                for (int j = 0; j < 4; ++j) { const f32x4 wv = ((const f32x4*)a.in[2])[lane + 64 * j];
#pragma unroll
                    for (int k = 0; k < 4; ++k) hm[(4 * lane + 256 * j + k) * 16 + r] = v[j][k] * rs * wv[k]; } }
            __syncthreads();
            const int col = tid & 15, ksp = tid >> 4, pcol = job * 16 + col, src = pcol < 2048 ? 1024 + pcol : 4096 + (pcol - 2048);
            float acc[16];
#pragma unroll
            for (int r = 0; r < 16; ++r) acc[r] = 0.f;
#pragma unroll 8
            for (int dd = 0; dd < 32; ++dd) { const int d = ksp * 32 + dd; const float wv = w_in[(size_t)d * INC + src];
                const f32x4 h0 = *(const LAS f32x4*)(hm + d * 16), h1 = *(const LAS f32x4*)(hm + d * 16 + 4), h2 = *(const LAS f32x4*)(hm + d * 16 + 8), h3 = *(const LAS f32x4*)(hm + d * 16 + 12);
#pragma unroll
                for (int k = 0; k < 4; ++k) { acc[k] += h0[k] * wv; acc[4 + k] += h1[k] * wv; acc[8 + k] += h2[k] * wv; acc[12 + k] += h3[k] * wv; } }
#pragma unroll
            for (int r = 0; r < 16; ++r) red[(ksp * 16 + r) * 16 + col] = acc[r];
            __syncthreads();
            if (tid < 256) { const int r = tid >> 4, c = tid & 15; float s = 0.f;
#pragma unroll 8
                for (int k = 0; k < 32; ++k) s += red[(k * 16 + r) * 16 + c];
                PM[r * 4096 + job * 16 + c] = s; }
        }
        __syncthreads();
    }
    GSYNC();
    const XcdBarrier xbar = xcd_barrier_post((unsigned*)(ws + WS_BAR), (volatile LAS unsigned*)(L + LDS_BARST));

    for (int rep_ = 0; rep_ < 1 + ((REPMASK >> 1) & 1); ++rep_) if ((PHMASK >> 1) & 1) {
        PIN_TID();
        for (int rm_ = 0; rm_ < 1 + ((REPMASK >> 8) & 1); ++rm_)
        for (int i = gtid; i < NB * 16 * 256; i += GT) { const int ch = i & 255, r = (i >> 8) & 15, b = i >> 12; const bool isv = ch >= 128; const int c = (ch & 127) * 8;
            f32x4 o0, o1;
            if (!isv) { const int d = c & 63, base = c - d, dl = d & 31; const float* plo = PM + r * 4096 + base + dl; const float* phi = plo + 32;
#pragma unroll
                for (int k = 0; k < 8; ++k) { float cs, sn; rope_cs((float)r, inv_freq(dl + k), cs, sn); const float xl = plo[k], xh = phi[k]; const float y = d < 32 ? xl * cs - xh * sn : xh * cs + xl * sn;
                    if (k < 4) o0[k] = y; else o1[k - 4] = y; }
            } else { o0 = *(const f32x4*)(PM + r * 4096 + 1024 + c); o1 = *(const f32x4*)(PM + r * 4096 + 1024 + c + 4); }
            *(v4u*)((isv ? VB : KB) + ((size_t)b * KROWS + r) * DM + c) = pack8(o0, o1); }
        pg8::Gemm g{HB, HB, Win_t, DM, DM, DM / 64}; pg8::StaticOrder S; S.init(MTOK, INC, G, bx);
        pg8::EpiInProj E{rs1, QO, KB, VB, CB, U, SGA, SGB};
        for (int rg_ = 0; rg_ < 1 + ((REPMASK >> 9) & 1); ++rg_)
        pg8::gemm_phase<pg8::EpiInProj, pg8::StaticOrder, true, true>(L, g, S, E);
    }
    XSYNC();

    for (int rep_ = 0; rep_ < 1 + ((REPMASK >> 2) & 1); ++rep_) if ((PHMASK >> 2) & 1) {
        PIN_TID();
        const float* cw = a.in[9]; bf16* OAp = (bf16*)a.out + (size_t)MTOK * DM; bf16* OBp = CB;
        float lam;
        { const float s1 = wave_sum(a.in[4][lane] * a.in[5][lane]), s2 = wave_sum(a.in[6][lane] * a.in[7][lane]); lam = __uint_as_float(__builtin_amdgcn_readfirstlane(__float_as_uint(expf(s1) - expf(s2) + LAMBDA_INIT))); }
        const float* subw = a.in[8];
        const int conv_grp = (bx >> 3) & 3, conv_before = conv_grp == 0 ? 0 : conv_grp == 1 ? 4 : conv_grp == 2 ? 6 : 7;
        for (int bh = vcu; bh < NB * 8; bh += G) { const int b = bh >> 3, hh = bh & 7;
            for (int qb = 0; qb < 8; ++qb) {
                if (bh == vcu && qb == conv_before) { int gt2 = gtid; asm volatile("" : "+v"(gt2));
                    for (int it = gt2; it < (MTOK / 16) * 128; it += GT) { const int ch = it & 127, rb = it >> 7, g0 = rb * 16, c = ch * 8;
                        const f32x4 w00 = *(const f32x4*)(cw + c), w01 = *(const f32x4*)(cw + c + 4), w10 = *(const f32x4*)(cw + DM + c), w11 = *(const f32x4*)(cw + DM + c + 4), w20 = *(const f32x4*)(cw + 2 * DM + c), w21 = *(const f32x4*)(cw + 2 * DM + c + 4);
                        f32x4 p0, p1, q0, q1;
                        if ((g0 & (SEQ - 1)) == 0) { const float* m14 = PM + 14 * 4096 + 2048 + c; const float* m15 = PM + 15 * 4096 + 2048 + c;
                            p0 = *(const f32x4*)m14 * *(const f32x4*)(m14 + 1024); p1 = *(const f32x4*)(m14 + 4) * *(const f32x4*)(m14 + 1028);
                            q0 = *(const f32x4*)m15 * *(const f32x4*)(m15 + 1024); q1 = *(const f32x4*)(m15 + 4) * *(const f32x4*)(m15 + 1028);
                        } else { unpack8(*(const v4u*)(U + (size_t)(g0 - 2) * DM + c), p0, p1); unpack8(*(const v4u*)(U + (size_t)(g0 - 1) * DM + c), q0, q1); }
#pragma unroll 4
                        for (int j = 0; j < 16; ++j) { const size_t off = (size_t)(g0 + j) * DM + c; f32x4 u0, u1, b0, b1; unpack8(__builtin_nontemporal_load((const v4u*)(U + off)), u0, u1); unpack8(__builtin_nontemporal_load((const v4u*)(CB + off)), b0, b1);
                            *(v4u*)(OBp + off) = pack8(b0 * (w00 * p0 + w10 * q0 + w20 * u0), b1 * (w01 * p1 + w11 * q1 + w21 * u1));
                            p0 = q0; p1 = q1; q0 = u0; q1 = u1; }
                    }
                }
                for (int m = 0; m < 2; ++m) {
                    const attn_body::bf16* Qw = (const attn_body::bf16*)QO + ((size_t)b * SEQ + qb * 256 + wave * 32) * DM + hh * 128 + m * 64;
                    const attn_body::bf16* Kh = (const attn_body::bf16*)KB + (size_t)b * KROWS * DM + hh * 128 + m * 64;
                    const attn_body::bf16* Vh = (const attn_body::bf16*)VB + (size_t)b * KROWS * DM + hh * 128;
                    const attn_body::bf16* Khn = (const attn_body::bf16*)KB + (size_t)b * KROWS * DM + hh * 128 + (1 - m) * 64;
                    attn_body::attn_pass<8>(Qw, Kh, Vh, 4 * qb + 5, m, lam, (char*)lds, Khn, !(qb == 7 && m == 1), !(qb == 0 && m == 0));
                }
                { int ln = lane; asm volatile("" : "+v"(ln)); const LAS unsigned char* Hw = L + attn_body::LDS_H + wave * 8192; const int row = ln >> 1, half = ln & 1; float s = 0.f;
#pragma unroll
                    for (int j = 0; j < 8; ++j) { const int chunk = half * 8 + j; f32x4 v0, v1; unpack8(*(const LAS v4u*)(Hw + row * 256 + ((chunk ^ (row & 15)) << 4)), v0, v1);
                        s += (v0[0] * v0[0] + v0[1] * v0[1]) + (v0[2] * v0[2] + v0[3] * v0[3]) + (v1[0] * v1[0] + v1[1] * v1[1]) + (v1[2] * v1[2] + v1[3] * v1[3]); }
                    s += __uint_as_float((unsigned)__builtin_amdgcn_mov_dpp((int)__float_as_uint(s), 0xB1, 0xF, 0xF, true));
                    const float rn = __builtin_amdgcn_rsqf(s * (1.f / 128.f) + NORM_EPS) * (1.f - LAMBDA_INIT);
                    bf16* Ow = OAp + ((size_t)b * SEQ + qb * 256 + wave * 32 + row) * DM + hh * 128 + half * 64;
#pragma unroll
                    for (int j = 0; j < 8; ++j) { const int chunk = half * 8 + j; f32x4 v0, v1; unpack8(*(const LAS v4u*)(Hw + row * 256 + ((chunk ^ (row & 15)) << 4)), v0, v1);
                        const f32x4 w0 = *(const f32x4*)(subw + chunk * 8), w1 = *(const f32x4*)(subw + chunk * 8 + 4);
                        *(v4u*)(Ow + j * 8) = pack8(v0 * w0 * rn, v1 * w1 * rn); }
                    asm volatile("s_waitcnt lgkmcnt(0)" ::: "memory");
                }
            }
        }
        asm volatile("s_waitcnt vmcnt(0)" ::: "memory"); __syncthreads();
    }
    XSYNC();

    for (int rep_ = 0; rep_ < 1 + ((REPMASK >> 3) & 1); ++rep_) if ((PHMASK >> 3) & 1) {
        pg8::Gemm g{(bf16*)a.out + (size_t)MTOK * DM, CB, Wp_t, DM, 2 * DM, DM / 64}; pg8::StaticOrder S; S.init(MTOK, DM, G, bx);
        pg8::EpiMerge E{SGA, SGB, MG};
        pg8::gemm_phase<pg8::EpiMerge, pg8::StaticOrder, true, true>(L, g, S, E);
    }
    XSYNC();
    for (int rep_ = 0; rep_ < 1 + ((REPMASK >> 4) & 1); ++rep_) if ((PHMASK >> 4) & 1) {
        pg8::Gemm g{MG, MG, Wout_t, DM, DM, DM / 64}; pg8::StaticOrder S; S.init(MTOK, DM, G, bx);
        pg8::EpiResid<true> E{HB, H2B, ss2, rs1};
        pg8::gemm_phase<pg8::EpiResid<true>, pg8::StaticOrder, true, true>(L, g, S, E);
    }
    XSYNC();
    for (int rep_ = 0; rep_ < 1 + ((REPMASK >> 5) & 1); ++rep_) if ((PHMASK >> 5) & 1) {
        pg8::Gemm g{H2B, H2B, Wgu_t, DM, DM, DM / 64}; pg8::StaticOrder S; S.init(MTOK, 2 * DFF, G, bx);
        pg8::EpiGateUp E{ss2, ACT};
        pg8::gemm_phase<pg8::EpiGateUp, pg8::StaticOrder, true, true>(L, g, S, E);
    }
    XSYNC();
    for (int rep_ = 0; rep_ < 1 + ((REPMASK >> 6) & 1); ++rep_) if ((PHMASK >> 6) & 1) {
        pg8::Gemm g{ACT, ACT, Wdn_t, DFF, DFF, DFF / 64}; pg8::StaticOrder S; S.init(MTOK, DM, G, bx);
        pg8::EpiResid<true> E{H2B, H3B, ss3, nullptr};
        pg8::gemm_phase<pg8::EpiResid<true>, pg8::StaticOrder, true, true>(L, g, S, E);
    }
    XSYNC();
    for (int rep_ = 0; rep_ < 1 + ((REPMASK >> 7) & 1); ++rep_) if ((PHMASK >> 7) & 1) {
        PIN_TID();
        const int gw = vcu * 8 + wave, NGW = G * 8; const float* wf = a.in[16];
        f32x4 wv[4];
#pragma unroll
        for (int j = 0; j < 4; ++j) wv[j] = ((const f32x4*)wf)[lane + 64 * j];
        for (int m0 = gw * 4; m0 < MTOK; m0 += NGW * 4) {
            unsigned long long w[4][4]; float r3[4];
#pragma unroll
            for (int r = 0; r < 4; ++r) { const unsigned long long* i8 = (const unsigned long long*)(H3B + (size_t)(m0 + r) * DM) + lane; r3[r] = ss3[m0 + r];
#pragma unroll
                for (int j = 0; j < 4; ++j) w[r][j] = __builtin_nontemporal_load(&i8[64 * j]); }
#pragma unroll
            for (int r = 0; r < 4; ++r) { f32x4* orow = (f32x4*)(a.out + (size_t)(m0 + r) * DM) + lane; const float rr = __builtin_amdgcn_rsqf(r3[r] * (1.f / DM) + NORM_EPS);
#pragma unroll
                for (int j = 0; j < 4; ++j) { const unsigned lo = (unsigned)w[r][j], hi = (unsigned)(w[r][j] >> 32);
                    __builtin_nontemporal_store((f32x4){bf_lo(lo), bf_hi(lo), bf_lo(hi), bf_hi(hi)} * wv[j] * rr, &orow[64 * j]); } }
        }
    }
#undef GSYNC
#undef XSYNC
}
#undef Win_t
#undef Wp_t
#undef Wout_t
#undef Wgu_t
#undef Wdn_t
#undef QO
#undef CB
#undef U
#undef SGA
#undef SGB
#undef KB
#undef VB
#undef MG
#undef H2B
#undef ACT
#undef H3B
#undef ss2
#undef ss3
#undef rs1
#undef PM

extern "C" void kernel_launch(void* const* d_in, const int* in_sizes, int n_in, void* d_out, int out_size, void* d_ws, size_t ws_size, hipStream_t stream) {
    static int grid = 0;
    if (grid == 0) {
        if (n_in != 17 || in_sizes[0] != MTOK * DM || out_size != MTOK * DM || ws_size < WS_END) { fprintf(stderr, "kernel_launch: unexpected shapes / workspace (n_in %d, ws %zu)\n", n_in, ws_size); grid = -1; return; }
        int dev = 0, cus = 0, per_cu = 0;
        if (hipGetDevice(&dev) != hipSuccess || hipDeviceGetAttribute(&cus, hipDeviceAttributeMultiprocessorCount, dev) != hipSuccess) { grid = -1; return; }
        if (hipFuncSetAttribute((const void*)fwd_kernel, hipFuncAttributeMaxDynamicSharedMemorySize, LDS_BYTES) != hipSuccess) { fprintf(stderr, "kernel_launch: hipFuncSetAttribute failed\n"); grid = -1; return; }
        if (hipOccupancyMaxActiveBlocksPerMultiprocessor(&per_cu, (const void*)fwd_kernel, 512, LDS_BYTES) != hipSuccess || per_cu < 1) per_cu = 1;
        (void)hipGetLastError();
        grid = cus * per_cu;
    }
    if (grid < 0) return;
    Args a{};
    for (int i = 0; i < 17; ++i) a.in[i] = (const float*)d_in[i];
    a.out = (float*)d_out; a.ws = (unsigned char*)d_ws;
    void* args[] = {&a};
    hipError_t e = hipLaunchCooperativeKernel((const void*)fwd_kernel, dim3(grid), dim3(512), args, LDS_BYTES, stream);
    if (e != hipSuccess) fprintf(stderr, "kernel_launch: cooperative launch failed: %s (grid %d)\n", hipGetErrorString(e), grid);
}
```

```cpp
#include <hip/hip_runtime.h>
#include <hip/hip_cooperative_groups.h>
#include <hip/hip_bf16.h>
#include <cstdio>
#include <cstdint>
#include <cmath>
namespace pg8 {
#define PG8_LAS __attribute__((address_space(3)))
typedef unsigned short bf16_t;
typedef short bf16x8 __attribute__((ext_vector_type(8)));
typedef float f32x4 __attribute__((ext_vector_type(4)));
typedef unsigned u32x4 __attribute__((ext_vector_type(4)));
constexpr int BM = 256, BK = 64, HALF = 128, HTB = HALF * BK * 2  , STAGE_BYTES = 8 * HTB, NXCD = 8, WGM = 8;

__host__ __device__ __forceinline__ int lds_byte(int r, int c) { const int st = (r >> 4) * 2 + (c >> 5), rr = r & 15, cc = c & 31, ob = rr * 64 + cc * 2; return st * 1024 + (ob ^ (((ob >> 9) & 1) << 5)); }
__host__ __device__ __forceinline__ void stage_rc(int b, int& R, int& C) { const int st = b / 1024, sb = b % 1024, swz = sb ^ (((sb >> 9) & 1) << 5); R = (st >> 1) * 16 + swz / 64; C = (st & 1) * 32 + (swz % 64) / 2; }
__host__ __device__ __forceinline__ int perm32(int rho) { const int n = rho >> 4, i = rho & 15; return 8 * (i >> 2) + 4 * n + (i & 3); }

struct Unit { int pm, pn; };
struct Gemm { const bf16_t* A; const bf16_t* A2; const bf16_t* Bt; int lda, K, ks; };

struct StaticOrder {
    int nM, nN, nwg, G, c;
    __host__ __device__ void init(int M, int N, int G_, int c_) { nM = M / BM; nN = N / BM; nwg = nM * nN; G = G_; c = c_; }
    __host__ __device__ bool next(int i, Unit& u) const {
        const long L = (long)i * G + c; if (L >= nwg) return false;
        int wgid = (int)L; { const int q = nwg / NXCD, r = nwg % NXCD, xcd = wgid % NXCD, off = wgid / NXCD; wgid = (xcd < r ? xcd * (q + 1) : r * (q + 1) + (xcd - r) * q) + off; }
        const int nig = WGM * nN, gid = wgid / nig, fm = gid * WGM, gsz = (nM - fm) < WGM ? (nM - fm) : WGM;
        u.pm = fm + ((wgid % nig) % gsz); u.pn = (wgid % nig) / gsz; return true;
    }
    __device__ __forceinline__ void a_ready(const Unit&) const {}
    __device__ __forceinline__ void done(const Unit&) const {}
};

typedef float cvt_f32x2_t __attribute__((ext_vector_type(2))); typedef __bf16 cvt_bf16x2_t __attribute__((ext_vector_type(2)));
__device__ __forceinline__ unsigned cvt_pk_bf16(float lo, float hi) { const cvt_f32x2_t v = {lo, hi}; const cvt_bf16x2_t b = __builtin_convertvector(v, cvt_bf16x2_t); return __builtin_bit_cast(unsigned, b); }
template <class Epi, class Sched, bool ALIGN_EPI = false, bool SP2 = false>
__device__ __forceinline__ void gemm_phase(PG8_LAS unsigned char* lds, const Gemm g, const Sched& S, const Epi& E) {
    int tid_ = threadIdx.x; asm volatile("" : "+v"(tid_));
    const int tid = tid_, wid = __builtin_amdgcn_readfirstlane(tid >> 6), lane = tid & 63, wr = wid >> 2, wc = wid & 3, fr = lane & 15, fq = lane >> 4;
    const int K = g.K, nt = K / BK, ks = g.ks, lda = g.lda;
    unsigned voffA[2], voffB[2];
#pragma unroll
    for (int i = 0; i < 2; ++i) { int R, C; stage_rc(tid * 16 + i * 8192, R, C); const int Rb = Epi::PERM ? ((R & ~31) + perm32(R & 31)) : R;
        voffA[i] = (unsigned)(R * lda + C) * 2u; voffB[i] = (unsigned)(Rb * K + C) * 2u; }
    const size_t kstep = (size_t)(BK * 2);
    const size_t hstepA = (size_t)HALF * lda * 2, hstepB = (size_t)HALF * K * 2;
    const size_t tstepA = 2 * hstepA, tstepB = 2 * hstepB;
    const unsigned ldsw = (unsigned)wid * 1024u;
    const int aoff = lds_byte(wr * 64 + fr, fq * 8), boff = lds_byte(wc * 32 + fr, fq * 8);
#define PG8_SA(b, h) (((b) * 2 + (h)) * HTB)
#define PG8_SB(b, h) ((4 + (b) * 2 + (h)) * HTB)
#define PG8_STAGE(bufoff, gbase, voff) do { _Pragma("unroll") for (int _i = 0; _i < 2; ++_i) \
        __builtin_amdgcn_global_load_lds((const unsigned*)((const char*)(gbase) + (voff)[_i]), (PG8_LAS unsigned*)(lds + (bufoff) + ldsw + _i * 8192), 16, 0, 0); } while (0)
#define PG8_LDA(dst, b, h) do { _Pragma("unroll") for (int m = 0; m < 4; ++m) _Pragma("unroll") for (int k = 0; k < 2; ++k) dst[m][k] = *(const PG8_LAS bf16x8*)(lds + PG8_SA(b, h) + aoff + m * 2048 + k * 1024); } while (0)
#define PG8_LDB(dst, b, h) do { _Pragma("unroll") for (int n = 0; n < 2; ++n) _Pragma("unroll") for (int k = 0; k < 2; ++k) dst[n][k] = *(const PG8_LAS bf16x8*)(lds + PG8_SB(b, h) + boff + n * 2048 + k * 1024); } while (0)
#define PG8_MMA(ai, bj, At, Bt) do { __builtin_amdgcn_s_setprio(1); _Pragma("unroll") for (int m = 0; m < 4; ++m) _Pragma("unroll") for (int n = 0; n < 2; ++n) _Pragma("unroll") for (int k = 0; k < 2; ++k) \
        acc[ai][bj][m][n] = __builtin_amdgcn_mfma_f32_16x16x32_bf16(Bt[n][k], At[m][k], acc[ai][bj][m][n], 0, 0, 0); __builtin_amdgcn_s_setprio(0); } while (0)
#define PG8_WAIT_V(n) asm volatile("s_waitcnt vmcnt(" #n ")" ::: "memory")
#define PG8_WAIT_L(n) asm volatile("s_waitcnt lgkmcnt(" #n ")" ::: "memory")
#define PG8_BAR __builtin_amdgcn_s_barrier()
#define PG8_SCHED __builtin_amdgcn_sched_barrier(0)
    Unit cur, nxt; int ui = 0;
    if (!S.next(0, cur)) return;
    f32x4 acc[2][2][4][2];
#pragma unroll
    for (int a = 0; a < 2; ++a)
#pragma unroll
        for (int b = 0; b < 2; ++b)
#pragma unroll
            for (int m = 0; m < 4; ++m)
#pragma unroll
                for (int n = 0; n < 2; ++n) acc[a][b][m][n] = (f32x4){0.f, 0.f, 0.f, 0.f};
    bf16x8 At[4][2], B0[2][2], B1[2][2];
    const char* cA = (const char*)g.A + (size_t)cur.pm * tstepA; const char* cA2 = (const char*)g.A2 + (size_t)cur.pm * tstepA; const char* cB = (const char*)g.Bt + (size_t)cur.pn * tstepB;
    S.a_ready(cur);
    if constexpr (SP2) {
        PG8_STAGE(PG8_SB(0, 0), cB, voffB); PG8_STAGE(PG8_SB(0, 1), cB + hstepB, voffB); PG8_STAGE(PG8_SA(0, 0), cA, voffA); PG8_STAGE(PG8_SA(0, 1), cA + hstepA, voffA);
        if (wr == 1) PG8_BAR;
        PG8_WAIT_V(2); PG8_BAR;
        PG8_STAGE(PG8_SB(1, 0), cB + kstep, voffB); PG8_STAGE(PG8_SA(1, 0), cA + kstep, voffA); PG8_STAGE(PG8_SB(1, 1), cB + hstepB + kstep, voffB);
        PG8_WAIT_V(6); PG8_BAR;
    } else {
        PG8_STAGE(PG8_SB(0, 0), cB, voffB); PG8_STAGE(PG8_SA(0, 0), cA, voffA); PG8_STAGE(PG8_SB(0, 1), cB + hstepB, voffB); PG8_STAGE(PG8_SA(0, 1), cA + hstepA, voffA);
        if (wr == 1) PG8_BAR;
        PG8_WAIT_V(4); PG8_BAR;
        PG8_STAGE(PG8_SB(1, 0), cB + kstep, voffB); PG8_STAGE(PG8_SA(1, 0), cA + kstep, voffA); PG8_STAGE(PG8_SB(1, 1), cB + hstepB + kstep, voffB);
        PG8_WAIT_V(6); PG8_BAR;
    }
    for (;;) {
        const bool has_next = S.next(ui + 1, nxt);
        const char* nA = has_next ? (const char*)g.A + (size_t)nxt.pm * tstepA : cA; const char* nA2 = has_next ? (const char*)g.A2 + (size_t)nxt.pm * tstepA : cA2; const char* nB = has_next ? (const char*)g.Bt + (size_t)nxt.pn * tstepB : cB;
        for (int t = 0; t < nt; t += 2) {
            const bool last = (t == nt - 2);
#define PG8_ATILE(tt) ((tt) < ks ? cA + (size_t)(tt) * kstep : cA2 + (size_t)((tt) - ks) * kstep)
            if constexpr (Epi::MID) { if (t == ks) E.mid(acc, cur, wr, wc, fr, fq); }
            const char* a1 = PG8_ATILE(t + 1);
            const char* a2 = last ? nA : PG8_ATILE(t + 2); const char* b2 = last ? nB : cB + (size_t)(t + 2) * kstep;
            const char* a3 = last ? nA + kstep : PG8_ATILE(t + 3); const char* b3 = b2 + kstep;
            if (last && has_next) S.a_ready(nxt);
            if constexpr (SP2) {
            PG8_LDB(B0, 0, 0); PG8_LDB(B1, 0, 1); PG8_SCHED; PG8_LDA(At, 0, 0); PG8_STAGE(PG8_SA(1, 1), a1 + hstepA, voffA);
            PG8_WAIT_V(8); PG8_WAIT_L(0); PG8_BAR; PG8_MMA(0, 0, At, B0); PG8_MMA(0, 1, At, B1); PG8_BAR; PG8_SCHED;
            PG8_LDA(At, 0, 1); PG8_STAGE(PG8_SB(0, 0), b2, voffB); PG8_STAGE(PG8_SB(0, 1), b2 + hstepB, voffB); PG8_STAGE(PG8_SA(0, 0), a2, voffA);
            PG8_WAIT_V(8); PG8_WAIT_L(0); PG8_BAR; PG8_MMA(1, 0, At, B0); PG8_MMA(1, 1, At, B1); PG8_BAR; PG8_SCHED;
            PG8_LDB(B0, 1, 0); PG8_LDB(B1, 1, 1); PG8_SCHED; PG8_LDA(At, 1, 0); PG8_STAGE(PG8_SA(0, 1), a2 + hstepA, voffA);
            PG8_WAIT_V(8); PG8_WAIT_L(0); PG8_BAR; PG8_MMA(0, 0, At, B0); PG8_MMA(0, 1, At, B1); PG8_BAR; PG8_SCHED;
            PG8_LDA(At, 1, 1); PG8_STAGE(PG8_SB(1, 0), b3, voffB); PG8_STAGE(PG8_SB(1, 1), b3 + hstepB, voffB); PG8_STAGE(PG8_SA(1, 0), a3, voffA);
            PG8_WAIT_V(8); PG8_WAIT_L(0); PG8_BAR; PG8_MMA(1, 0, At, B0); PG8_MMA(1, 1, At, B1); PG8_BAR; PG8_SCHED;
            } else {
            PG8_LDB(B0, 0, 0); PG8_SCHED; PG8_LDA(At, 0, 0); PG8_STAGE(PG8_SA(1, 1), a1 + hstepA, voffA);
            PG8_WAIT_L(8); PG8_BAR; PG8_WAIT_L(0); PG8_MMA(0, 0, At, B0); PG8_BAR; PG8_SCHED;
            PG8_LDB(B1, 0, 1); PG8_STAGE(PG8_SB(0, 0), b2, voffB);
            PG8_BAR; PG8_WAIT_L(0); PG8_MMA(0, 1, At, B1); PG8_BAR;
            PG8_LDA(At, 0, 1); PG8_STAGE(PG8_SA(0, 0), a2, voffA);
            PG8_BAR; PG8_WAIT_L(0); PG8_MMA(1, 0, At, B0); PG8_BAR; PG8_SCHED;
            PG8_STAGE(PG8_SB(0, 1), b2 + hstepB, voffB);
            PG8_WAIT_V(6); PG8_BAR; PG8_MMA(1, 1, At, B1); PG8_BAR;
            PG8_LDB(B0, 1, 0); PG8_SCHED; PG8_LDA(At, 1, 0); PG8_STAGE(PG8_SA(0, 1), a2 + hstepA, voffA);
            PG8_WAIT_L(8); PG8_BAR; PG8_WAIT_L(0); PG8_MMA(0, 0, At, B0); PG8_BAR; PG8_SCHED;
            PG8_LDB(B1, 1, 1); PG8_STAGE(PG8_SB(1, 0), b3, voffB);
            PG8_BAR; PG8_WAIT_L(0); PG8_MMA(0, 1, At, B1); PG8_BAR;
            PG8_LDA(At, 1, 1); PG8_STAGE(PG8_SA(1, 0), a3, voffA);
            PG8_BAR; PG8_WAIT_L(0); PG8_MMA(1, 0, At, B0); PG8_BAR; PG8_SCHED;
            PG8_STAGE(PG8_SB(1, 1), b3 + hstepB, voffB);
            PG8_WAIT_V(6); PG8_BAR; PG8_MMA(1, 1, At, B1); PG8_BAR;
            }
        }
        if constexpr (ALIGN_EPI) { if (wr == 0) PG8_BAR; }
        if constexpr (!Epi::AFTER_DRAIN) { E(acc, cur, wr, wc, fr, fq); S.done(cur); }
        if (!has_next) break;
#pragma unroll
        for (int a = 0; a < 2; ++a)
#pragma unroll
            for (int b = 0; b < 2; ++b)
#pragma unroll
                for (int m = 0; m < 4; ++m)
#pragma unroll
                    for (int n = 0; n < 2; ++n) acc[a][b][m][n] = (f32x4){0.f, 0.f, 0.f, 0.f};
        cur = nxt; cA = nA; cA2 = nA2; cB = nB; ++ui;
        if constexpr (ALIGN_EPI) { if (wr == 1) PG8_BAR; }
    }
    PG8_WAIT_V(0);
    if constexpr (!ALIGN_EPI) { if (wr == 0) PG8_BAR; }
    PG8_BAR;
    if constexpr (Epi::AFTER_DRAIN) { E.fused(acc, cur, wr, wc, fr, fq, lds, wid, lane); S.done(cur); }
#undef PG8_SA
#undef PG8_ATILE
#undef PG8_SB
#undef PG8_STAGE
#undef PG8_LDA
#undef PG8_LDB
#undef PG8_MMA
#undef PG8_WAIT_V
#undef PG8_WAIT_L
#undef PG8_BAR
#undef PG8_SCHED
}
}

namespace attn_body {
using bf16=__hip_bfloat16;
using bf16x8=__attribute__((ext_vector_type(8)))short;
using s16x4=__attribute__((ext_vector_type(4)))short;
using f32x16=__attribute__((ext_vector_type(16)))float;
using u32x4=__attribute__((ext_vector_type(4)))unsigned;
constexpr int D=64,DM=1024;
constexpr int NW=8,QBLK=32,QB=QBLK*NW,KVBLK=64;
constexpr int ATTN_PITCH=DM, ATTN_UNIT_ROWS=QB;
__device__ __forceinline__ int crow(int r,int hi){return (r&3)+8*(r>>2)+4*hi;}
#define SBAR() __builtin_amdgcn_sched_barrier(0)
__device__ __forceinline__ void cmask(f32x16&p0,f32x16&p1,int jb,int qrel,int hi){
  const float NEG=-INFINITY; int kb=64*jb+4*hi;
  #pragma unroll
  for(int r=0;r<16;++r){int kv=kb+(r&3)+8*(r>>2); if(kv>qrel)p0[r]=NEG; if(kv+32>qrel)p1[r]=NEG;}
}

constexpr int NSLOT=3, SLOTB=8192;
constexpr int LDS_K=0, LDS_V=NSLOT*SLOTB, LDS_WS=LDS_V+2*NSLOT*SLOTB, LDS_H=LDS_WS+NW*64*4, LDS_BYTES=LDS_H+NW*8192;
constexpr float C2=0.125f*1.4426950408889634f;
__device__ __forceinline__ void glds16(const void*gsrc,unsigned lds_dst){unsigned keep;
  asm volatile("s_mov_b32 %0, m0\n\ts_mov_b32 m0, %2\n\ts_nop 0\n\tglobal_load_lds_dwordx4 %1, off\n\ts_mov_b32 m0, %0":"=&s"(keep):"v"(gsrc),"s"(lds_dst):"memory");}
__device__ __forceinline__ void glds16s(const void*sbase,unsigned voff,unsigned lds_dst){unsigned keep;
  asm volatile("s_nop 4\n\ts_mov_b32 %0, m0\n\ts_mov_b32 m0, %2\n\ts_nop 0\n\tglobal_load_lds_dwordx4 %1, %3\n\ts_mov_b32 m0, %0":"=&s"(keep):"v"(voff),"s"(lds_dst),"s"(sbase):"memory");}
__device__ __forceinline__ float max3f(float a,float b,float c){float r;asm("v_max3_f32 %0, %1, %2, %3":"=v"(r):"v"(a),"v"(b),"v"(c));return r;}
__device__ __forceinline__ float max2f(float a,float b){float r;asm("v_max_f32_e32 %0, %1, %2":"=v"(r):"v"(a),"v"(b));return r;}
__device__ __forceinline__ float fadd_s(float a,float b){float r;asm("v_add_f32_e32 %0, %1, %2":"=v"(r):"v"(a),"v"(b));return r;}
__device__ __forceinline__ float fsub_s(float a,float b){float r;asm("v_sub_f32_e32 %0, %1, %2":"=v"(r):"v"(a),"v"(b));return r;}
typedef float f32x2_t __attribute__((ext_vector_type(2))); typedef __bf16 bf16x2_t __attribute__((ext_vector_type(2)));
__device__ __forceinline__ unsigned cvtpk_s(float lo,float hi){f32x2_t v={lo,hi};bf16x2_t b=__builtin_convertvector(v,bf16x2_t);return __builtin_bit_cast(unsigned,b);}
#define WAIT_BAR(N) asm volatile("s_waitcnt vmcnt(" #N ") lgkmcnt(0)\n\ts_barrier":::"memory")

__device__ __forceinline__ void qkt(f32x16&p0,f32x16&p1,const char*Kslot,const bf16x8*qr,int r32,int hi){ const f32x16 zc=f32x16{};
  const char*kb=Kslot+hi*1024+r32*16;
  #pragma unroll
  for(int d0=0;d0<4;++d0){
    const bf16x8 b0=*reinterpret_cast<const bf16x8*>(kb+d0*2048);
    const bf16x8 b1=*reinterpret_cast<const bf16x8*>(kb+d0*2048+512);
    if(d0==0){p0=__builtin_amdgcn_mfma_f32_32x32x16_bf16(b0,qr[0],zc,0,0,0);p1=__builtin_amdgcn_mfma_f32_32x32x16_bf16(b1,qr[0],zc,0,0,0);}
    else{p0=__builtin_amdgcn_mfma_f32_32x32x16_bf16(b0,qr[d0],p0,0,0,0);p1=__builtin_amdgcn_mfma_f32_32x32x16_bf16(b1,qr[d0],p1,0,0,0);}}
}
typedef __attribute__((address_space(3))) const char* lds_cptr;
typedef short v4i16_t __attribute__((ext_vector_type(4)));
__device__ __forceinline__ void kload8(bf16x8*kf,lds_cptr kp){
  kf[0]=*(const __attribute__((address_space(3))) bf16x8*)(kp);      kf[1]=*(const __attribute__((address_space(3))) bf16x8*)(kp+512);
  kf[2]=*(const __attribute__((address_space(3))) bf16x8*)(kp+2048); kf[3]=*(const __attribute__((address_space(3))) bf16x8*)(kp+2560);
  kf[4]=*(const __attribute__((address_space(3))) bf16x8*)(kp+4096); kf[5]=*(const __attribute__((address_space(3))) bf16x8*)(kp+4608);
  kf[6]=*(const __attribute__((address_space(3))) bf16x8*)(kp+6144); kf[7]=*(const __attribute__((address_space(3))) bf16x8*)(kp+6656);
}
__device__ __forceinline__ void kload2(bf16x8*kf,lds_cptr kp,int j){ kf[2*j]=*(const __attribute__((address_space(3))) bf16x8*)(kp+j*2048); kf[2*j+1]=*(const __attribute__((address_space(3))) bf16x8*)(kp+j*2048+512); }
__device__ __forceinline__ s16x4 vtr(lds_cptr p){ return __builtin_bit_cast(s16x4,__builtin_amdgcn_ds_read_tr16_b64_v4i16((__attribute__((address_space(3))) v4i16_t*)p)); }
__device__ __forceinline__ float rowmax(const f32x16&p0,const f32x16&p1){
  float a=max3f(p0[0],p0[1],p1[0]),b=max3f(p0[2],p0[3],p1[1]);a=max3f(a,p1[2],p1[3]);
  #pragma unroll
  for(int r=4;r<16;r+=4){a=max3f(a,p0[r],p0[r+1]);b=max3f(b,p0[r+2],p0[r+3]);a=max3f(a,p1[r],p1[r+1]);b=max3f(b,p1[r+2],p1[r+3]);}
  const float m=max2f(a,b);
  auto rr=__builtin_amdgcn_permlane32_swap(__float_as_uint(m),__float_as_uint(m),false,false);
  return max2f(__uint_as_float(rr[0]),__uint_as_float(rr[1]));
}
__device__ __forceinline__ void pv(f32x16*o,int vb,bf16x8 pa0,bf16x8 pa1,bf16x8 pa2,bf16x8 pa3){
  #pragma unroll
  for(int d0=0;d0<2;++d0){s16x4 lo[4],hi[4];
    #pragma unroll
    for(int ks=0;ks<4;++ks){
      asm volatile("ds_read_b64_tr_b16 %0,%1 offset:%c2":"=&v"(lo[ks]):"v"(vb),"i"(d0*4096+ks*1024):"memory");
      asm volatile("ds_read_b64_tr_b16 %0,%1 offset:%c2":"=&v"(hi[ks]):"v"(vb),"i"(d0*4096+ks*1024+512):"memory");}
    asm volatile("s_waitcnt lgkmcnt(0)":::"memory");SBAR();
    #define PK(k) (bf16x8){lo[k][0],lo[k][1],lo[k][2],lo[k][3],hi[k][0],hi[k][1],hi[k][2],hi[k][3]}
    o[d0]=__builtin_amdgcn_mfma_f32_32x32x16_bf16(pa0,PK(0),o[d0],0,0,0);
    o[d0]=__builtin_amdgcn_mfma_f32_32x32x16_bf16(pa1,PK(1),o[d0],0,0,0);
    o[d0]=__builtin_amdgcn_mfma_f32_32x32x16_bf16(pa2,PK(2),o[d0],0,0,0);
    o[d0]=__builtin_amdgcn_mfma_f32_32x32x16_bf16(pa3,PK(3),o[d0],0,0,0);
    #undef PK
  }
}

#ifndef ATTN_STORE16
#define ATTN_STORE16(p,v) (*(u32x4*)(p)=(v))
#endif
template<int THRL> __device__ __forceinline__ void attn_pass(const bf16*Qw,const bf16*__restrict__ Kh,const bf16*__restrict__ Vh,int NT,int m_sub,float lam,char*shm,const bf16*Kh_next,bool has_next,bool prefetched){
  const int tid=threadIdx.x; int lane_=tid&63; asm volatile("":"+v"(lane_));
  const int lane=lane_,r32=lane&31,hi=lane>>5; const int wid=__builtin_amdgcn_readfirstlane(tid>>6);
  if(wid>=4)__builtin_amdgcn_s_setprio(1);
  const unsigned lds0=(unsigned)(uintptr_t)shm;
  float*wsf=(float*)(shm+LDS_WS)+wid*64;
  const bf16*ksrc=Kh+wid*8; const unsigned koff=(unsigned)lane*(DM*2);
  const bf16*vsrc=Vh+(long)(16*(wid&3))*DM+(wid>>2)*32; const unsigned voff=(unsigned)(lane>>2)*(DM*2)+(unsigned)(lane&3)*16;
  const unsigned kdst=lds0+LDS_K+wid*1024, vdst=lds0+LDS_V+wid*1024;
  #define DMA_K(t,slot) glds16s(ksrc+(long)(t)*KVBLK*DM,koff,(unsigned)__builtin_amdgcn_readfirstlane(kdst+(slot)))
  #define DMA_V(t,slot) do{ glds16s(vsrc+(long)(t)*KVBLK*DM,voff,(unsigned)__builtin_amdgcn_readfirstlane(vdst+2*(slot))); glds16s(vsrc+(long)(t)*KVBLK*DM+64,voff,(unsigned)__builtin_amdgcn_readfirstlane(vdst+2*(slot)+8192)); }while(0)
  const int vb0=(int)(lds0+LDS_V)+((lane>>4)&1)*32+(lane&3)*8+(4*hi+((lane&15)>>2))*64;
  const char*Kbase=shm+LDS_K; bf16x8 kf[8];
  const lds_cptr shm3=(lds_cptr)shm; const lds_cptr kp0=shm3+LDS_K+hi*1024+r32*16; const lds_cptr vp0=shm3+LDS_V+((lane>>4)&1)*32+(lane&3)*8+(4*hi+((lane&15)>>2))*64;
  if(!prefetched){DMA_K(0,0);DMA_V(0,0);DMA_K(1,SLOTB);}
  bf16x8 qr[4];
  #pragma unroll
  for(int d0=0;d0<4;++d0)qr[d0]=*reinterpret_cast<const bf16x8*>(&Qw[(long)r32*DM+d0*16+hi*8]);
  float mhat=0.f,l_reg=0.f;f32x16 o[4]; { float z_; asm volatile("v_mov_b32 %0, 0":"=v"(z_)); _Pragma("unroll") for(int r=0;r<16;++r){o[0][r]=z_;o[1][r]=z_;o[2][r]=z_;o[3][r]=z_;} }
  const int qrel=wid*QBLK+r32;
  #define CMASK(P0,P1,t) do{int jb_=(t)-(NT-4); if(jb_>=0)cmask(P0,P1,jb_,qrel,hi);}while(0)
  bool resc=false;
  #define START(P0,P1) do{ const float rm=rowmax(P0,P1); resc=false; \
    { const float dl=rm; mhat=fadd_s(mhat,dl); \
      _Pragma("unroll") for(int r=0;r<16;++r){P0[r]=fsub_s(P0[r],dl);P1[r]=fsub_s(P1[r],dl);} \
      } \
    _Pragma("unroll") for(int r=0;r<16;++r)P0[r]=__builtin_amdgcn_exp2f(P0[r]); }while(0)
  #define RESC() do{ if(resc){ asm volatile("s_waitcnt lgkmcnt(0)":::"memory"); \
      _Pragma("unroll") for(int d_=0;d_<4;++d_) _Pragma("unroll") for(int r=0;r<16;++r)o[d_][r]*=wsf[crow(r,hi)]; } }while(0)
  f32x16 pA0,pA1,pB0,pB1;
  int sl_prev=0,sl_cur=0,sl_next=SLOTB;
  #define ROT() do{sl_prev=sl_cur;sl_cur=sl_next;sl_next=(sl_next==(NSLOT-1)*SLOTB)?0:sl_next+SLOTB;}while(0)
  DMA_K(2,2*SLOTB);
  WAIT_BAR(4);
  qkt(pA0,pA1,Kbase,qr,r32,hi);asm volatile("s_nop 15\n\ts_nop 7":"+v"(pA0),"+v"(pA1));
  { _Pragma("unroll") for(int r=8;r<16;++r)pA0[r]=-INFINITY; _Pragma("unroll") for(int r=0;r<16;++r)pA1[r]=-INFINITY; }
  START(pA0,pA1);
  _Pragma("unroll") for(int r=0;r<16;++r)pA1[r]=__builtin_amdgcn_exp2f(pA1[r]);
  WAIT_BAR(0);
  DMA_K(3,0);DMA_V(1,SLOTB);
  ROT();
  kload8(kf,kp0+sl_cur);
  WAIT_BAR(3);
  s16x4 vlo[8],vhi[8]; u32x4 pw0,pw1,pw2,pw3;
  #define PKW(P,B) cvtpk_s(P[B],P[B+1])
  #define PAF(k) __builtin_bit_cast(bf16x8,pw##k)
  #define VFR(i) (bf16x8){vlo[i][0],vlo[i][1],vlo[i][2],vlo[i][3],vhi[i][0],vhi[i][1],vhi[i][2],vhi[i][3]}
  #define PIN(x) asm volatile("":"+v"(x))
  #define MX3(a,b,c) __builtin_fmaxf(__builtin_fmaxf((a),(b)),(c))
  #define GAPA(MF,A0,A1,A2,A3,W0,W1,PW) do{ MF; sacc+=A0; sacc+=A1; sacc+=A2; sacc+=A3; PIN(sacc); W0; W1; PIN(PW); SBAR(); }while(0)
  #define EX(v) __builtin_amdgcn_exp2f(v)
  #define GAPB(MF,X,B) do{ MF; X[B]=EX(X[B]); X[B+1]=EX(X[B+1]); X[B+2]=EX(X[B+2]); X[B+3]=EX(X[B+3]); PIN(X); SBAR(); }while(0)
  #define GAPB2(MF,RD,X,B) do{ MF; RD; X[B]=EX(X[B]); X[B+1]=EX(X[B+1]); PIN(X); SBAR(); }while(0)
  #define VRD2(i) do{ vlo[i]=vtr(vp2_+(((i)>>2)*4096+((i)&3)*1024)); vhi[i]=vtr(vp2_+(((i)>>2)*4096+((i)&3)*1024+512)); }while(0)
  #define VRD(i) do{ vlo[i]=vtr(vp_+(((i)>>2)*4096+((i)&3)*1024)); vhi[i]=vtr(vp_+(((i)>>2)*4096+((i)&3)*1024+512)); }while(0)
  #define KRD(G,j) do{ if(G){ kload2(kf,kp0+sl_next,j); SBAR(); } }while(0)
  #define STEP(C0,C1,P0,P1,t,GK,GV,GL) do{ SBAR(); \
    const lds_cptr vp_=vp0+2*sl_prev; \
    VRD(0); SBAR(); float sacc=(P0[0]+P0[1]); \
    GAPA(C0=__builtin_amdgcn_mfma_f32_32x32x16_bf16(kf[0],qr[0],f32x16{},0,0,0), P0[2],P0[3],P0[4],P0[5],     pw0[0]=PKW(P0,0), pw0[1]=PKW(P0,2), pw0); \
    VRD(4); SBAR(); GAPA(C1=__builtin_amdgcn_mfma_f32_32x32x16_bf16(kf[1],qr[0],f32x16{},0,0,0), P0[6],P0[7],P0[8],P0[9],     pw0[2]=PKW(P0,4), pw0[3]=PKW(P0,6), pw0); \
    VRD(1); SBAR(); GAPA(C0=__builtin_amdgcn_mfma_f32_32x32x16_bf16(kf[2],qr[1],C0,0,0,0),   P0[10],P0[11],P0[12],P0[13], pw1[0]=PKW(P0,8), pw1[1]=PKW(P0,10), pw1); \
    VRD(5); SBAR(); GAPA(C1=__builtin_amdgcn_mfma_f32_32x32x16_bf16(kf[3],qr[1],C1,0,0,0),   P0[14],P0[15],P1[0],P1[1],   pw1[2]=PKW(P0,12),pw1[3]=PKW(P0,14), pw1); \
    VRD(2); SBAR(); GAPA(C0=__builtin_amdgcn_mfma_f32_32x32x16_bf16(kf[4],qr[2],C0,0,0,0),   P1[2],P1[3],P1[4],P1[5],     pw2[0]=PKW(P1,0), pw2[1]=PKW(P1,2), pw2); \
    VRD(6); SBAR(); GAPA(C1=__builtin_amdgcn_mfma_f32_32x32x16_bf16(kf[5],qr[2],C1,0,0,0),   P1[6],P1[7],P1[8],P1[9],     pw2[2]=PKW(P1,4), pw2[3]=PKW(P1,6), pw2); \
    VRD(3); SBAR(); GAPA(C0=__builtin_amdgcn_mfma_f32_32x32x16_bf16(kf[6],qr[3],C0,0,0,0),   P1[10],P1[11],P1[12],P1[13], pw3[0]=PKW(P1,8), pw3[1]=PKW(P1,10), pw3); \
    VRD(7); SBAR(); GAPA(C1=__builtin_amdgcn_mfma_f32_32x32x16_bf16(kf[7],qr[3],C1,0,0,0),   P1[14],P1[15],0.f,0.f,       pw3[2]=PKW(P1,12),pw3[3]=PKW(P1,14), pw3); \
    l_reg+=sacc; \
    _Pragma("unroll") for(int r=0;r<16;++r){ float a_=C0[r]-mhat; asm volatile("":"+v"(a_)); C0[r]=a_; float b_=C1[r]-mhat; asm volatile("":"+v"(b_)); C1[r]=b_; }   \
    if(GK){DMA_K((t)+3,sl_cur);} if(GV){DMA_V((t)+1,sl_next);} \
    CMASK(C0,C1,t); \
    { float a=MX3(C0[0],C0[1],C1[0]),b=MX3(C0[2],C0[3],C1[1]); a=MX3(a,C1[2],C1[3]); \
      _Pragma("unroll") for(int r=4;r<16;r+=4){a=MX3(a,C0[r],C0[r+1]);b=MX3(b,C0[r+2],C0[r+3]);a=MX3(a,C1[r],C1[r+1]);b=MX3(b,C1[r+2],C1[r+3]);} \
      float rm=__builtin_fmaxf(a,b); { auto rr=__builtin_amdgcn_permlane32_swap(__float_as_uint(rm),__float_as_uint(rm),false,false); rm=__builtin_fmaxf(__uint_as_float(rr[0]),__uint_as_float(rr[1])); } \
      resc=false; \
      if(__builtin_expect(__any(rm>(float)THRL),0)){ const float dl=__builtin_fmaxf(rm,0.f); mhat+=dl; \
        _Pragma("unroll") for(int r=0;r<16;++r){C0[r]-=dl;C1[r]-=dl;} \
        const float f=__builtin_amdgcn_exp2f(-dl); l_reg*=f; if(hi==0)wsf[r32]=f; resc=true; } } \
    SBAR(); \
    const lds_cptr vp2_=vp0+2*sl_prev+8192; \
    GAPB2(o[0]=__builtin_amdgcn_mfma_f32_32x32x16_bf16(PAF(0),VFR(0),o[0],0,0,0), VRD2(0), C0,0); \
    GAPB2(o[1]=__builtin_amdgcn_mfma_f32_32x32x16_bf16(PAF(0),VFR(4),o[1],0,0,0), VRD2(4), C0,2); \
    GAPB2(o[0]=__builtin_amdgcn_mfma_f32_32x32x16_bf16(PAF(1),VFR(1),o[0],0,0,0), VRD2(1), C0,4); \
    GAPB2(o[1]=__builtin_amdgcn_mfma_f32_32x32x16_bf16(PAF(1),VFR(5),o[1],0,0,0), VRD2(5), C0,6); \
    GAPB2(o[0]=__builtin_amdgcn_mfma_f32_32x32x16_bf16(PAF(2),VFR(2),o[0],0,0,0), VRD2(2), C0,8); \
    GAPB2(o[1]=__builtin_amdgcn_mfma_f32_32x32x16_bf16(PAF(2),VFR(6),o[1],0,0,0), VRD2(6), C0,10); \
    GAPB2(o[0]=__builtin_amdgcn_mfma_f32_32x32x16_bf16(PAF(3),VFR(3),o[0],0,0,0), VRD2(3), C0,12); \
    GAPB2(o[1]=__builtin_amdgcn_mfma_f32_32x32x16_bf16(PAF(3),VFR(7),o[1],0,0,0), VRD2(7), C0,14); \
    KRD(GL,0); GAPB2(o[2]=__builtin_amdgcn_mfma_f32_32x32x16_bf16(PAF(0),VFR(0),o[2],0,0,0), (void)0, C1,0); \
    KRD(GL,1); GAPB2(o[3]=__builtin_amdgcn_mfma_f32_32x32x16_bf16(PAF(0),VFR(4),o[3],0,0,0), (void)0, C1,2); \
    KRD(GL,2); GAPB2(o[2]=__builtin_amdgcn_mfma_f32_32x32x16_bf16(PAF(1),VFR(1),o[2],0,0,0), (void)0, C1,4); \
    KRD(GL,3); GAPB2(o[3]=__builtin_amdgcn_mfma_f32_32x32x16_bf16(PAF(1),VFR(5),o[3],0,0,0), (void)0, C1,6); \
    GAPB2(o[2]=__builtin_amdgcn_mfma_f32_32x32x16_bf16(PAF(2),VFR(2),o[2],0,0,0), (void)0, C1,8); \
    GAPB2(o[3]=__builtin_amdgcn_mfma_f32_32x32x16_bf16(PAF(2),VFR(6),o[3],0,0,0), (void)0, C1,10); \
    GAPB2(o[2]=__builtin_amdgcn_mfma_f32_32x32x16_bf16(PAF(3),VFR(3),o[2],0,0,0), (void)0, C1,12); \
    GAPB2(o[3]=__builtin_amdgcn_mfma_f32_32x32x16_bf16(PAF(3),VFR(7),o[3],0,0,0), (void)0, C1,14); \
    }while(0)
  int t=1;
  #undef CMASK
  #define CMASK(P0,P1,t) do{}while(0)
  for(;t+5<NT;t+=2){
    STEP(pB0,pB1,pA0,pA1,t,true,true,true);     WAIT_BAR(3); RESC(); ROT();
    STEP(pA0,pA1,pB0,pB1,t+1,true,true,true);   WAIT_BAR(3); RESC(); ROT();
  }
  #undef CMASK
  #define CMASK(P0,P1,t) do{int jb_=(t)-(NT-4); if(jb_>=0)cmask(P0,P1,jb_,qrel,hi);}while(0)
  #define ENDW(tt) do{ if((tt)+3<NT){WAIT_BAR(3);} else if((tt)+2<NT){WAIT_BAR(2);} else {WAIT_BAR(0);} }while(0)
  for(;t+3<NT;t+=2){
    STEP(pB0,pB1,pA0,pA1,t,(t+3<NT),(t+1<NT),(t+1<NT));       ENDW(t);   RESC(); ROT();
    STEP(pA0,pA1,pB0,pB1,t+1,(t+4<NT),(t+2<NT),(t+2<NT));     ENDW(t+1); RESC(); ROT();
  }
  STEP(pB0,pB1,pA0,pA1,NT-2,false,true,true);  WAIT_BAR(0); RESC(); ROT();
  STEP(pA0,pA1,pB0,pB1,NT-1,false,false,false); RESC();
  { float sacc=pA0[0]+pA0[1]; _Pragma("unroll") for(int r=2;r<16;++r)sacc+=pA0[r]; _Pragma("unroll") for(int r=0;r<16;++r)sacc+=pA1[r]; l_reg+=sacc;
    pw0=(u32x4){PKW(pA0,0),PKW(pA0,2),PKW(pA0,4),PKW(pA0,6)};pw1=(u32x4){PKW(pA0,8),PKW(pA0,10),PKW(pA0,12),PKW(pA0,14)};pw2=(u32x4){PKW(pA1,0),PKW(pA1,2),PKW(pA1,4),PKW(pA1,6)};pw3=(u32x4){PKW(pA1,8),PKW(pA1,10),PKW(pA1,12),PKW(pA1,14)};
    SBAR(); pv(o,vb0+2*sl_cur,PAF(0),PAF(1),PAF(2),PAF(3)); pv(o+2,vb0+2*sl_cur+8192,PAF(0),PAF(1),PAF(2),PAF(3)); }
  asm volatile("s_waitcnt lgkmcnt(0)\n\ts_barrier":::"memory");
  if(has_next){ const bf16*ksrc_n=Kh_next+wid*8;
    glds16s(ksrc_n,koff,(unsigned)__builtin_amdgcn_readfirstlane(kdst)); DMA_V(0,0); glds16s(ksrc_n+(long)KVBLK*DM,koff,(unsigned)__builtin_amdgcn_readfirstlane(kdst+SLOTB)); }
  #undef PKW
  #undef PAF
  #undef VFR
  #undef PIN
  #undef MX3
  #undef GAPA
  #undef GAPB
  #undef GAPB2
  #undef VRD2
  #undef EX
  #undef VRD
  #undef KRD
  #undef STEP
  #undef ENDW
  {auto rr=__builtin_amdgcn_permlane32_swap(__float_as_uint(l_reg),__float_as_uint(l_reg),false,false);l_reg=__uint_as_float(rr[0])+__uint_as_float(rr[1]);}
  if(hi==0)wsf[32+r32]=l_reg;asm volatile("s_waitcnt lgkmcnt(0)":::"memory");
  float rli[16];
  #pragma unroll
  for(int r=0;r<16;++r)rli[r]=__builtin_amdgcn_rcpf(wsf[32+crow(r,hi)]);
  { typedef __attribute__((address_space(3))) unsigned short* lds_u16p;
    int ln=lane; asm volatile("":"+v"(ln));
    const int r32e=ln&31, hie=ln>>5; const int bc=hie*4+(r32e>>3); const int lb=hie*512+(r32e&7);
    const lds_u16p Hw=(lds_u16p)(shm3+LDS_H+wid*8192);
    #pragma unroll
    for(int r=0;r<16;++r){
      #pragma unroll
      for(int d0=0;d0<4;++d0){ const int idx=lb+((r&3)+8*(r>>2))*128+((bc^(((((r>>2)&1)<<3)|(r&3))^(d0<<2)))<<3);
        float val=o[d0][r]*rli[r];
        if(m_sub){ const float old=__uint_as_float(((unsigned)Hw[idx])<<16); val=old-lam*val; }
        Hw[idx]=(unsigned short)(cvtpk_s(val,0.f)&0xffffu); } } }
  asm volatile("s_waitcnt lgkmcnt(0)":::"memory");
  __builtin_amdgcn_s_setprio(0);
  #undef DMA_K
  #undef DMA_V
  #undef CMASK
  #undef START
  #undef RESC
  #undef ROT
}
constexpr int ATTN_LDS_BYTES=LDS_BYTES;
#undef SBAR
#undef WAIT_BAR
}

namespace cg = cooperative_groups;
#define GAS __attribute__((address_space(1)))
#define LAS __attribute__((address_space(3)))
typedef unsigned short bf16;
typedef unsigned v4u __attribute__((ext_vector_type(4)));
typedef float f32x4 __attribute__((ext_vector_type(4)));

constexpr int NB = 32, SEQ = 2048, DM = 1024, MTOK = NB * SEQ;
constexpr int INC = 8192, DFF = 2816, KROWS = 64 + SEQ;
constexpr float NORM_EPS = 1e-5f, LAMBDA_INIT = 0.2f;
constexpr float QSCALE = 0.125f * 1.4426950408889634f;
constexpr size_t MiB = 1u << 20;
constexpr size_t WS_SS2 = 0, WS_SS3 = 256 * 1024, WS_RS1 = 512 * 1024, WS_PM = 768 * 1024;
constexpr size_t WS_WIN = 2 * MiB, WS_WP = 18 * MiB, WS_WOUT = 22 * MiB, WS_WGU = 24 * MiB, WS_WDN = 35 * MiB;
constexpr size_t WS_QO = 48 * MiB, WS_CB = 176 * MiB, WS_U = 304 * MiB, WS_SGA = 432 * MiB, WS_SGB = 560 * MiB, WS_KB = 688 * MiB, WS_VB = 820 * MiB, WS_END = 952 * MiB;
constexpr size_t WS_MG = WS_KB, WS_H2B = WS_VB, WS_ACT = WS_QO;
static_assert(WS_ACT + (size_t)MTOK * DFF * 2 <= WS_SGA + 128 * MiB && WS_KB + (size_t)NB * KROWS * DM * 2 <= WS_VB && WS_VB + (size_t)NB * KROWS * DM * 2 <= WS_END, "ws map");
constexpr int LDS_BYTES = 147456;
static_assert(attn_body::ATTN_LDS_BYTES <= LDS_BYTES, "attention LDS");
constexpr size_t WS_BAR = 1 * MiB;
constexpr int LDS_BARST = LDS_BYTES - 256;
static_assert(attn_body::ATTN_LDS_BYTES <= LDS_BARST, "attention LDS vs barrier words");
#define RLX_AGENT __ATOMIC_RELAXED, __HIP_MEMORY_SCOPE_AGENT
#define XB_TMO      128
#define XB_XCNT(j)  (256  + 64 * (j))
#define XB_XSUB(j)  (1280 + 64 * (j))
#define XB_XGEN(j)  (2304 + 64 * (j))
#define XB_TOP      3328
#define XB_TOPGEN   3392
#define XCD_BAR_WORDS 3456
#define XB_SPIN_CAP (1u << 18)

__device__ __forceinline__ unsigned xb_ld(unsigned* p)              { return __hip_atomic_load(p, __ATOMIC_RELAXED, __HIP_MEMORY_SCOPE_AGENT); }
__device__ __forceinline__ unsigned xb_add(unsigned* p, unsigned v) { return __hip_atomic_fetch_add(p, v, __ATOMIC_RELAXED, __HIP_MEMORY_SCOPE_AGENT); }
__device__ __forceinline__ unsigned xb_xcc_id() { return (unsigned)__builtin_amdgcn_s_getreg((3 << 11) | 20) & 0xFu; }
#define XB_SPIN(cond, bar) do { unsigned _sp = 0; while (cond) { __builtin_amdgcn_s_sleep(1); \
    if ((++_sp & 255u) == 0u) { if (xb_ld(&(bar)[XB_TMO])) break; if (_sp > XB_SPIN_CAP) { atomicAdd(&(bar)[XB_TMO], 1u); break; } } } } while (0)

struct XcdBarrier {
    unsigned* bar; unsigned x;
    volatile LAS unsigned* st;
};

__device__ __forceinline__ XcdBarrier xcd_barrier_post(unsigned* bar, volatile LAS unsigned* st) {
    XcdBarrier b; b.bar = bar; b.x = xb_xcc_id(); b.st = st;
    if (threadIdx.x == 0) (void)xb_add(&bar[XB_XCNT(b.x)], 1u);
    return b;
}
__device__ __forceinline__ void xcd_barrier_complete(unsigned* bar, unsigned x, unsigned& nloc, unsigned& nx) {
    const unsigned G = gridDim.x * gridDim.y * gridDim.z;
    unsigned sum, cnt, mine, sp = 0u;
    for (;;) {
        sum = 0u; cnt = 0u; mine = 0u;
#pragma unroll
        for (unsigned j = 0; j < 16; ++j) { const unsigned c = xb_ld(&bar[XB_XCNT(j)]); sum += c; cnt += (c > 0u) ? 1u : 0u; mine = (j == x) ? c : mine; }
        if (sum == G) break;
        __builtin_amdgcn_s_sleep(1);
        if ((++sp & 255u) == 0u) { if (xb_ld(&bar[XB_TMO])) break; if (sp > XB_SPIN_CAP) { atomicAdd(&bar[XB_TMO], 1u); break; } }
    }
    nloc = mine > 0u ? mine : 1u; nx = cnt > 0u ? cnt : 1u;
}

__device__ __forceinline__ void xcd_barrier(const XcdBarrier& b) {
    asm volatile("s_waitcnt vmcnt(0)" ::: "memory");
    __syncthreads();
    if (threadIdx.x == 0) {
        unsigned* bar = b.bar;
        __builtin_amdgcn_s_waitcnt(0);
        unsigned nloc = b.st[0], nx = b.st[1];
        if (nloc == 0u) { xcd_barrier_complete(bar, b.x, nloc, nx); b.st[0] = nloc; b.st[1] = nx; }
        const unsigned old = xb_add(&bar[XB_XSUB(b.x)], 1u);
        const unsigned gen = old / nloc;
        if (old + 1u == (gen + 1u) * nloc) {
            __builtin_amdgcn_fence(__ATOMIC_RELEASE, "agent");
            asm volatile("s_waitcnt vmcnt(0)" ::: "memory");
            const unsigned og = xb_add(&bar[XB_TOP], 1u);
            const unsigned tg = og / nx;
            if (og + 1u == (tg + 1u) * nx) xb_add(&bar[XB_TOPGEN], 1u);
            else XB_SPIN(xb_ld(&bar[XB_TOPGEN]) == tg, bar);
            __builtin_amdgcn_fence(__ATOMIC_ACQUIRE, "agent");
            xb_add(&bar[XB_XGEN(b.x)], 1u);
            asm volatile("s_waitcnt vmcnt(0)" ::: "memory");
        } else {
            XB_SPIN(xb_ld(&bar[XB_XGEN(b.x)]) == gen, bar);
            __builtin_amdgcn_fence(__ATOMIC_ACQUIRE, "agent");
            asm volatile("s_waitcnt vmcnt(0)" ::: "memory");
        }
    }
    __syncthreads();
}


template <int K> __device__ __forceinline__ float xor_swz(float v) { return __uint_as_float((unsigned)__builtin_amdgcn_ds_swizzle((int)__float_as_uint(v), (K << 10) | 0x1f)); }
__device__ __forceinline__ float xor32_sum(float v) { auto rr = __builtin_amdgcn_permlane32_swap(__float_as_uint(v), __float_as_uint(v), false, false); return __uint_as_float(rr[0]) + __uint_as_float(rr[1]); }
__device__ __forceinline__ float wave_sum(float v) { v += xor_swz<1>(v); v += xor_swz<2>(v); v += xor_swz<4>(v); v += xor_swz<8>(v); v += xor_swz<16>(v); return xor32_sum(v); }
__device__ __forceinline__ float bf_lo(unsigned w) { return __uint_as_float(w << 16); }
__device__ __forceinline__ float bf_hi(unsigned w) { return __uint_as_float(w & 0xffff0000u); }
__device__ __forceinline__ v4u pack8(f32x4 a, f32x4 b) { v4u w; w.x = pg8::cvt_pk_bf16(a[0], a[1]); w.y = pg8::cvt_pk_bf16(a[2], a[3]); w.z = pg8::cvt_pk_bf16(b[0], b[1]); w.w = pg8::cvt_pk_bf16(b[2], b[3]); return w; }
__device__ __forceinline__ void unpack8(v4u w, f32x4& a, f32x4& b) { a = (f32x4){bf_lo(w.x), bf_hi(w.x), bf_lo(w.y), bf_hi(w.y)}; b = (f32x4){bf_lo(w.z), bf_hi(w.z), bf_lo(w.w), bf_hi(w.w)}; }
__device__ __forceinline__ float sigm(float x) { return __builtin_amdgcn_rcpf(1.f + __builtin_amdgcn_exp2f(-1.4426950408889634f * x)); }
__device__ __forceinline__ float inv_freq(int d) { return exp2f(-(float)d * (13.287712379549449f / 32.f)); }
__device__ __forceinline__ void rope_cs(float pos, float invf, float& c, float& s) {
    const float ang = pos * invf; float rev = ang * 0.15915494309189535f; rev = __builtin_amdgcn_fractf(rev);
    s = __builtin_amdgcn_sinf(rev); c = __builtin_amdgcn_cosf(rev);
}

namespace pg8 {
#define NTST(ptr, val) (*(v4u*)(ptr) = (val))
struct EpiInProj {
    static constexpr bool PERM = true, AFTER_DRAIN = false, MID = false;
    const float* rs1; bf16_t *QO, *KB, *VB, *CB, *U, *SGA, *SGB;
    __device__ __forceinline__ void operator()(const f32x4 (&acc)[2][2][4][2], const Unit& u, int wr, int wc, int fr, int fq) const {
        int frp = fr; asm volatile("" : "+v"(frp)); const int pn = u.pn, row0 = u.pm * BM + wr * 64 + frp;
        const size_t kvshift = (size_t)64 * ((u.pm >> 3) + 1);
        if (pn < 8) {
            const bool isq = pn < 4; bf16_t* base = isq ? QO : KB; const float s0 = isq ? QSCALE : 1.f;
            const int colt = (pn & 3) * 256 + wc * 64 + 8 * fq;
            float invf[8];
#pragma unroll
            for (int k = 0; k < 8; ++k) invf[k] = inv_freq(8 * fq + k);
#pragma unroll
            for (int ai = 0; ai < 2; ++ai)
#pragma unroll
                for (int m = 0; m < 4; ++m) {
                    const int row = row0 + ai * HALF + m * 16; const float pos = (float)(16 + (row & (SEQ - 1))); const float sc = s0;
                    const size_t orow = isq ? (size_t)row : (size_t)row + kvshift;
                    f32x4 lo[2], hi[2], ylo[2], yhi[2];
                    lo[0] = acc[ai][0][m][0] * sc; lo[1] = acc[ai][0][m][1] * sc; hi[0] = acc[ai][1][m][0] * sc; hi[1] = acc[ai][1][m][1] * sc;
#pragma unroll
                    for (int n = 0; n < 2; ++n)
#pragma unroll
                        for (int k = 0; k < 4; ++k) { float c, s; rope_cs(pos, invf[4 * n + k], c, s); ylo[n][k] = lo[n][k] * c - hi[n][k] * s; yhi[n][k] = hi[n][k] * c + lo[n][k] * s; }
                    bf16_t* p = base + orow * DM + colt;
                    NTST(p, pack8(ylo[0], ylo[1])); NTST((p + 32), pack8(yhi[0], yhi[1]));
                }
        } else if (pn < 16) {
            const bool isv = pn < 12; bf16_t* base = isv ? VB : CB; const int colt = (pn & 3) * 256 + wc * 32 + 8 * fq;
#pragma unroll
            for (int ai = 0; ai < 2; ++ai)
#pragma unroll
                for (int m = 0; m < 4; ++m) {
                    const int row = row0 + ai * HALF + m * 16; const float sc = 1.f; const size_t orow = isv ? (size_t)row + kvshift : (size_t)row;
                    bf16_t* p = base + orow * DM + colt;
#pragma unroll
                    for (int bj = 0; bj < 2; ++bj) NTST((p + bj * HALF), pack8(acc[ai][bj][m][0] * sc, acc[ai][bj][m][1] * sc));
                }
        } else if (pn < 24) {
            const int colt = (pn - 16) * 128 + wc * 32 + 8 * fq;
#pragma unroll
            for (int ai = 0; ai < 2; ++ai)
#pragma unroll
                for (int m = 0; m < 4; ++m) {
                    const int row = row0 + ai * HALF + m * 16; const float sc2 = 1.f;
                    NTST((U + (size_t)row * DM + colt), pack8(acc[ai][0][m][0] * acc[ai][1][m][0] * sc2, acc[ai][0][m][1] * acc[ai][1][m][1] * sc2));
                }
        } else {
            const int colt = (pn - 24) * 128 + wc * 32 + 8 * fq;
#pragma unroll
            for (int ai = 0; ai < 2; ++ai)
#pragma unroll
                for (int m = 0; m < 4; ++m) {
                    const int row = row0 + ai * HALF + m * 16; f32x4 ra[2], sb[2];
#pragma unroll
                    for (int n = 0; n < 2; ++n)
#pragma unroll
                        for (int k = 0; k < 4; ++k) { const float ea = __builtin_amdgcn_exp2f(fminf(-1.4426950408889634f * acc[ai][0][m][n][k], 80.f)), eb = __builtin_amdgcn_exp2f(fminf(-1.4426950408889634f * acc[ai][1][m][n][k], 80.f));
                            ra[n][k] = __builtin_amdgcn_rcpf(1.f + ea) * (1.f + eb); sb[n][k] = __builtin_amdgcn_rcpf(1.f + eb); }
                    NTST((SGA + (size_t)row * DM + colt), pack8(ra[0], ra[1])); NTST((SGB + (size_t)row * DM + colt), pack8(sb[0], sb[1]));
                }
        }
    }
};
struct EpiMerge {
    static constexpr bool PERM = true, AFTER_DRAIN = false, MID = true;
    const bf16_t *SGA, *SGB; bf16_t* MG;
    __device__ __forceinline__ void mid(f32x4 (&acc)[2][2][4][2], const Unit& u, int wr, int wc, int fr, int fq) const {
        int frp = fr; asm volatile("" : "+v"(frp)); const int row0 = u.pm * BM + wr * 64 + frp, col0 = u.pn * BM + wc * 32 + 8 * fq;
#pragma unroll
        for (int ai = 0; ai < 2; ++ai)
#pragma unroll
            for (int m = 0; m < 4; ++m) { const size_t off = (size_t)(row0 + ai * HALF + m * 16) * DM + col0;
#pragma unroll
                for (int bj = 0; bj < 2; ++bj) { f32x4 a0, a1; unpack8(*(const v4u*)(SGA + off + bj * HALF), a0, a1);
                    acc[ai][bj][m][0] *= a0; acc[ai][bj][m][1] *= a1; }
                if (m == 3) asm volatile("" ::: "memory"); }
    }
    __device__ __forceinline__ void operator()(const f32x4 (&acc)[2][2][4][2], const Unit& u, int wr, int wc, int fr, int fq) const {
        int frp = fr; asm volatile("" : "+v"(frp)); const int row0 = u.pm * BM + wr * 64 + frp, col0 = u.pn * BM + wc * 32 + 8 * fq;
#pragma unroll
        for (int ai = 0; ai < 2; ++ai)
#pragma unroll
            for (int m = 0; m < 4; ++m) { const size_t off = (size_t)(row0 + ai * HALF + m * 16) * DM + col0;
#pragma unroll
                for (int bj = 0; bj < 2; ++bj) { f32x4 b0, b1; unpack8(*(const v4u*)(SGB + off + bj * HALF), b0, b1);
                    NTST((MG + off + bj * HALF), pack8(acc[ai][bj][m][0] * b0, acc[ai][bj][m][1] * b1)); } }
    }
};
template <bool IN_BF16> struct EpiResid {
    static constexpr bool PERM = true, AFTER_DRAIN = false, MID = false;
    const void* hin; bf16_t* hb; float* ss; const float* rsn;
    __device__ __forceinline__ void operator()(const f32x4 (&acc)[2][2][4][2], const Unit& u, int wr, int wc, int fr, int fq) const {
        int frp = fr; asm volatile("" : "+v"(frp)); const int row0 = u.pm * BM + wr * 64 + frp, col0 = u.pn * BM + wc * 32 + 8 * fq;
#pragma unroll
        for (int ai = 0; ai < 2; ++ai)
#pragma unroll
            for (int m = 0; m < 4; ++m) { const int row = row0 + ai * HALF + m * 16; const size_t off = (size_t)row * DM + col0; float s = 0.f; const float rinv = rsn ? __builtin_amdgcn_rcpf(rsn[row]) : 1.f;
#pragma unroll
                for (int bj = 0; bj < 2; ++bj) { f32x4 h0, h1;
                    if (IN_BF16) unpack8(*(const v4u*)((const bf16_t*)hin + off + bj * HALF), h0, h1);
                    else { h0 = *(const f32x4*)((const float*)hin + off + bj * HALF); h1 = *(const f32x4*)((const float*)hin + off + bj * HALF + 4); }
                    if (rsn) { h0 = h0 * rinv; h1 = h1 * rinv; }
                    h0 += acc[ai][bj][m][0]; h1 += acc[ai][bj][m][1];
                    NTST((hb + off + bj * HALF), pack8(h0, h1));
                    s += (h0[0] * h0[0] + h0[1] * h0[1]) + (h0[2] * h0[2] + h0[3] * h0[3]) + (h1[0] * h1[0] + h1[1] * h1[1]) + (h1[2] * h1[2] + h1[3] * h1[3]); }
                s += xor_swz<16>(s); s = xor32_sum(s);
                if (fq == 0) (void)__hip_atomic_fetch_add(ss + row, s, __ATOMIC_RELAXED, __HIP_MEMORY_SCOPE_AGENT); }
    }
};
struct EpiGateUp {
    static constexpr bool PERM = true, AFTER_DRAIN = false, MID = false;
    const float* ss2; bf16_t* ACT;
    __device__ __forceinline__ void operator()(const f32x4 (&acc)[2][2][4][2], const Unit& u, int wr, int wc, int fr, int fq) const {
        int frp = fr; asm volatile("" : "+v"(frp)); const int row0 = u.pm * BM + wr * 64 + frp, col0 = u.pn * HALF + wc * 32 + 8 * fq;
#pragma unroll
        for (int ai = 0; ai < 2; ++ai)
#pragma unroll
            for (int m = 0; m < 4; ++m) { const int row = row0 + ai * HALF + m * 16; const float r2 = __builtin_amdgcn_rsqf(ss2[row] * (1.f / DM) + NORM_EPS);
                f32x4 o[2];
#pragma unroll
                for (int n = 0; n < 2; ++n) { const f32x4 g = acc[ai][0][m][n] * r2, uu = acc[ai][1][m][n] * r2;
#pragma unroll
                    for (int k = 0; k < 4; ++k) o[n][k] = g[k] * sigm(g[k]) * uu[k]; }
                NTST((ACT + (size_t)row * DFF + col0), pack8(o[0], o[1])); }
    }
};
}

__device__ __forceinline__ void transpose_item(const float* W, int N, int k0, int n0src, const float* ksc, bf16* WT, int ldk, int drow0, int dk0, LAS float* scr, int lane) {
#pragma unroll
    for (int i = 0; i < 32; ++i) { const int kk = 2 * i + (lane >> 5); float v = W[(size_t)(k0 + kk) * N + n0src + (lane & 31)]; if (ksc) v *= ksc[k0 + kk]; scr[kk * 33 + (lane & 31)] = v; }
    asm volatile("s_waitcnt lgkmcnt(0)" ::: "memory");
    const int c = lane & 7;
#pragma unroll
    for (int j = 0; j < 4; ++j) { const int n = (lane >> 3) + 8 * j; const LAS float* s = scr + (8 * c) * 33 + n;
        v4u o; o.x = pg8::cvt_pk_bf16(s[0 * 33], s[1 * 33]); o.y = pg8::cvt_pk_bf16(s[2 * 33], s[3 * 33]); o.z = pg8::cvt_pk_bf16(s[4 * 33], s[5 * 33]); o.w = pg8::cvt_pk_bf16(s[6 * 33], s[7 * 33]);
        *(v4u*)(WT + (size_t)(drow0 + n) * ldk + dk0 + 8 * c) = o; }
    asm volatile("s_waitcnt lgkmcnt(0)" ::: "memory");
}
__device__ __forceinline__ int win_src_col(int rb) {
    const int pn = rb >> 3, sb = rb & 7, bj = sb >> 2, wc = sb & 3;
    if (pn < 8) return pn * 256 + 64 * wc + 32 * bj;
    if (pn < 16) return pn * 256 + sb * 32;
    if (pn < 24) return (bj ? 5120 : 4096) + 128 * (pn - 16) + 32 * wc;
    return (bj ? 7168 : 6144) + 128 * (pn - 24) + 32 * wc;
}

#ifndef REPMASK
#define REPMASK 0
#endif
#ifndef PHMASK
#define PHMASK 0xFF
#endif
struct Args { const float* in[17]; float* out; unsigned char* ws; };

__global__ void __launch_bounds__(512, 2) fwd_kernel(Args a) {
    extern __shared__ __attribute__((aligned(16))) unsigned char lds[];
    cg::grid_group grid = cg::this_grid();
    const int wave = __builtin_amdgcn_readfirstlane((int)threadIdx.x >> 6);
#define PIN_TID() int tid_ = threadIdx.x; asm volatile("" : "+v"(tid_)); const int tid = tid_, lane = tid & 63, gtid = bx * 512 + tid; (void)lane; (void)gtid
    const int G = gridDim.x, bx = blockIdx.x;
    const int vcu = (G % 8 == 0) ? (bx % 8) * (G / 8) + bx / 8 : bx;
    LAS unsigned char* L = (LAS unsigned char*)lds;
    unsigned char* ws = a.ws;
    const float* x = a.in[0]; const float* w_in = a.in[3];
#define Win_t ((bf16*)(ws + WS_WIN))
#define Wp_t ((bf16*)(ws + WS_WP))
#define Wout_t ((bf16*)(ws + WS_WOUT))
#define Wgu_t ((bf16*)(ws + WS_WGU))
#define Wdn_t ((bf16*)(ws + WS_WDN))
#define QO ((bf16*)(ws + WS_QO))
#define CB ((bf16*)(ws + WS_CB))
#define U ((bf16*)(ws + WS_U))
#define SGA ((bf16*)(ws + WS_SGA))
#define SGB ((bf16*)(ws + WS_SGB))
#define KB ((bf16*)(ws + WS_KB))
#define VB ((bf16*)(ws + WS_VB))
#define MG ((bf16*)(ws + WS_MG))
#define H2B ((bf16*)(ws + WS_H2B))
#define ACT ((bf16*)(ws + WS_ACT))
#define H3B ((bf16*)(ws + WS_SGA))
#define ss2 ((float*)(ws + WS_SS2))
#define ss3 ((float*)(ws + WS_SS3))
#define rs1 ((float*)(ws + WS_RS1))
#define PM ((float*)(ws + WS_PM))
    bf16* HB = (bf16*)a.out;
    { volatile LAS unsigned* st0 = (volatile LAS unsigned*)(L + LDS_BARST); if (threadIdx.x < 2) st0[threadIdx.x] = 0u; __syncthreads(); }
#define XSYNC() xcd_barrier(xbar)
#define GSYNC() do { asm volatile("s_waitcnt vmcnt(0)" ::: "memory"); __syncthreads(); grid.sync(); \
    if (threadIdx.x == 0) { __builtin_amdgcn_fence(__ATOMIC_ACQUIRE, "agent"); asm volatile("s_waitcnt vmcnt(0)" ::: "memory"); } __syncthreads(); } while (0)
    const int GT = G * 512;

    for (int rep_ = 0; rep_ < 1 + ((REPMASK >> 0) & 1); ++rep_) if ((PHMASK >> 0) & 1) {
        PIN_TID();
        const int gw = vcu * 8 + wave, NGW = G * 8;
        for (int i = gtid; i < 2 * MTOK / 4; i += GT) ((f32x4*)ss2)[i] = (f32x4){0.f, 0.f, 0.f, 0.f};
        for (int i = gtid; i < XCD_BAR_WORDS; i += GT) ((unsigned*)(ws + WS_BAR))[i] = 0u;
        for (int i = gtid; i < 2 * NB * 6144; i += GT) { const int buf = i / (NB * 6144), r = i % (NB * 6144), b = r / 6144, o = r % 6144;
            ((v4u*)((buf ? VB : KB) + ((size_t)b * KROWS + 16) * DM))[o] = (v4u){0u, 0u, 0u, 0u}; }
        LAS float* scr = (LAS float*)(L + wave * 16384);
        constexpr int I_IN = 16 * 256, I_P = 16 * 32, I_GU = 16 * 176, I_DN = 44 * 32, NITEMS = I_IN + 3 * I_P + I_GU + I_DN;
        for (int it = gw; it < NITEMS; it += NGW) {
            int r = it;
            if (r < I_IN) { const int kb = r >> 8, rb = r & 255; transpose_item(w_in, INC, kb * 64, win_src_col(rb), a.in[2], Win_t, DM, rb * 32, kb * 64, scr, lane); continue; } r -= I_IN;
            if (r < I_P) { const int kb = r >> 5, rb = r & 31; transpose_item(a.in[10], DM, kb * 64, rb * 32, nullptr, Wp_t, 2 * DM, rb * 32, kb * 64, scr, lane); continue; } r -= I_P;
            if (r < I_P) { const int kb = r >> 5, rb = r & 31; transpose_item(a.in[11], DM, kb * 64, rb * 32, nullptr, Wp_t, 2 * DM, rb * 32, DM + kb * 64, scr, lane); continue; } r -= I_P;
            if (r < I_P) { const int kb = r >> 5, rb = r & 31; transpose_item(a.in[12], DM, kb * 64, rb * 32, nullptr, Wout_t, DM, rb * 32, kb * 64, scr, lane); continue; } r -= I_P;
            if (r < I_GU) { const int kb = r / 176, rb = r % 176, pn = rb >> 3, sb = rb & 7;
                transpose_item(a.in[14], 2 * DFF, kb * 64, ((sb >> 2) ? DFF : 0) + 128 * pn + 32 * (sb & 3), a.in[13], Wgu_t, DM, rb * 32, kb * 64, scr, lane); continue; } r -= I_GU;
            { const int kb = r >> 5, rb = r & 31; transpose_item(a.in[15], DM, kb * 64, rb * 32, nullptr, Wdn_t, DFF, rb * 32, kb * 64, scr, lane); }
        }
        for (int m0 = gw * 4; m0 < MTOK; m0 += NGW * 4) {
            f32x4 v[4][4]; float s[4];
#pragma unroll
            for (int r = 0; r < 4; ++r) { const f32x4* xr = (const f32x4*)(x + (size_t)(m0 + r) * DM) + lane;
#pragma unroll
                for (int j = 0; j < 4; ++j) v[r][j] = __builtin_nontemporal_load(&xr[64 * j]); }
#pragma unroll
            for (int r = 0; r < 4; ++r) { s[r] = 0.f;
#pragma unroll
                for (int j = 0; j < 4; ++j) s[r] += (v[r][j][0] * v[r][j][0] + v[r][j][1] * v[r][j][1]) + (v[r][j][2] * v[r][j][2] + v[r][j][3] * v[r][j][3]);
                s[r] = wave_sum(s[r]); }
            if (lane < 4) rs1[m0 + lane] = __builtin_amdgcn_rsqf((lane == 0 ? s[0] : lane == 1 ? s[1] : lane == 2 ? s[2] : s[3]) * (1.f / DM) + NORM_EPS);
#pragma unroll
            for (int r = 0; r < 4; ++r) { unsigned long long* o8 = (unsigned long long*)(HB + (size_t)(m0 + r) * DM) + lane; const float rsr = __builtin_amdgcn_rsqf(s[r] * (1.f / DM) + NORM_EPS);
#pragma unroll
                for (int j = 0; j < 4; ++j) { const f32x4 q = v[r][j] * rsr; o8[64 * j] = (unsigned long long)pg8::cvt_pk_bf16(q[0], q[1]) | ((unsigned long long)pg8::cvt_pk_bf16(q[2], q[3]) << 32); } }
        }
        for (int job = bx; job < 256; job += G) {
            LAS float* hm = (LAS float*)L; LAS float* red = (LAS float*)(L + 65536);
            __syncthreads();
#pragma unroll
            for (int rr = 0; rr < 2; ++rr) { const int r = wave * 2 + rr; const f32x4* mr = (const f32x4*)(a.in[1] + (size_t)r * DM) + lane; f32x4 v[4]; float s = 0.f;
#pragma unroll
                for (int j = 0; j < 4; ++j) { v[j] = mr[64 * j]; s += (v[j][0] * v[j][0] + v[j][1] * v[j][1]) + (v[j][2] * v[j][2] + v[j][3] * v[j][3]); }
                const float rs = __builtin_amdgcn_rsqf(wave_sum(s) * (1.f / DM) + NORM_EPS);
#pragma unroll
                for (int j = 0; j < 4; ++j) { const f32x4 wv = ((const f32x4*)a.in[2])[lane + 64 * j];
#pragma unroll
                    for (int k = 0; k < 4; ++k) hm[(4 * lane + 256 * j + k) * 16 + r] = v[j][k] * rs * wv[k]; } }
            __syncthreads();
            const int col = tid & 15, ksp = tid >> 4, pcol = job * 16 + col, src = pcol < 2048 ? 1024 + pcol : 4096 + (pcol - 2048);
            float acc[16];
#pragma unroll
            for (int r = 0; r < 16; ++r) acc[r] = 0.f;
#pragma unroll 8
            for (int dd = 0; dd < 32; ++dd) { const int d = ksp * 32 + dd; const float wv = w_in[(size_t)d * INC + src];
                const f32x4 h0 = *(const LAS f32x4*)(hm + d * 16), h1 = *(const LAS f32x4*)(hm + d * 16 + 4), h2 = *(const LAS f32x4*)(hm + d * 16 + 8), h3 = *(const LAS f32x4*)(hm + d * 16 + 12);
#pragma unroll
                for (int k = 0; k < 4; ++k) { acc[k] += h0[k] * wv; acc[4 + k] += h1[k] * wv; acc[8 + k] += h2[k] * wv; acc[12 + k] += h3[k] * wv; } }
#pragma unroll
            for (int r = 0; r < 16; ++r) red[(ksp * 16 + r) * 16 + col] = acc[r];
            __syncthreads();
            if (tid < 256) { const int r = tid >> 4, c = tid & 15; float s = 0.f;
#pragma unroll 8
                for (int k = 0; k < 32; ++k) s += red[(k * 16 + r) * 16 + c];
                PM[r * 4096 + job * 16 + c] = s; }
        }
        __syncthreads();
    }
    GSYNC();
    const XcdBarrier xbar = xcd_barrier_post((unsigned*)(ws + WS_BAR), (volatile LAS unsigned*)(L + LDS_BARST));

    for (int rep_ = 0; rep_ < 1 + ((REPMASK >> 1) & 1); ++rep_) if ((PHMASK >> 1) & 1) {
        PIN_TID();
        for (int rm_ = 0; rm_ < 1 + ((REPMASK >> 8) & 1); ++rm_)
        for (int i = gtid; i < NB * 16 * 256; i += GT) { const int ch = i & 255, r = (i >> 8) & 15, b = i >> 12; const bool isv = ch >= 128; const int c = (ch & 127) * 8;
            f32x4 o0, o1;
            if (!isv) { const int d = c & 63, base = c - d, dl = d & 31; const float* plo = PM + r * 4096 + base + dl; const float* phi = plo + 32;
#pragma unroll
                for (int k = 0; k < 8; ++k) { float cs, sn; rope_cs((float)r, inv_freq(dl + k), cs, sn); const float xl = plo[k], xh = phi[k]; const float y = d < 32 ? xl * cs - xh * sn : xh * cs + xl * sn;
                    if (k < 4) o0[k] = y; else o1[k - 4] = y; }
            } else { o0 = *(const f32x4*)(PM + r * 4096 + 1024 + c); o1 = *(const f32x4*)(PM + r * 4096 + 1024 + c + 4); }
            *(v4u*)((isv ? VB : KB) + ((size_t)b * KROWS + r) * DM + c) = pack8(o0, o1); }
        pg8::Gemm g{HB, HB, Win_t, DM, DM, DM / 64}; pg8::StaticOrder S; S.init(MTOK, INC, G, bx);
        pg8::EpiInProj E{rs1, QO, KB, VB, CB, U, SGA, SGB};
        for (int rg_ = 0; rg_ < 1 + ((REPMASK >> 9) & 1); ++rg_)
        pg8::gemm_phase<pg8::EpiInProj, pg8::StaticOrder, true, true>(L, g, S, E);
    }
    XSYNC();

    for (int rep_ = 0; rep_ < 1 + ((REPMASK >> 2) & 1); ++rep_) if ((PHMASK >> 2) & 1) {
        PIN_TID();
        const float* cw = a.in[9]; bf16* OAp = (bf16*)a.out + (size_t)MTOK * DM; bf16* OBp = CB;
        float lam;
        { const float s1 = wave_sum(a.in[4][lane] * a.in[5][lane]), s2 = wave_sum(a.in[6][lane] * a.in[7][lane]); lam = __uint_as_float(__builtin_amdgcn_readfirstlane(__float_as_uint(expf(s1) - expf(s2) + LAMBDA_INIT))); }
        const float* subw = a.in[8];
        const int conv_grp = (bx >> 3) & 3, conv_before = conv_grp == 0 ? 0 : conv_grp == 1 ? 4 : conv_grp == 2 ? 6 : 7;
        for (int bh = vcu; bh < NB * 8; bh += G) { const int b = bh >> 3, hh = bh & 7;
            for (int qb = 0; qb < 8; ++qb) {
                if (bh == vcu && qb == conv_before) { int gt2 = gtid; asm volatile("" : "+v"(gt2));
                    for (int it = gt2; it < (MTOK / 16) * 128; it += GT) { const int ch = it & 127, rb = it >> 7, g0 = rb * 16, c = ch * 8;
                        const f32x4 w00 = *(const f32x4*)(cw + c), w01 = *(const f32x4*)(cw + c + 4), w10 = *(const f32x4*)(cw + DM + c), w11 = *(const f32x4*)(cw + DM + c + 4), w20 = *(const f32x4*)(cw + 2 * DM + c), w21 = *(const f32x4*)(cw + 2 * DM + c + 4);
                        f32x4 p0, p1, q0, q1;
                        if ((g0 & (SEQ - 1)) == 0) { const float* m14 = PM + 14 * 4096 + 2048 + c; const float* m15 = PM + 15 * 4096 + 2048 + c;
                            p0 = *(const f32x4*)m14 * *(const f32x4*)(m14 + 1024); p1 = *(const f32x4*)(m14 + 4) * *(const f32x4*)(m14 + 1028);
                            q0 = *(const f32x4*)m15 * *(const f32x4*)(m15 + 1024); q1 = *(const f32x4*)(m15 + 4) * *(const f32x4*)(m15 + 1028);
                        } else { unpack8(*(const v4u*)(U + (size_t)(g0 - 2) * DM + c), p0, p1); unpack8(*(const v4u*)(U + (size_t)(g0 - 1) * DM + c), q0, q1); }
#pragma unroll 4
                        for (int j = 0; j < 16; ++j) { const size_t off = (size_t)(g0 + j) * DM + c; f32x4 u0, u1, b0, b1; unpack8(*(const v4u*)(U + off), u0, u1); unpack8(*(const v4u*)(CB + off), b0, b1);
                            *(v4u*)(OBp + off) = pack8(b0 * (w00 * p0 + w10 * q0 + w20 * u0), b1 * (w01 * p1 + w11 * q1 + w21 * u1));
                            p0 = q0; p1 = q1; q0 = u0; q1 = u1; }
                    }
                }
                for (int m = 0; m < 2; ++m) {
                    const attn_body::bf16* Qw = (const attn_body::bf16*)QO + ((size_t)b * SEQ + qb * 256 + wave * 32) * DM + hh * 128 + m * 64;
                    const attn_body::bf16* Kh = (const attn_body::bf16*)KB + (size_t)b * KROWS * DM + hh * 128 + m * 64;
                    const attn_body::bf16* Vh = (const attn_body::bf16*)VB + (size_t)b * KROWS * DM + hh * 128;
                    const attn_body::bf16* Khn = (const attn_body::bf16*)KB + (size_t)b * KROWS * DM + hh * 128 + (1 - m) * 64;
                    attn_body::attn_pass<8>(Qw, Kh, Vh, 4 * qb + 5, m, lam, (char*)lds, Khn, !(qb == 7 && m == 1), !(qb == 0 && m == 0));
                }
                { int ln = lane; asm volatile("" : "+v"(ln)); const LAS unsigned char* Hw = L + attn_body::LDS_H + wave * 8192; const int row = ln >> 1, half = ln & 1; float s = 0.f;
#pragma unroll
                    for (int j = 0; j < 8; ++j) { const int chunk = half * 8 + j; f32x4 v0, v1; unpack8(*(const LAS v4u*)(Hw + row * 256 + ((chunk ^ (row & 15)) << 4)), v0, v1);
                        s += (v0[0] * v0[0] + v0[1] * v0[1]) + (v0[2] * v0[2] + v0[3] * v0[3]) + (v1[0] * v1[0] + v1[1] * v1[1]) + (v1[2] * v1[2] + v1[3] * v1[3]); }
                    s += __uint_as_float((unsigned)__builtin_amdgcn_mov_dpp((int)__float_as_uint(s), 0xB1, 0xF, 0xF, true));
                    const float rn = __builtin_amdgcn_rsqf(s * (1.f / 128.f) + NORM_EPS) * (1.f - LAMBDA_INIT);
                    bf16* Ow = OAp + ((size_t)b * SEQ + qb * 256 + wave * 32 + row) * DM + hh * 128 + half * 64;
#pragma unroll
                    for (int j = 0; j < 8; ++j) { const int chunk = half * 8 + j; f32x4 v0, v1; unpack8(*(const LAS v4u*)(Hw + row * 256 + ((chunk ^ (row & 15)) << 4)), v0, v1);
                        const f32x4 w0 = *(const f32x4*)(subw + chunk * 8), w1 = *(const f32x4*)(subw + chunk * 8 + 4);
                        *(v4u*)(Ow + j * 8) = pack8(v0 * w0 * rn, v1 * w1 * rn); }
                    asm volatile("s_waitcnt lgkmcnt(0)" ::: "memory");
                }
            }
        }
        asm volatile("s_waitcnt vmcnt(0)" ::: "memory"); __syncthreads();
    }
    XSYNC();

    for (int rep_ = 0; rep_ < 1 + ((REPMASK >> 3) & 1); ++rep_) if ((PHMASK >> 3) & 1) {
        pg8::Gemm g{(bf16*)a.out + (size_t)MTOK * DM, CB, Wp_t, DM, 2 * DM, DM / 64}; pg8::StaticOrder S; S.init(MTOK, DM, G, bx);
        pg8::EpiMerge E{SGA, SGB, MG};
        pg8::gemm_phase<pg8::EpiMerge, pg8::StaticOrder, true, true>(L, g, S, E);
    }
    XSYNC();
    for (int rep_ = 0; rep_ < 1 + ((REPMASK >> 4) & 1); ++rep_) if ((PHMASK >> 4) & 1) {
        pg8::Gemm g{MG, MG, Wout_t, DM, DM, DM / 64}; pg8::StaticOrder S; S.init(MTOK, DM, G, bx);
        pg8::EpiResid<true> E{HB, H2B, ss2, rs1};
        pg8::gemm_phase<pg8::EpiResid<true>, pg8::StaticOrder, true, true>(L, g, S, E);
    }
    XSYNC();
    for (int rep_ = 0; rep_ < 1 + ((REPMASK >> 5) & 1); ++rep_) if ((PHMASK >> 5) & 1) {
        pg8::Gemm g{H2B, H2B, Wgu_t, DM, DM, DM / 64}; pg8::StaticOrder S; S.init(MTOK, 2 * DFF, G, bx);
        pg8::EpiGateUp E{ss2, ACT};
        pg8::gemm_phase<pg8::EpiGateUp, pg8::StaticOrder, true, true>(L, g, S, E);
    }
    XSYNC();
    for (int rep_ = 0; rep_ < 1 + ((REPMASK >> 6) & 1); ++rep_) if ((PHMASK >> 6) & 1) {
        pg8::Gemm g{ACT, ACT, Wdn_t, DFF, DFF, DFF / 64}; pg8::StaticOrder S; S.init(MTOK, DM, G, bx);
        pg8::EpiResid<true> E{H2B, H3B, ss3, nullptr};
        pg8::gemm_phase<pg8::EpiResid<true>, pg8::StaticOrder, true, true>(L, g, S, E);
    }
    XSYNC();
    for (int rep_ = 0; rep_ < 1 + ((REPMASK >> 7) & 1); ++rep_) if ((PHMASK >> 7) & 1) {
        PIN_TID();
        const int gw = vcu * 8 + wave, NGW = G * 8; const float* wf = a.in[16];
        f32x4 wv[4];
#pragma unroll
        for (int j = 0; j < 4; ++j) wv[j] = ((const f32x4*)wf)[lane + 64 * j];
        for (int m0 = gw * 4; m0 < MTOK; m0 += NGW * 4) {
            unsigned long long w[4][4]; float r3[4];
#pragma unroll
            for (int r = 0; r < 4; ++r) { const unsigned long long* i8 = (const unsigned long long*)(H3B + (size_t)(m0 + r) * DM) + lane; r3[r] = ss3[m0 + r];
#pragma unroll
                for (int j = 0; j < 4; ++j) w[r][j] = __builtin_nontemporal_load(&i8[64 * j]); }
#pragma unroll
            for (int r = 0; r < 4; ++r) { f32x4* orow = (f32x4*)(a.out + (size_t)(m0 + r) * DM) + lane; const float rr = __builtin_amdgcn_rsqf(r3[r] * (1.f / DM) + NORM_EPS);
#pragma unroll
                for (int j = 0; j < 4; ++j) { const unsigned lo = (unsigned)w[r][j], hi = (unsigned)(w[r][j] >> 32);
                    __builtin_nontemporal_store((f32x4){bf_lo(lo), bf_hi(lo), bf_lo(hi), bf_hi(hi)} * wv[j] * rr, &orow[64 * j]); } }
        }
    }
#undef GSYNC
#undef XSYNC
}
#undef Win_t
#undef Wp_t
#undef Wout_t
#undef Wgu_t
#undef Wdn_t
#undef QO
#undef CB
#undef U
#undef SGA
#undef SGB
#undef KB
#undef VB
#undef MG
#undef H2B
#undef ACT
#undef H3B
#undef ss2
#undef ss3
#undef rs1
#undef PM

extern "C" void kernel_launch(void* const* d_in, const int* in_sizes, int n_in, void* d_out, int out_size, void* d_ws, size_t ws_size, hipStream_t stream) {
    static int grid = 0;
    if (grid == 0) {
        if (n_in != 17 || in_sizes[0] != MTOK * DM || out_size != MTOK * DM || ws_size < WS_END) { fprintf(stderr, "kernel_launch: unexpected shapes / workspace (n_in %d, ws %zu)\n", n_in, ws_size); grid = -1; return; }
        int dev = 0, cus = 0, per_cu = 0;
        if (hipGetDevice(&dev) != hipSuccess || hipDeviceGetAttribute(&cus, hipDeviceAttributeMultiprocessorCount, dev) != hipSuccess) { grid = -1; return; }
        if (hipFuncSetAttribute((const void*)fwd_kernel, hipFuncAttributeMaxDynamicSharedMemorySize, LDS_BYTES) != hipSuccess) { fprintf(stderr, "kernel_launch: hipFuncSetAttribute failed\n"); grid = -1; return; }
        if (hipOccupancyMaxActiveBlocksPerMultiprocessor(&per_cu, (const void*)fwd_kernel, 512, LDS_BYTES) != hipSuccess || per_cu < 1) per_cu = 1;
        (void)hipGetLastError();
        grid = cus * per_cu;
    }
    if (grid < 0) return;
    Args a{};
    for (int i = 0; i < 17; ++i) a.in[i] = (const float*)d_in[i];
    a.out = (float*)d_out; a.ws = (unsigned char*)d_ws;
    void* args[] = {&a};
    hipError_t e = hipLaunchCooperativeKernel((const void*)fwd_kernel, dim3(grid), dim3(512), args, LDS_BYTES, stream);
    if (e != hipSuccess) fprintf(stderr, "kernel_launch: cooperative launch failed: %s (grid %d)\n", hipGetErrorString(e), grid);
}
```

```cpp
#include <hip/hip_runtime.h>
#include <hip/hip_cooperative_groups.h>
#include <hip/hip_bf16.h>
#include <cstdio>
#include <cstdint>
#include <cmath>
namespace pg8 {
#define PG8_LAS __attribute__((address_space(3)))
typedef unsigned short bf16_t;
typedef short bf16x8 __attribute__((ext_vector_type(8)));
typedef float f32x4 __attribute__((ext_vector_type(4)));
typedef unsigned u32x4 __attribute__((ext_vector_type(4)));
constexpr int BM = 256, BK = 64, HALF = 128, HTB = HALF * BK * 2  , STAGE_BYTES = 8 * HTB, NXCD = 8, WGM = 8;

__host__ __device__ __forceinline__ int lds_byte(int r, int c) { const int st = (r >> 4) * 2 + (c >> 5), rr = r & 15, cc = c & 31, ob = rr * 64 + cc * 2; return st * 1024 + (ob ^ (((ob >> 9) & 1) << 5)); }
__host__ __device__ __forceinline__ void stage_rc(int b, int& R, int& C) { const int st = b / 1024, sb = b % 1024, swz = sb ^ (((sb >> 9) & 1) << 5); R = (st >> 1) * 16 + swz / 64; C = (st & 1) * 32 + (swz % 64) / 2; }
__host__ __device__ __forceinline__ int perm32(int rho) { const int n = rho >> 4, i = rho & 15; return 8 * (i >> 2) + 4 * n + (i & 3); }

struct Unit { int pm, pn; };
struct Gemm { const bf16_t* A; const bf16_t* A2; const bf16_t* Bt; int lda, K, ks; };

struct StaticOrder {
    int nM, nN, nwg, G, c;
    __host__ __device__ void init(int M, int N, int G_, int c_) { nM = M / BM; nN = N / BM; nwg = nM * nN; G = G_; c = c_; }
    __host__ __device__ bool next(int i, Unit& u) const {
        const long L = (long)i * G + c; if (L >= nwg) return false;
        int wgid = (int)L; { const int q = nwg / NXCD, r = nwg % NXCD, xcd = wgid % NXCD, off = wgid / NXCD; wgid = (xcd < r ? xcd * (q + 1) : r * (q + 1) + (xcd - r) * q) + off; }
        const int nig = WGM * nN, gid = wgid / nig, fm = gid * WGM, gsz = (nM - fm) < WGM ? (nM - fm) : WGM;
        u.pm = fm + ((wgid % nig) % gsz); u.pn = (wgid % nig) / gsz; return true;
    }
    __device__ __forceinline__ void a_ready(const Unit&) const {}
    __device__ __forceinline__ void done(const Unit&) const {}
};

typedef float cvt_f32x2_t __attribute__((ext_vector_type(2))); typedef __bf16 cvt_bf16x2_t __attribute__((ext_vector_type(2)));
__device__ __forceinline__ unsigned cvt_pk_bf16(float lo, float hi) { const cvt_f32x2_t v = {lo, hi}; const cvt_bf16x2_t b = __builtin_convertvector(v, cvt_bf16x2_t); return __builtin_bit_cast(unsigned, b); }
template <class Epi, class Sched, bool ALIGN_EPI = false, bool SP2 = false>
__device__ __forceinline__ void gemm_phase(PG8_LAS unsigned char* lds, const Gemm g, const Sched& S, const Epi& E) {
    int tid_ = threadIdx.x; asm volatile("" : "+v"(tid_));
    const int tid = tid_, wid = __builtin_amdgcn_readfirstlane(tid >> 6), lane = tid & 63, wr = wid >> 2, wc = wid & 3, fr = lane & 15, fq = lane >> 4;
    const int K = g.K, nt = K / BK, ks = g.ks, lda = g.lda;
    unsigned voffA[2], voffB[2];
#pragma unroll
    for (int i = 0; i < 2; ++i) { int R, C; stage_rc(tid * 16 + i * 8192, R, C); const int Rb = Epi::PERM ? ((R & ~31) + perm32(R & 31)) : R;
        voffA[i] = (unsigned)(R * lda + C) * 2u; voffB[i] = (unsigned)(Rb * K + C) * 2u; }
    const size_t kstep = (size_t)(BK * 2);
    const size_t hstepA = (size_t)HALF * lda * 2, hstepB = (size_t)HALF * K * 2;
    const size_t tstepA = 2 * hstepA, tstepB = 2 * hstepB;
    const unsigned ldsw = (unsigned)wid * 1024u;
    const int aoff = lds_byte(wr * 64 + fr, fq * 8), boff = lds_byte(wc * 32 + fr, fq * 8);
#define PG8_SA(b, h) (((b) * 2 + (h)) * HTB)
#define PG8_SB(b, h) ((4 + (b) * 2 + (h)) * HTB)
#define PG8_STAGE(bufoff, gbase, voff) do { _Pragma("unroll") for (int _i = 0; _i < 2; ++_i) \
        __builtin_amdgcn_global_load_lds((const unsigned*)((const char*)(gbase) + (voff)[_i]), (PG8_LAS unsigned*)(lds + (bufoff) + ldsw + _i * 8192), 16, 0, 0); } while (0)
#define PG8_LDA(dst, b, h) do { _Pragma("unroll") for (int m = 0; m < 4; ++m) _Pragma("unroll") for (int k = 0; k < 2; ++k) dst[m][k] = *(const PG8_LAS bf16x8*)(lds + PG8_SA(b, h) + aoff + m * 2048 + k * 1024); } while (0)
#define PG8_LDB(dst, b, h) do { _Pragma("unroll") for (int n = 0; n < 2; ++n) _Pragma("unroll") for (int k = 0; k < 2; ++k) dst[n][k] = *(const PG8_LAS bf16x8*)(lds + PG8_SB(b, h) + boff + n * 2048 + k * 1024); } while (0)
#define PG8_MMA(ai, bj, At, Bt) do { __builtin_amdgcn_s_setprio(1); _Pragma("unroll") for (int m = 0; m < 4; ++m) _Pragma("unroll") for (int n = 0; n < 2; ++n) _Pragma("unroll") for (int k = 0; k < 2; ++k) \
        acc[ai][bj][m][n] = __builtin_amdgcn_mfma_f32_16x16x32_bf16(Bt[n][k], At[m][k], acc[ai][bj][m][n], 0, 0, 0); __builtin_amdgcn_s_setprio(0); } while (0)
#define PG8_WAIT_V(n) asm volatile("s_waitcnt vmcnt(" #n ")" ::: "memory")
#define PG8_WAIT_L(n) asm volatile("s_waitcnt lgkmcnt(" #n ")" ::: "memory")
#define PG8_BAR __builtin_amdgcn_s_barrier()
#define PG8_SCHED __builtin_amdgcn_sched_barrier(0)
    Unit cur, nxt; int ui = 0;
    if (!S.next(0, cur)) return;
    f32x4 acc[2][2][4][2];
#pragma unroll
    for (int a = 0; a < 2; ++a)
#pragma unroll
        for (int b = 0; b < 2; ++b)
#pragma unroll
            for (int m = 0; m < 4; ++m)
#pragma unroll
                for (int n = 0; n < 2; ++n) acc[a][b][m][n] = (f32x4){0.f, 0.f, 0.f, 0.f};
    bf16x8 At[4][2], B0[2][2], B1[2][2];
    const char* cA = (const char*)g.A + (size_t)cur.pm * tstepA; const char* cA2 = (const char*)g.A2 + (size_t)cur.pm * tstepA; const char* cB = (const char*)g.Bt + (size_t)cur.pn * tstepB;
    S.a_ready(cur);
    if constexpr (SP2) {
        PG8_STAGE(PG8_SB(0, 0), cB, voffB); PG8_STAGE(PG8_SB(0, 1), cB + hstepB, voffB); PG8_STAGE(PG8_SA(0, 0), cA, voffA); PG8_STAGE(PG8_SA(0, 1), cA + hstepA, voffA);
        if (wr == 1) PG8_BAR;
        PG8_WAIT_V(2); PG8_BAR;
        PG8_STAGE(PG8_SB(1, 0), cB + kstep, voffB); PG8_STAGE(PG8_SA(1, 0), cA + kstep, voffA); PG8_STAGE(PG8_SB(1, 1), cB + hstepB + kstep, voffB);
        PG8_WAIT_V(6); PG8_BAR;
    } else {
        PG8_STAGE(PG8_SB(0, 0), cB, voffB); PG8_STAGE(PG8_SA(0, 0), cA, voffA); PG8_STAGE(PG8_SB(0, 1), cB + hstepB, voffB); PG8_STAGE(PG8_SA(0, 1), cA + hstepA, voffA);
        if (wr == 1) PG8_BAR;
        PG8_WAIT_V(4); PG8_BAR;
        PG8_STAGE(PG8_SB(1, 0), cB + kstep, voffB); PG8_STAGE(PG8_SA(1, 0), cA + kstep, voffA); PG8_STAGE(PG8_SB(1, 1), cB + hstepB + kstep, voffB);
        PG8_WAIT_V(6); PG8_BAR;
    }
    for (;;) {
        const bool has_next = S.next(ui + 1, nxt);
        const char* nA = has_next ? (const char*)g.A + (size_t)nxt.pm * tstepA : cA; const char* nA2 = has_next ? (const char*)g.A2 + (size_t)nxt.pm * tstepA : cA2; const char* nB = has_next ? (const char*)g.Bt + (size_t)nxt.pn * tstepB : cB;
        for (int t = 0; t < nt; t += 2) {
            const bool last = (t == nt - 2);
#define PG8_ATILE(tt) ((tt) < ks ? cA + (size_t)(tt) * kstep : cA2 + (size_t)((tt) - ks) * kstep)
            if constexpr (Epi::MID) { if (t == ks) E.mid(acc, cur, wr, wc, fr, fq); }
            const char* a1 = PG8_ATILE(t + 1);
            const char* a2 = last ? nA : PG8_ATILE(t + 2); const char* b2 = last ? nB : cB + (size_t)(t + 2) * kstep;
            const char* a3 = last ? nA + kstep : PG8_ATILE(t + 3); const char* b3 = b2 + kstep;
            if (last && has_next) S.a_ready(nxt);
            if constexpr (SP2) {
            PG8_LDB(B0, 0, 0); PG8_LDB(B1, 0, 1); PG8_SCHED; PG8_LDA(At, 0, 0); PG8_STAGE(PG8_SA(1, 1), a1 + hstepA, voffA);
            PG8_WAIT_V(8); PG8_WAIT_L(0); PG8_BAR; PG8_MMA(0, 0, At, B0); PG8_MMA(0, 1, At, B1); PG8_BAR; PG8_SCHED;
            PG8_LDA(At, 0, 1); PG8_STAGE(PG8_SB(0, 0), b2, voffB); PG8_STAGE(PG8_SB(0, 1), b2 + hstepB, voffB); PG8_STAGE(PG8_SA(0, 0), a2, voffA);
            PG8_WAIT_V(8); PG8_WAIT_L(0); PG8_BAR; PG8_MMA(1, 0, At, B0); PG8_MMA(1, 1, At, B1); PG8_BAR; PG8_SCHED;
            PG8_LDB(B0, 1, 0); PG8_LDB(B1, 1, 1); PG8_SCHED; PG8_LDA(At, 1, 0); PG8_STAGE(PG8_SA(0, 1), a2 + hstepA, voffA);
            PG8_WAIT_V(8); PG8_WAIT_L(0); PG8_BAR; PG8_MMA(0, 0, At, B0); PG8_MMA(0, 1, At, B1); PG8_BAR; PG8_SCHED;
            PG8_LDA(At, 1, 1); PG8_STAGE(PG8_SB(1, 0), b3, voffB); PG8_STAGE(PG8_SB(1, 1), b3 + hstepB, voffB); PG8_STAGE(PG8_SA(1, 0), a3, voffA);
            PG8_WAIT_V(8); PG8_WAIT_L(0); PG8_BAR; PG8_MMA(1, 0, At, B0); PG8_MMA(1, 1, At, B1); PG8_BAR; PG8_SCHED;
            } else {
            PG8_LDB(B0, 0, 0); PG8_SCHED; PG8_LDA(At, 0, 0); PG8_STAGE(PG8_SA(1, 1), a1 + hstepA, voffA);
            PG8_WAIT_L(8); PG8_BAR; PG8_WAIT_L(0); PG8_MMA(0, 0, At, B0); PG8_BAR; PG8_SCHED;
            PG8_LDB(B1, 0, 1); PG8_STAGE(PG8_SB(0, 0), b2, voffB);
            PG8_BAR; PG8_WAIT_L(0); PG8_MMA(0, 1, At, B1); PG8_BAR;
            PG8_LDA(At, 0, 1); PG8_STAGE(PG8_SA(0, 0), a2, voffA);
            PG8_BAR; PG8_WAIT_L(0); PG8_MMA(1, 0, At, B0); PG8_BAR; PG8_SCHED;
            PG8_STAGE(PG8_SB(0, 1), b2 + hstepB, voffB);
            PG8_WAIT_V(6); PG8_BAR; PG8_MMA(1, 1, At, B1); PG8_BAR;
            PG8_LDB(B0, 1, 0); PG8_SCHED; PG8_LDA(At, 1, 0); PG8_STAGE(PG8_SA(0, 1), a2 + hstepA, voffA);
            PG8_WAIT_L(8); PG8_BAR; PG8_WAIT_L(0); PG8_MMA(0, 0, At, B0); PG8_BAR; PG8_SCHED;
            PG8_LDB(B1, 1, 1); PG8_STAGE(PG8_SB(1, 0), b3, voffB);
            PG8_BAR; PG8_WAIT_L(0); PG8_MMA(0, 1, At, B1); PG8_BAR;
            PG8_LDA(At, 1, 1); PG8_STAGE(PG8_SA(1, 0), a3, voffA);
            PG8_BAR; PG8_WAIT_L(0); PG8_MMA(1, 0, At, B0); PG8_BAR; PG8_SCHED;
            PG8_STAGE(PG8_SB(1, 1), b3 + hstepB, voffB);
            PG8_WAIT_V(6); PG8_BAR; PG8_MMA(1, 1, At, B1); PG8_BAR;
            }
        }
        if constexpr (ALIGN_EPI) { if (wr == 0) PG8_BAR; }
        if constexpr (!Epi::AFTER_DRAIN) { E(acc, cur, wr, wc, fr, fq); S.done(cur); }
        if (!has_next) break;
#pragma unroll
        for (int a = 0; a < 2; ++a)
#pragma unroll
            for (int b = 0; b < 2; ++b)
#pragma unroll
                for (int m = 0; m < 4; ++m)
#pragma unroll
                    for (int n = 0; n < 2; ++n) acc[a][b][m][n] = (f32x4){0.f, 0.f, 0.f, 0.f};
        cur = nxt; cA = nA; cA2 = nA2; cB = nB; ++ui;
        if constexpr (ALIGN_EPI) { if (wr == 1) PG8_BAR; }
    }
    PG8_WAIT_V(0);
    if constexpr (!ALIGN_EPI) { if (wr == 0) PG8_BAR; }
    PG8_BAR;
    if constexpr (Epi::AFTER_DRAIN) { E.fused(acc, cur, wr, wc, fr, fq, lds, wid, lane); S.done(cur); }
#undef PG8_SA
#undef PG8_ATILE
#undef PG8_SB
#undef PG8_STAGE
#undef PG8_LDA
#undef PG8_LDB
#undef PG8_MMA
#undef PG8_WAIT_V
#undef PG8_WAIT_L
#undef PG8_BAR
#undef PG8_SCHED
}
}

namespace attn_body {
using bf16=__hip_bfloat16;
using bf16x8=__attribute__((ext_vector_type(8)))short;
using s16x4=__attribute__((ext_vector_type(4)))short;
using f32x16=__attribute__((ext_vector_type(16)))float;
using u32x4=__attribute__((ext_vector_type(4)))unsigned;
constexpr int D=64,DM=1024;
constexpr int NW=8,QBLK=32,QB=QBLK*NW,KVBLK=64;
constexpr int ATTN_PITCH=DM, ATTN_UNIT_ROWS=QB;
__device__ __forceinline__ int crow(int r,int hi){return (r&3)+8*(r>>2)+4*hi;}
#define SBAR() __builtin_amdgcn_sched_barrier(0)
__device__ __forceinline__ void cmask(f32x16&p0,f32x16&p1,int jb,int qrel,int hi){
  const float NEG=-INFINITY; int kb=64*jb+4*hi;
  #pragma unroll
  for(int r=0;r<16;++r){int kv=kb+(r&3)+8*(r>>2); if(kv>qrel)p0[r]=NEG; if(kv+32>qrel)p1[r]=NEG;}
}

constexpr int NSLOT=3, SLOTB=8192;
constexpr int LDS_K=0, LDS_V=NSLOT*SLOTB, LDS_WS=LDS_V+2*NSLOT*SLOTB, LDS_H=LDS_WS+NW*64*4, LDS_BYTES=LDS_H+NW*8192;
constexpr float C2=0.125f*1.4426950408889634f;
__device__ __forceinline__ void glds16(const void*gsrc,unsigned lds_dst){unsigned keep;
  asm volatile("s_mov_b32 %0, m0\n\ts_mov_b32 m0, %2\n\ts_nop 0\n\tglobal_load_lds_dwordx4 %1, off\n\ts_mov_b32 m0, %0":"=&s"(keep):"v"(gsrc),"s"(lds_dst):"memory");}
__device__ __forceinline__ void glds16s(const void*sbase,unsigned voff,unsigned lds_dst){unsigned keep;
  asm volatile("s_nop 4\n\ts_mov_b32 %0, m0\n\ts_mov_b32 m0, %2\n\ts_nop 0\n\tglobal_load_lds_dwordx4 %1, %3\n\ts_mov_b32 m0, %0":"=&s"(keep):"v"(voff),"s"(lds_dst),"s"(sbase):"memory");}
__device__ __forceinline__ float max3f(float a,float b,float c){float r;asm("v_max3_f32 %0, %1, %2, %3":"=v"(r):"v"(a),"v"(b),"v"(c));return r;}
__device__ __forceinline__ float max2f(float a,float b){float r;asm("v_max_f32_e32 %0, %1, %2":"=v"(r):"v"(a),"v"(b));return r;}
__device__ __forceinline__ float fadd_s(float a,float b){float r;asm("v_add_f32_e32 %0, %1, %2":"=v"(r):"v"(a),"v"(b));return r;}
__device__ __forceinline__ float fsub_s(float a,float b){float r;asm("v_sub_f32_e32 %0, %1, %2":"=v"(r):"v"(a),"v"(b));return r;}
typedef float f32x2_t __attribute__((ext_vector_type(2))); typedef __bf16 bf16x2_t __attribute__((ext_vector_type(2)));
__device__ __forceinline__ unsigned cvtpk_s(float lo,float hi){f32x2_t v={lo,hi};bf16x2_t b=__builtin_convertvector(v,bf16x2_t);return __builtin_bit_cast(unsigned,b);}
#define WAIT_BAR(N) asm volatile("s_waitcnt vmcnt(" #N ") lgkmcnt(0)\n\ts_barrier":::"memory")

__device__ __forceinline__ void qkt(f32x16&p0,f32x16&p1,const char*Kslot,const bf16x8*qr,int r32,int hi){ const f32x16 zc=f32x16{};
  const char*kb=Kslot+hi*1024+r32*16;
  #pragma unroll
  for(int d0=0;d0<4;++d0){
    const bf16x8 b0=*reinterpret_cast<const bf16x8*>(kb+d0*2048);
    const bf16x8 b1=*reinterpret_cast<const bf16x8*>(kb+d0*2048+512);
    if(d0==0){p0=__builtin_amdgcn_mfma_f32_32x32x16_bf16(b0,qr[0],zc,0,0,0);p1=__builtin_amdgcn_mfma_f32_32x32x16_bf16(b1,qr[0],zc,0,0,0);}
    else{p0=__builtin_amdgcn_mfma_f32_32x32x16_bf16(b0,qr[d0],p0,0,0,0);p1=__builtin_amdgcn_mfma_f32_32x32x16_bf16(b1,qr[d0],p1,0,0,0);}}
}
typedef __attribute__((address_space(3))) const char* lds_cptr;
typedef short v4i16_t __attribute__((ext_vector_type(4)));
__device__ __forceinline__ void kload8(bf16x8*kf,lds_cptr kp){
  kf[0]=*(const __attribute__((address_space(3))) bf16x8*)(kp);      kf[1]=*(const __attribute__((address_space(3))) bf16x8*)(kp+512);
  kf[2]=*(const __attribute__((address_space(3))) bf16x8*)(kp+2048); kf[3]=*(const __attribute__((address_space(3))) bf16x8*)(kp+2560);
  kf[4]=*(const __attribute__((address_space(3))) bf16x8*)(kp+4096); kf[5]=*(const __attribute__((address_space(3))) bf16x8*)(kp+4608);
  kf[6]=*(const __attribute__((address_space(3))) bf16x8*)(kp+6144); kf[7]=*(const __attribute__((address_space(3))) bf16x8*)(kp+6656);
}
__device__ __forceinline__ void kload2(bf16x8*kf,lds_cptr kp,int j){ kf[2*j]=*(const __attribute__((address_space(3))) bf16x8*)(kp+j*2048); kf[2*j+1]=*(const __attribute__((address_space(3))) bf16x8*)(kp+j*2048+512); }
__device__ __forceinline__ s16x4 vtr(lds_cptr p){ return __builtin_bit_cast(s16x4,__builtin_amdgcn_ds_read_tr16_b64_v4i16((__attribute__((address_space(3))) v4i16_t*)p)); }
__device__ __forceinline__ float rowmax(const f32x16&p0,const f32x16&p1){
  float a=max3f(p0[0],p0[1],p1[0]),b=max3f(p0[2],p0[3],p1[1]);a=max3f(a,p1[2],p1[3]);
  #pragma unroll
  for(int r=4;r<16;r+=4){a=max3f(a,p0[r],p0[r+1]);b=max3f(b,p0[r+2],p0[r+3]);a=max3f(a,p1[r],p1[r+1]);b=max3f(b,p1[r+2],p1[r+3]);}
  const float m=max2f(a,b);
  auto rr=__builtin_amdgcn_permlane32_swap(__float_as_uint(m),__float_as_uint(m),false,false);
  return max2f(__uint_as_float(rr[0]),__uint_as_float(rr[1]));
}
__device__ __forceinline__ void pv(f32x16*o,int vb,bf16x8 pa0,bf16x8 pa1,bf16x8 pa2,bf16x8 pa3){
  #pragma unroll
  for(int d0=0;d0<2;++d0){s16x4 lo[4],hi[4];
    #pragma unroll
    for(int ks=0;ks<4;++ks){
      asm volatile("ds_read_b64_tr_b16 %0,%1 offset:%c2":"=&v"(lo[ks]):"v"(vb),"i"(d0*4096+ks*1024):"memory");
      asm volatile("ds_read_b64_tr_b16 %0,%1 offset:%c2":"=&v"(hi[ks]):"v"(vb),"i"(d0*4096+ks*1024+512):"memory");}
    asm volatile("s_waitcnt lgkmcnt(0)":::"memory");SBAR();
    #define PK(k) (bf16x8){lo[k][0],lo[k][1],lo[k][2],lo[k][3],hi[k][0],hi[k][1],hi[k][2],hi[k][3]}
    o[d0]=__builtin_amdgcn_mfma_f32_32x32x16_bf16(pa0,PK(0),o[d0],0,0,0);
    o[d0]=__builtin_amdgcn_mfma_f32_32x32x16_bf16(pa1,PK(1),o[d0],0,0,0);
    o[d0]=__builtin_amdgcn_mfma_f32_32x32x16_bf16(pa2,PK(2),o[d0],0,0,0);
    o[d0]=__builtin_amdgcn_mfma_f32_32x32x16_bf16(pa3,PK(3),o[d0],0,0,0);
    #undef PK
  }
}

#ifndef ATTN_STORE16
#define ATTN_STORE16(p,v) (*(u32x4*)(p)=(v))
#endif
template<int THRL> __device__ __forceinline__ void attn_pass(const bf16*Qw,const bf16*__restrict__ Kh,const bf16*__restrict__ Vh,int NT,int m_sub,float lam,char*shm,const bf16*Kh_next,bool has_next,bool prefetched){
  const int tid=threadIdx.x; int lane_=tid&63; asm volatile("":"+v"(lane_));
  const int lane=lane_,r32=lane&31,hi=lane>>5; const int wid=__builtin_amdgcn_readfirstlane(tid>>6);
  if(wid>=4)__builtin_amdgcn_s_setprio(1);
  const unsigned lds0=(unsigned)(uintptr_t)shm;
  float*wsf=(float*)(shm+LDS_WS)+wid*64;
  const bf16*ksrc=Kh+wid*8; const unsigned koff=(unsigned)lane*(DM*2);
  const bf16*vsrc=Vh+(long)(16*(wid&3))*DM+(wid>>2)*32; const unsigned voff=(unsigned)(lane>>2)*(DM*2)+(unsigned)(lane&3)*16;
  const unsigned kdst=lds0+LDS_K+wid*1024, vdst=lds0+LDS_V+wid*1024;
  #define DMA_K(t,slot) glds16s(ksrc+(long)(t)*KVBLK*DM,koff,(unsigned)__builtin_amdgcn_readfirstlane(kdst+(slot)))
  #define DMA_V(t,slot) do{ glds16s(vsrc+(long)(t)*KVBLK*DM,voff,(unsigned)__builtin_amdgcn_readfirstlane(vdst+2*(slot))); glds16s(vsrc+(long)(t)*KVBLK*DM+64,voff,(unsigned)__builtin_amdgcn_readfirstlane(vdst+2*(slot)+8192)); }while(0)
  const int vb0=(int)(lds0+LDS_V)+((lane>>4)&1)*32+(lane&3)*8+(4*hi+((lane&15)>>2))*64;
  const char*Kbase=shm+LDS_K; bf16x8 kf[8];
  const lds_cptr shm3=(lds_cptr)shm; const lds_cptr kp0=shm3+LDS_K+hi*1024+r32*16; const lds_cptr vp0=shm3+LDS_V+((lane>>4)&1)*32+(lane&3)*8+(4*hi+((lane&15)>>2))*64;
  if(!prefetched){DMA_K(0,0);DMA_V(0,0);DMA_K(1,SLOTB);}
  bf16x8 qr[4];
  #pragma unroll
  for(int d0=0;d0<4;++d0)qr[d0]=*reinterpret_cast<const bf16x8*>(&Qw[(long)r32*DM+d0*16+hi*8]);
  float mhat=0.f,l_reg=0.f;f32x16 o[4]; { float z_; asm volatile("v_mov_b32 %0, 0":"=v"(z_)); _Pragma("unroll") for(int r=0;r<16;++r){o[0][r]=z_;o[1][r]=z_;o[2][r]=z_;o[3][r]=z_;} }
  const int qrel=wid*QBLK+r32;
  #define CMASK(P0,P1,t) do{int jb_=(t)-(NT-4); if(jb_>=0)cmask(P0,P1,jb_,qrel,hi);}while(0)
  bool resc=false;
  #define START(P0,P1) do{ const float rm=rowmax(P0,P1); resc=false; \
    { const float dl=rm; mhat=fadd_s(mhat,dl); \
      _Pragma("unroll") for(int r=0;r<16;++r){P0[r]=fsub_s(P0[r],dl);P1[r]=fsub_s(P1[r],dl);} \
      } \
    _Pragma("unroll") for(int r=0;r<16;++r)P0[r]=__builtin_amdgcn_exp2f(P0[r]); }while(0)
  #define RESC() do{ if(resc){ asm volatile("s_waitcnt lgkmcnt(0)":::"memory"); \
      _Pragma("unroll") for(int d_=0;d_<4;++d_) _Pragma("unroll") for(int r=0;r<16;++r)o[d_][r]*=wsf[crow(r,hi)]; } }while(0)
  f32x16 pA0,pA1,pB0,pB1;
  int sl_prev=0,sl_cur=0,sl_next=SLOTB;
  #define ROT() do{sl_prev=sl_cur;sl_cur=sl_next;sl_next=(sl_next==(NSLOT-1)*SLOTB)?0:sl_next+SLOTB;}while(0)
  DMA_K(2,2*SLOTB);
  WAIT_BAR(4);
  qkt(pA0,pA1,Kbase,qr,r32,hi);asm volatile("s_nop 15\n\ts_nop 7":"+v"(pA0),"+v"(pA1));
  { _Pragma("unroll") for(int r=8;r<16;++r)pA0[r]=-INFINITY; _Pragma("unroll") for(int r=0;r<16;++r)pA1[r]=-INFINITY; }
  START(pA0,pA1);
  _Pragma("unroll") for(int r=0;r<16;++r)pA1[r]=__builtin_amdgcn_exp2f(pA1[r]);
  WAIT_BAR(0);
  DMA_K(3,0);DMA_V(1,SLOTB);
  ROT();
  kload8(kf,kp0+sl_cur);
  WAIT_BAR(3);
  s16x4 vlo[8],vhi[8]; u32x4 pw0,pw1,pw2,pw3;
  #define PKW(P,B) cvtpk_s(P[B],P[B+1])
  #define PAF(k) __builtin_bit_cast(bf16x8,pw##k)
  #define VFR(i) (bf16x8){vlo[i][0],vlo[i][1],vlo[i][2],vlo[i][3],vhi[i][0],vhi[i][1],vhi[i][2],vhi[i][3]}
  #define PIN(x) asm volatile("":"+v"(x))
  #define MX3(a,b,c) __builtin_fmaxf(__builtin_fmaxf((a),(b)),(c))
  #define GAPA(MF,A0,A1,A2,A3,W0,W1,PW) do{ MF; sacc+=A0; sacc+=A1; sacc+=A2; sacc+=A3; PIN(sacc); W0; W1; PIN(PW); SBAR(); }while(0)
  #define EX(v) __builtin_amdgcn_exp2f(v)
  #define GAPB(MF,X,B) do{ MF; X[B]=EX(X[B]); X[B+1]=EX(X[B+1]); X[B+2]=EX(X[B+2]); X[B+3]=EX(X[B+3]); PIN(X); SBAR(); }while(0)
  #define GAPB2(MF,RD,X,B) do{ MF; RD; X[B]=EX(X[B]); X[B+1]=EX(X[B+1]); PIN(X); SBAR(); }while(0)
  #define VRD2(i) do{ vlo[i]=vtr(vp2_+(((i)>>2)*4096+((i)&3)*1024)); vhi[i]=vtr(vp2_+(((i)>>2)*4096+((i)&3)*1024+512)); }while(0)
  #define VRD(i) do{ vlo[i]=vtr(vp_+(((i)>>2)*4096+((i)&3)*1024)); vhi[i]=vtr(vp_+(((i)>>2)*4096+((i)&3)*1024+512)); }while(0)
  #define KRD(G,j) do{ if(G){ kload2(kf,kp0+sl_next,j); SBAR(); } }while(0)
  #define STEP(C0,C1,P0,P1,t,GK,GV,GL) do{ SBAR(); \
    const lds_cptr vp_=vp0+2*sl_prev; \
    VRD(0); SBAR(); float sacc=(P0[0]+P0[1]); \
    GAPA(C0=__builtin_amdgcn_mfma_f32_32x32x16_bf16(kf[0],qr[0],f32x16{},0,0,0), P0[2],P0[3],P0[4],P0[5],     pw0[0]=PKW(P0,0), pw0[1]=PKW(P0,2), pw0); \
    VRD(4); SBAR(); GAPA(C1=__builtin_amdgcn_mfma_f32_32x32x16_bf16(kf[1],qr[0],f32x16{},0,0,0), P0[6],P0[7],P0[8],P0[9],     pw0[2]=PKW(P0,4), pw0[3]=PKW(P0,6), pw0); \
    VRD(1); SBAR(); GAPA(C0=__builtin_amdgcn_mfma_f32_32x32x16_bf16(kf[2],qr[1],C0,0,0,0),   P0[10],P0[11],P0[12],P0[13], pw1[0]=PKW(P0,8), pw1[1]=PKW(P0,10), pw1); \
    VRD(5); SBAR(); GAPA(C1=__builtin_amdgcn_mfma_f32_32x32x16_bf16(kf[3],qr[1],C1,0,0,0),   P0[14],P0[15],P1[0],P1[1],   pw1[2]=PKW(P0,12),pw1[3]=PKW(P0,14), pw1); \
    VRD(2); SBAR(); GAPA(C0=__builtin_amdgcn_mfma_f32_32x32x16_bf16(kf[4],qr[2],C0,0,0,0),   P1[2],P1[3],P1[4],P1[5],     pw2[0]=PKW(P1,0), pw2[1]=PKW(P1,2), pw2); \
    VRD(6); SBAR(); GAPA(C1=__builtin_amdgcn_mfma_f32_32x32x16_bf16(kf[5],qr[2],C1,0,0,0),   P1[6],P1[7],P1[8],P1[9],     pw2[2]=PKW(P1,4), pw2[3]=PKW(P1,6), pw2); \
    VRD(3); SBAR(); GAPA(C0=__builtin_amdgcn_mfma_f32_32x32x16_bf16(kf[6],qr[3],C0,0,0,0),   P1[10],P1[11],P1[12],P1[13], pw3[0]=PKW(P1,8), pw3[1]=PKW(P1,10), pw3); \
    VRD(7); SBAR(); GAPA(C1=__builtin_amdgcn_mfma_f32_32x32x16_bf16(kf[7],qr[3],C1,0,0,0),   P1[14],P1[15],0.f,0.f,       pw3[2]=PKW(P1,12),pw3[3]=PKW(P1,14), pw3); \
    l_reg+=sacc; \
    _Pragma("unroll") for(int r=0;r<16;++r){C0[r]-=mhat;C1[r]-=mhat;} \
    if(GK){DMA_K((t)+3,sl_cur);} if(GV){DMA_V((t)+1,sl_next);} \
    CMASK(C0,C1,t); \
    { float a=MX3(C0[0],C0[1],C1[0]),b=MX3(C0[2],C0[3],C1[1]); a=MX3(a,C1[2],C1[3]); \
      _Pragma("unroll") for(int r=4;r<16;r+=4){a=MX3(a,C0[r],C0[r+1]);b=MX3(b,C0[r+2],C0[r+3]);a=MX3(a,C1[r],C1[r+1]);b=MX3(b,C1[r+2],C1[r+3]);} \
      float rm=__builtin_fmaxf(a,b); { auto rr=__builtin_amdgcn_permlane32_swap(__float_as_uint(rm),__float_as_uint(rm),false,false); rm=__builtin_fmaxf(__uint_as_float(rr[0]),__uint_as_float(rr[1])); } \
      resc=false; \
      if(__builtin_expect(__any(rm>(float)THRL),0)){ const float dl=__builtin_fmaxf(rm,0.f); mhat+=dl; \
        _Pragma("unroll") for(int r=0;r<16;++r){C0[r]-=dl;C1[r]-=dl;} \
        const float f=__builtin_amdgcn_exp2f(-dl); l_reg*=f; if(hi==0)wsf[r32]=f; resc=true; } } \
    SBAR(); \
    const lds_cptr vp2_=vp0+2*sl_prev+8192; \
    GAPB2(o[0]=__builtin_amdgcn_mfma_f32_32x32x16_bf16(PAF(0),VFR(0),o[0],0,0,0), VRD2(0), C0,0); \
    GAPB2(o[1]=__builtin_amdgcn_mfma_f32_32x32x16_bf16(PAF(0),VFR(4),o[1],0,0,0), VRD2(4), C0,2); \
    GAPB2(o[0]=__builtin_amdgcn_mfma_f32_32x32x16_bf16(PAF(1),VFR(1),o[0],0,0,0), VRD2(1), C0,4); \
    GAPB2(o[1]=__builtin_amdgcn_mfma_f32_32x32x16_bf16(PAF(1),VFR(5),o[1],0,0,0), VRD2(5), C0,6); \
    GAPB2(o[0]=__builtin_amdgcn_mfma_f32_32x32x16_bf16(PAF(2),VFR(2),o[0],0,0,0), VRD2(2), C0,8); \
    GAPB2(o[1]=__builtin_amdgcn_mfma_f32_32x32x16_bf16(PAF(2),VFR(6),o[1],0,0,0), VRD2(6), C0,10); \
    GAPB2(o[0]=__builtin_amdgcn_mfma_f32_32x32x16_bf16(PAF(3),VFR(3),o[0],0,0,0), VRD2(3), C0,12); \
    GAPB2(o[1]=__builtin_amdgcn_mfma_f32_32x32x16_bf16(PAF(3),VFR(7),o[1],0,0,0), VRD2(7), C0,14); \
    KRD(GL,0); GAPB2(o[2]=__builtin_amdgcn_mfma_f32_32x32x16_bf16(PAF(0),VFR(0),o[2],0,0,0), (void)0, C1,0); \
    KRD(GL,1); GAPB2(o[3]=__builtin_amdgcn_mfma_f32_32x32x16_bf16(PAF(0),VFR(4),o[3],0,0,0), (void)0, C1,2); \
    KRD(GL,2); GAPB2(o[2]=__builtin_amdgcn_mfma_f32_32x32x16_bf16(PAF(1),VFR(1),o[2],0,0,0), (void)0, C1,4); \
    KRD(GL,3); GAPB2(o[3]=__builtin_amdgcn_mfma_f32_32x32x16_bf16(PAF(1),VFR(5),o[3],0,0,0), (void)0, C1,6); \
    GAPB2(o[2]=__builtin_amdgcn_mfma_f32_32x32x16_bf16(PAF(2),VFR(2),o[2],0,0,0), (void)0, C1,8); \
    GAPB2(o[3]=__builtin_amdgcn_mfma_f32_32x32x16_bf16(PAF(2),VFR(6),o[3],0,0,0), (void)0, C1,10); \
    GAPB2(o[2]=__builtin_amdgcn_mfma_f32_32x32x16_bf16(PAF(3),VFR(3),o[2],0,0,0), (void)0, C1,12); \
    GAPB2(o[3]=__builtin_amdgcn_mfma_f32_32x32x16_bf16(PAF(3),VFR(7),o[3],0,0,0), (void)0, C1,14); \
    }while(0)
  int t=1;
  #undef CMASK
  #define CMASK(P0,P1,t) do{}while(0)
  for(;t+5<NT;t+=2){
    STEP(pB0,pB1,pA0,pA1,t,true,true,true);     WAIT_BAR(3); RESC(); ROT();
    STEP(pA0,pA1,pB0,pB1,t+1,true,true,true);   WAIT_BAR(3); RESC(); ROT();
  }
  #undef CMASK
  #define CMASK(P0,P1,t) do{int jb_=(t)-(NT-4); if(jb_>=0)cmask(P0,P1,jb_,qrel,hi);}while(0)
  #define ENDW(tt) do{ if((tt)+3<NT){WAIT_BAR(3);} else if((tt)+2<NT){WAIT_BAR(2);} else {WAIT_BAR(0);} }while(0)
  for(;t+3<NT;t+=2){
    STEP(pB0,pB1,pA0,pA1,t,(t+3<NT),(t+1<NT),(t+1<NT));       ENDW(t);   RESC(); ROT();
    STEP(pA0,pA1,pB0,pB1,t+1,(t+4<NT),(t+2<NT),(t+2<NT));     ENDW(t+1); RESC(); ROT();
  }
  STEP(pB0,pB1,pA0,pA1,NT-2,false,true,true);  WAIT_BAR(0); RESC(); ROT();
  STEP(pA0,pA1,pB0,pB1,NT-1,false,false,false); RESC();
  { float sacc=pA0[0]+pA0[1]; _Pragma("unroll") for(int r=2;r<16;++r)sacc+=pA0[r]; _Pragma("unroll") for(int r=0;r<16;++r)sacc+=pA1[r]; l_reg+=sacc;
    pw0=(u32x4){PKW(pA0,0),PKW(pA0,2),PKW(pA0,4),PKW(pA0,6)};pw1=(u32x4){PKW(pA0,8),PKW(pA0,10),PKW(pA0,12),PKW(pA0,14)};pw2=(u32x4){PKW(pA1,0),PKW(pA1,2),PKW(pA1,4),PKW(pA1,6)};pw3=(u32x4){PKW(pA1,8),PKW(pA1,10),PKW(pA1,12),PKW(pA1,14)};
    SBAR(); pv(o,vb0+2*sl_cur,PAF(0),PAF(1),PAF(2),PAF(3)); pv(o+2,vb0+2*sl_cur+8192,PAF(0),PAF(1),PAF(2),PAF(3)); }
  asm volatile("s_waitcnt lgkmcnt(0)\n\ts_barrier":::"memory");
  if(has_next){ const bf16*ksrc_n=Kh_next+wid*8;
    glds16s(ksrc_n,koff,(unsigned)__builtin_amdgcn_readfirstlane(kdst)); DMA_V(0,0); glds16s(ksrc_n+(long)KVBLK*DM,koff,(unsigned)__builtin_amdgcn_readfirstlane(kdst+SLOTB)); }
  #undef PKW
  #undef PAF
  #undef VFR
  #undef PIN
  #undef MX3
  #undef GAPA
  #undef GAPB
  #undef GAPB2
  #undef VRD2
  #undef EX
  #undef VRD
  #undef KRD
  #undef STEP
  #undef ENDW
  {auto rr=__builtin_amdgcn_permlane32_swap(__float_as_uint(l_reg),__float_as_uint(l_reg),false,false);l_reg=__uint_as_float(rr[0])+__uint_as_float(rr[1]);}
  if(hi==0)wsf[32+r32]=l_reg;asm volatile("s_waitcnt lgkmcnt(0)":::"memory");
  float rli[16];
  #pragma unroll
  for(int r=0;r<16;++r)rli[r]=__builtin_amdgcn_rcpf(wsf[32+crow(r,hi)]);
  { typedef __attribute__((address_space(3))) unsigned short* lds_u16p;
    int ln=lane; asm volatile("":"+v"(ln));
    const int r32e=ln&31, hie=ln>>5; const int bc=hie*4+(r32e>>3); const int lb=hie*512+(r32e&7);
    const lds_u16p Hw=(lds_u16p)(shm3+LDS_H+wid*8192);
    #pragma unroll
    for(int r=0;r<16;++r){
      #pragma unroll
      for(int d0=0;d0<4;++d0){ const int idx=lb+((r&3)+8*(r>>2))*128+((bc^(((((r>>2)&1)<<3)|(r&3))^(d0<<2)))<<3);
        float val=o[d0][r]*rli[r];
        if(m_sub){ const float old=__uint_as_float(((unsigned)Hw[idx])<<16); val=old-lam*val; }
        Hw[idx]=(unsigned short)(cvtpk_s(val,0.f)&0xffffu); } } }
  asm volatile("s_waitcnt lgkmcnt(0)":::"memory");
  __builtin_amdgcn_s_setprio(0);
  #undef DMA_K
  #undef DMA_V
  #undef CMASK
  #undef START
  #undef RESC
  #undef ROT
}
constexpr int ATTN_LDS_BYTES=LDS_BYTES;
#undef SBAR
#undef WAIT_BAR
}

namespace cg = cooperative_groups;
#define GAS __attribute__((address_space(1)))
#define LAS __attribute__((address_space(3)))
typedef unsigned short bf16;
typedef unsigned v4u __attribute__((ext_vector_type(4)));
typedef float f32x4 __attribute__((ext_vector_type(4)));

constexpr int NB = 32, SEQ = 2048, DM = 1024, MTOK = NB * SEQ;
constexpr int INC = 8192, DFF = 2816, KROWS = 64 + SEQ;
constexpr float NORM_EPS = 1e-5f, LAMBDA_INIT = 0.2f;
constexpr float QSCALE = 0.125f * 1.4426950408889634f;
constexpr size_t MiB = 1u << 20;
constexpr size_t WS_SS2 = 0, WS_SS3 = 256 * 1024, WS_RS1 = 512 * 1024, WS_PM = 768 * 1024;
constexpr size_t WS_WIN = 2 * MiB, WS_WP = 18 * MiB, WS_WOUT = 22 * MiB, WS_WGU = 24 * MiB, WS_WDN = 35 * MiB;
constexpr size_t WS_QO = 48 * MiB, WS_CB = 176 * MiB, WS_U = 304 * MiB, WS_SGA = 432 * MiB, WS_SGB = 560 * MiB, WS_KB = 688 * MiB, WS_VB = 820 * MiB, WS_END = 952 * MiB;
constexpr size_t WS_MG = WS_KB, WS_H2B = WS_VB, WS_ACT = WS_QO;
static_assert(WS_ACT + (size_t)MTOK * DFF * 2 <= WS_SGA + 128 * MiB && WS_KB + (size_t)NB * KROWS * DM * 2 <= WS_VB && WS_VB + (size_t)NB * KROWS * DM * 2 <= WS_END, "ws map");
constexpr int LDS_BYTES = 147456;
static_assert(attn_body::ATTN_LDS_BYTES <= LDS_BYTES, "attention LDS");
constexpr size_t WS_BAR = 1 * MiB;
constexpr int LDS_BARST = LDS_BYTES - 256;
static_assert(attn_body::ATTN_LDS_BYTES <= LDS_BARST, "attention LDS vs barrier words");
#define RLX_AGENT __ATOMIC_RELAXED, __HIP_MEMORY_SCOPE_AGENT
#define XB_TMO      128
#define XB_XCNT(j)  (256  + 64 * (j))
#define XB_XSUB(j)  (1280 + 64 * (j))
#define XB_XGEN(j)  (2304 + 64 * (j))
#define XB_TOP      3328
#define XB_TOPGEN   3392
#define XCD_BAR_WORDS 3456
#define XB_SPIN_CAP (1u << 18)

__device__ __forceinline__ unsigned xb_ld(unsigned* p)              { return __hip_atomic_load(p, __ATOMIC_RELAXED, __HIP_MEMORY_SCOPE_AGENT); }
__device__ __forceinline__ unsigned xb_add(unsigned* p, unsigned v) { return __hip_atomic_fetch_add(p, v, __ATOMIC_RELAXED, __HIP_MEMORY_SCOPE_AGENT); }
__device__ __forceinline__ unsigned xb_xcc_id() { return (unsigned)__builtin_amdgcn_s_getreg((3 << 11) | 20) & 0xFu; }
#define XB_SPIN(cond, bar) do { unsigned _sp = 0; while (cond) { __builtin_amdgcn_s_sleep(1); \
    if ((++_sp & 255u) == 0u) { if (xb_ld(&(bar)[XB_TMO])) break; if (_sp > XB_SPIN_CAP) { atomicAdd(&(bar)[XB_TMO], 1u); break; } } } } while (0)

struct XcdBarrier {
    unsigned* bar; unsigned x;
    volatile LAS unsigned* st;
};

__device__ __forceinline__ XcdBarrier xcd_barrier_post(unsigned* bar, volatile LAS unsigned* st) {
    XcdBarrier b; b.bar = bar; b.x = xb_xcc_id(); b.st = st;
    if (threadIdx.x == 0) (void)xb_add(&bar[XB_XCNT(b.x)], 1u);
    return b;
}
__device__ __forceinline__ void xcd_barrier_complete(unsigned* bar, unsigned x, unsigned& nloc, unsigned& nx) {
    const unsigned G = gridDim.x * gridDim.y * gridDim.z;
    unsigned sum, cnt, mine, sp = 0u;
    for (;;) {
        sum = 0u; cnt = 0u; mine = 0u;
#pragma unroll
        for (unsigned j = 0; j < 16; ++j) { const unsigned c = xb_ld(&bar[XB_XCNT(j)]); sum += c; cnt += (c > 0u) ? 1u : 0u; mine = (j == x) ? c : mine; }
        if (sum == G) break;
        __builtin_amdgcn_s_sleep(1);
        if ((++sp & 255u) == 0u) { if (xb_ld(&bar[XB_TMO])) break; if (sp > XB_SPIN_CAP) { atomicAdd(&bar[XB_TMO], 1u); break; } }
    }
    nloc = mine > 0u ? mine : 1u; nx = cnt > 0u ? cnt : 1u;
}

__device__ __forceinline__ void xcd_barrier(const XcdBarrier& b) {
    asm volatile("s_waitcnt vmcnt(0)" ::: "memory");
    __syncthreads();
    if (threadIdx.x == 0) {
        unsigned* bar = b.bar;
        __builtin_amdgcn_s_waitcnt(0);
        unsigned nloc = b.st[0], nx = b.st[1];
        if (nloc == 0u) { xcd_barrier_complete(bar, b.x, nloc, nx); b.st[0] = nloc; b.st[1] = nx; }
        const unsigned old = xb_add(&bar[XB_XSUB(b.x)], 1u);
        const unsigned gen = old / nloc;
        if (old + 1u == (gen + 1u) * nloc) {
            __builtin_amdgcn_fence(__ATOMIC_RELEASE, "agent");
            asm volatile("s_waitcnt vmcnt(0)" ::: "memory");
            const unsigned og = xb_add(&bar[XB_TOP], 1u);
            const unsigned tg = og / nx;
            if (og + 1u == (tg + 1u) * nx) xb_add(&bar[XB_TOPGEN], 1u);
            else XB_SPIN(xb_ld(&bar[XB_TOPGEN]) == tg, bar);
            __builtin_amdgcn_fence(__ATOMIC_ACQUIRE, "agent");
            xb_add(&bar[XB_XGEN(b.x)], 1u);
            asm volatile("s_waitcnt vmcnt(0)" ::: "memory");
        } else {
            XB_SPIN(xb_ld(&bar[XB_XGEN(b.x)]) == gen, bar);
            __builtin_amdgcn_fence(__ATOMIC_ACQUIRE, "agent");
            asm volatile("s_waitcnt vmcnt(0)" ::: "memory");
        }
    }
    __syncthreads();
}


template <int K> __device__ __forceinline__ float xor_swz(float v) { return __uint_as_float((unsigned)__builtin_amdgcn_ds_swizzle((int)__float_as_uint(v), (K << 10) | 0x1f)); }
__device__ __forceinline__ float xor32_sum(float v) { auto rr = __builtin_amdgcn_permlane32_swap(__float_as_uint(v), __float_as_uint(v), false, false); return __uint_as_float(rr[0]) + __uint_as_float(rr[1]); }
__device__ __forceinline__ float wave_sum(float v) { v += xor_swz<1>(v); v += xor_swz<2>(v); v += xor_swz<4>(v); v += xor_swz<8>(v); v += xor_swz<16>(v); return xor32_sum(v); }
__device__ __forceinline__ float bf_lo(unsigned w) { return __uint_as_float(w << 16); }
__device__ __forceinline__ float bf_hi(unsigned w) { return __uint_as_float(w & 0xffff0000u); }
__device__ __forceinline__ v4u pack8(f32x4 a, f32x4 b) { v4u w; w.x = pg8::cvt_pk_bf16(a[0], a[1]); w.y = pg8::cvt_pk_bf16(a[2], a[3]); w.z = pg8::cvt_pk_bf16(b[0], b[1]); w.w = pg8::cvt_pk_bf16(b[2], b[3]); return w; }
__device__ __forceinline__ void unpack8(v4u w, f32x4& a, f32x4& b) { a = (f32x4){bf_lo(w.x), bf_hi(w.x), bf_lo(w.y), bf_hi(w.y)}; b = (f32x4){bf_lo(w.z), bf_hi(w.z), bf_lo(w.w), bf_hi(w.w)}; }
__device__ __forceinline__ float sigm(float x) { return __builtin_amdgcn_rcpf(1.f + __builtin_amdgcn_exp2f(-1.4426950408889634f * x)); }
__device__ __forceinline__ float inv_freq(int d) { return exp2f(-(float)d * (13.287712379549449f / 32.f)); }
__device__ __forceinline__ void rope_cs(float pos, float invf, float& c, float& s) {
    const float ang = pos * invf; float rev = ang * 0.15915494309189535f; rev = __builtin_amdgcn_fractf(rev);
    s = __builtin_amdgcn_sinf(rev); c = __builtin_amdgcn_cosf(rev);
}

namespace pg8 {
#define NTST(ptr, val) (*(v4u*)(ptr) = (val))
struct EpiInProj {
    static constexpr bool PERM = true, AFTER_DRAIN = false, MID = false;
    const float* rs1; bf16_t *QO, *KB, *VB, *CB, *U, *SGA, *SGB;
    __device__ __forceinline__ void operator()(const f32x4 (&acc)[2][2][4][2], const Unit& u, int wr, int wc, int fr, int fq) const {
        int frp = fr; asm volatile("" : "+v"(frp)); const int pn = u.pn, row0 = u.pm * BM + wr * 64 + frp;
        const size_t kvshift = (size_t)64 * ((u.pm >> 3) + 1);
        if (pn < 8) {
            const bool isq = pn < 4; bf16_t* base = isq ? QO : KB; const float s0 = isq ? QSCALE : 1.f;
            const int colt = (pn & 3) * 256 + wc * 64 + 8 * fq;
            float invf[8];
#pragma unroll
            for (int k = 0; k < 8; ++k) invf[k] = inv_freq(8 * fq + k);
#pragma unroll
            for (int ai = 0; ai < 2; ++ai)
#pragma unroll
                for (int m = 0; m < 4; ++m) {
                    const int row = row0 + ai * HALF + m * 16; const float pos = (float)(16 + (row & (SEQ - 1))); const float sc = s0;
                    const size_t orow = isq ? (size_t)row : (size_t)row + kvshift;
                    f32x4 lo[2], hi[2], ylo[2], yhi[2];
                    lo[0] = acc[ai][0][m][0] * sc; lo[1] = acc[ai][0][m][1] * sc; hi[0] = acc[ai][1][m][0] * sc; hi[1] = acc[ai][1][m][1] * sc;
#pragma unroll
                    for (int n = 0; n < 2; ++n)
#pragma unroll
                        for (int k = 0; k < 4; ++k) { float c, s; rope_cs(pos, invf[4 * n + k], c, s); ylo[n][k] = lo[n][k] * c - hi[n][k] * s; yhi[n][k] = hi[n][k] * c + lo[n][k] * s; }
                    bf16_t* p = base + orow * DM + colt;
                    NTST(p, pack8(ylo[0], ylo[1])); NTST((p + 32), pack8(yhi[0], yhi[1]));
                }
        } else if (pn < 16) {
            const bool isv = pn < 12; bf16_t* base = isv ? VB : CB; const int colt = (pn & 3) * 256 + wc * 32 + 8 * fq;
#pragma unroll
            for (int ai = 0; ai < 2; ++ai)
#pragma unroll
                for (int m = 0; m < 4; ++m) {
                    const int row = row0 + ai * HALF + m * 16; const float sc = 1.f; const size_t orow = isv ? (size_t)row + kvshift : (size_t)row;
                    bf16_t* p = base + orow * DM + colt;
#pragma unroll
                    for (int bj = 0; bj < 2; ++bj) NTST((p + bj * HALF), pack8(acc[ai][bj][m][0] * sc, acc[ai][bj][m][1] * sc));
                }
        } else if (pn < 24) {
            const int colt = (pn - 16) * 128 + wc * 32 + 8 * fq;
#pragma unroll
            for (int ai = 0; ai < 2; ++ai)
#pragma unroll
                for (int m = 0; m < 4; ++m) {
                    const int row = row0 + ai * HALF + m * 16; const float sc2 = 1.f;
                    NTST((U + (size_t)row * DM + colt), pack8(acc[ai][0][m][0] * acc[ai][1][m][0] * sc2, acc[ai][0][m][1] * acc[ai][1][m][1] * sc2));
                }
        } else {
            const int colt = (pn - 24) * 128 + wc * 32 + 8 * fq;
#pragma unroll
            for (int ai = 0; ai < 2; ++ai)
#pragma unroll
                for (int m = 0; m < 4; ++m) {
                    const int row = row0 + ai * HALF + m * 16; f32x4 ra[2], sb[2];
#pragma unroll
                    for (int n = 0; n < 2; ++n)
#pragma unroll
                        for (int k = 0; k < 4; ++k) { const float ea = __builtin_amdgcn_exp2f(fminf(-1.4426950408889634f * acc[ai][0][m][n][k], 80.f)), eb = __builtin_amdgcn_exp2f(fminf(-1.4426950408889634f * acc[ai][1][m][n][k], 80.f));
                            ra[n][k] = __builtin_amdgcn_rcpf(1.f + ea) * (1.f + eb); sb[n][k] = __builtin_amdgcn_rcpf(1.f + eb); }
                    NTST((SGA + (size_t)row * DM + colt), pack8(ra[0], ra[1])); NTST((SGB + (size_t)row * DM + colt), pack8(sb[0], sb[1]));
                }
        }
    }
};
struct EpiMerge {
    static constexpr bool PERM = true, AFTER_DRAIN = false, MID = true;
    const bf16_t *SGA, *SGB; bf16_t* MG;
    __device__ __forceinline__ void mid(f32x4 (&acc)[2][2][4][2], const Unit& u, int wr, int wc, int fr, int fq) const {
        int frp = fr; asm volatile("" : "+v"(frp)); const int row0 = u.pm * BM + wr * 64 + frp, col0 = u.pn * BM + wc * 32 + 8 * fq;
#pragma unroll
        for (int ai = 0; ai < 2; ++ai)
#pragma unroll
            for (int m = 0; m < 4; ++m) { const size_t off = (size_t)(row0 + ai * HALF + m * 16) * DM + col0;
#pragma unroll
                for (int bj = 0; bj < 2; ++bj) { f32x4 a0, a1; unpack8(*(const v4u*)(SGA + off + bj * HALF), a0, a1);
                    acc[ai][bj][m][0] *= a0; acc[ai][bj][m][1] *= a1; }
                if (m == 3) asm volatile("" ::: "memory"); }
    }
    __device__ __forceinline__ void operator()(const f32x4 (&acc)[2][2][4][2], const Unit& u, int wr, int wc, int fr, int fq) const {
        int frp = fr; asm volatile("" : "+v"(frp)); const int row0 = u.pm * BM + wr * 64 + frp, col0 = u.pn * BM + wc * 32 + 8 * fq;
#pragma unroll
        for (int ai = 0; ai < 2; ++ai)
#pragma unroll
            for (int m = 0; m < 4; ++m) { const size_t off = (size_t)(row0 + ai * HALF + m * 16) * DM + col0;
#pragma unroll
                for (int bj = 0; bj < 2; ++bj) { f32x4 b0, b1; unpack8(*(const v4u*)(SGB + off + bj * HALF), b0, b1);
                    NTST((MG + off + bj * HALF), pack8(acc[ai][bj][m][0] * b0, acc[ai][bj][m][1] * b1)); } }
    }
};
template <bool IN_BF16> struct EpiResid {
    static constexpr bool PERM = true, AFTER_DRAIN = false, MID = false;
    const void* hin; bf16_t* hb; float* ss; const float* rsn;
    __device__ __forceinline__ void operator()(const f32x4 (&acc)[2][2][4][2], const Unit& u, int wr, int wc, int fr, int fq) const {
        int frp = fr; asm volatile("" : "+v"(frp)); const int row0 = u.pm * BM + wr * 64 + frp, col0 = u.pn * BM + wc * 32 + 8 * fq;
#pragma unroll
        for (int ai = 0; ai < 2; ++ai)
#pragma unroll
            for (int m = 0; m < 4; ++m) { const int row = row0 + ai * HALF + m * 16; const size_t off = (size_t)row * DM + col0; float s = 0.f; const float rinv = rsn ? __builtin_amdgcn_rcpf(rsn[row]) : 1.f;
#pragma unroll
                for (int bj = 0; bj < 2; ++bj) { f32x4 h0, h1;
                    if (IN_BF16) unpack8(*(const v4u*)((const bf16_t*)hin + off + bj * HALF), h0, h1);
                    else { h0 = *(const f32x4*)((const float*)hin + off + bj * HALF); h1 = *(const f32x4*)((const float*)hin + off + bj * HALF + 4); }
                    if (rsn) { h0 = h0 * rinv; h1 = h1 * rinv; }
                    h0 += acc[ai][bj][m][0]; h1 += acc[ai][bj][m][1];
                    NTST((hb + off + bj * HALF), pack8(h0, h1));
                    s += (h0[0] * h0[0] + h0[1] * h0[1]) + (h0[2] * h0[2] + h0[3] * h0[3]) + (h1[0] * h1[0] + h1[1] * h1[1]) + (h1[2] * h1[2] + h1[3] * h1[3]); }
                s += xor_swz<16>(s); s = xor32_sum(s);
                if (fq == 0) (void)__hip_atomic_fetch_add(ss + row, s, __ATOMIC_RELAXED, __HIP_MEMORY_SCOPE_AGENT); }
    }
};
struct EpiGateUp {
    static constexpr bool PERM = true, AFTER_DRAIN = false, MID = false;
    const float* ss2; bf16_t* ACT;
    __device__ __forceinline__ void operator()(const f32x4 (&acc)[2][2][4][2], const Unit& u, int wr, int wc, int fr, int fq) const {
        int frp = fr; asm volatile("" : "+v"(frp)); const int row0 = u.pm * BM + wr * 64 + frp, col0 = u.pn * HALF + wc * 32 + 8 * fq;
#pragma unroll
        for (int ai = 0; ai < 2; ++ai)
#pragma unroll
            for (int m = 0; m < 4; ++m) { const int row = row0 + ai * HALF + m * 16; const float r2 = __builtin_amdgcn_rsqf(ss2[row] * (1.f / DM) + NORM_EPS);
                f32x4 o[2];
#pragma unroll
                for (int n = 0; n < 2; ++n) { const f32x4 g = acc[ai][0][m][n] * r2, uu = acc[ai][1][m][n] * r2;
#pragma unroll
                    for (int k = 0; k < 4; ++k) o[n][k] = g[k] * sigm(g[k]) * uu[k]; }
                NTST((ACT + (size_t)row * DFF + col0), pack8(o[0], o[1])); }
    }
};
}

__device__ __forceinline__ void transpose_item(const float* W, int N, int k0, int n0src, const float* ksc, bf16* WT, int ldk, int drow0, int dk0, LAS float* scr, int lane) {
#pragma unroll
    for (int i = 0; i < 32; ++i) { const int kk = 2 * i + (lane >> 5); float v = __builtin_nontemporal_load(&W[(size_t)(k0 + kk) * N + n0src + (lane & 31)]);     if (ksc) v *= ksc[k0 + kk]; scr[kk * 33 + (lane & 31)] = v; }
    asm volatile("s_waitcnt lgkmcnt(0)" ::: "memory");
    const int c = lane & 7;
#pragma unroll
    for (int j = 0; j < 4; ++j) { const int n = (lane >> 3) + 8 * j; const LAS float* s = scr + (8 * c) * 33 + n;
        v4u o; o.x = pg8::cvt_pk_bf16(s[0 * 33], s[1 * 33]); o.y = pg8::cvt_pk_bf16(s[2 * 33], s[3 * 33]); o.z = pg8::cvt_pk_bf16(s[4 * 33], s[5 * 33]); o.w = pg8::cvt_pk_bf16(s[6 * 33], s[7 * 33]);
        *(v4u*)(WT + (size_t)(drow0 + n) * ldk + dk0 + 8 * c) = o; }
    asm volatile("s_waitcnt lgkmcnt(0)" ::: "memory");
}
__device__ __forceinline__ int win_src_col(int rb) {
    const int pn = rb >> 3, sb = rb & 7, bj = sb >> 2, wc = sb & 3;
    if (pn < 8) return pn * 256 + 64 * wc + 32 * bj;
    if (pn < 16) return pn * 256 + sb * 32;
    if (pn < 24) return (bj ? 5120 : 4096) + 128 * (pn - 16) + 32 * wc;
    return (bj ? 7168 : 6144) + 128 * (pn - 24) + 32 * wc;
}

#ifndef REPMASK
#define REPMASK 0
#endif
#ifndef PHMASK
#define PHMASK 0xFF
#endif
struct Args { const float* in[17]; float* out; unsigned char* ws; };

__global__ void __launch_bounds__(512, 2) fwd_kernel(Args a) {
    extern __shared__ __attribute__((aligned(16))) unsigned char lds[];
    cg::grid_group grid = cg::this_grid();
    const int wave = __builtin_amdgcn_readfirstlane((int)threadIdx.x >> 6);
#define PIN_TID() int tid_ = threadIdx.x; asm volatile("" : "+v"(tid_)); const int tid = tid_, lane = tid & 63, gtid = bx * 512 + tid; (void)lane; (void)gtid
    const int G = gridDim.x, bx = blockIdx.x;
    const int vcu = (G % 8 == 0) ? (bx % 8) * (G / 8) + bx / 8 : bx;
    LAS unsigned char* L = (LAS unsigned char*)lds;
    unsigned char* ws = a.ws;
    const float* x = a.in[0]; const float* w_in = a.in[3];
#define Win_t ((bf16*)(ws + WS_WIN))
#define Wp_t ((bf16*)(ws + WS_WP))
#define Wout_t ((bf16*)(ws + WS_WOUT))
#define Wgu_t ((bf16*)(ws + WS_WGU))
#define Wdn_t ((bf16*)(ws + WS_WDN))
#define QO ((bf16*)(ws + WS_QO))
#define CB ((bf16*)(ws + WS_CB))
#define U ((bf16*)(ws + WS_U))
#define SGA ((bf16*)(ws + WS_SGA))
#define SGB ((bf16*)(ws + WS_SGB))
#define KB ((bf16*)(ws + WS_KB))
#define VB ((bf16*)(ws + WS_VB))
#define MG ((bf16*)(ws + WS_MG))
#define H2B ((bf16*)(ws + WS_H2B))
#define ACT ((bf16*)(ws + WS_ACT))
#define H3B ((bf16*)(ws + WS_SGA))
#define ss2 ((float*)(ws + WS_SS2))
#define ss3 ((float*)(ws + WS_SS3))
#define rs1 ((float*)(ws + WS_RS1))
#define PM ((float*)(ws + WS_PM))
    bf16* HB = (bf16*)a.out;
    { volatile LAS unsigned* st0 = (volatile LAS unsigned*)(L + LDS_BARST); if (threadIdx.x < 2) st0[threadIdx.x] = 0u; __syncthreads(); }
#define XSYNC() xcd_barrier(xbar)
#define GSYNC() do { asm volatile("s_waitcnt vmcnt(0)" ::: "memory"); __syncthreads(); grid.sync(); \
    if (threadIdx.x == 0) { __builtin_amdgcn_fence(__ATOMIC_ACQUIRE, "agent"); asm volatile("s_waitcnt vmcnt(0)" ::: "memory"); } __syncthreads(); } while (0)
    const int GT = G * 512;

    for (int rep_ = 0; rep_ < 1 + ((REPMASK >> 0) & 1); ++rep_) if ((PHMASK >> 0) & 1) {
        PIN_TID();
        const int gw = vcu * 8 + wave, NGW = G * 8;
        for (int i = gtid; i < 2 * MTOK / 4; i += GT) ((f32x4*)ss2)[i] = (f32x4){0.f, 0.f, 0.f, 0.f};
        for (int i = gtid; i < XCD_BAR_WORDS; i += GT) ((unsigned*)(ws + WS_BAR))[i] = 0u;
        for (int i = gtid; i < 2 * NB * 6144; i += GT) { const int buf = i / (NB * 6144), r = i % (NB * 6144), b = r / 6144, o = r % 6144;
            ((v4u*)((buf ? VB : KB) + ((size_t)b * KROWS + 16) * DM))[o] = (v4u){0u, 0u, 0u, 0u}; }
        LAS float* scr = (LAS float*)(L + wave * 16384);
        constexpr int I_IN = 16 * 256, I_P = 16 * 32, I_GU = 16 * 176, I_DN = 44 * 32, NITEMS = I_IN + 3 * I_P + I_GU + I_DN;
        for (int it = gw; it < NITEMS; it += NGW) {
            int r = it;
            if (r < I_IN) { const int kb = r >> 8, rb = r & 255; transpose_item(w_in, INC, kb * 64, win_src_col(rb), a.in[2], Win_t, DM, rb * 32, kb * 64, scr, lane); continue; } r -= I_IN;
            if (r < I_P) { const int kb = r >> 5, rb = r & 31; transpose_item(a.in[10], DM, kb * 64, rb * 32, nullptr, Wp_t, 2 * DM, rb * 32, kb * 64, scr, lane); continue; } r -= I_P;
            if (r < I_P) { const int kb = r >> 5, rb = r & 31; transpose_item(a.in[11], DM, kb * 64, rb * 32, nullptr, Wp_t, 2 * DM, rb * 32, DM + kb * 64, scr, lane); continue; } r -= I_P;
            if (r < I_P) { const int kb = r >> 5, rb = r & 31; transpose_item(a.in[12], DM, kb * 64, rb * 32, nullptr, Wout_t, DM, rb * 32, kb * 64, scr, lane); continue; } r -= I_P;
            if (r < I_GU) { const int kb = r / 176, rb = r % 176, pn = rb >> 3, sb = rb & 7;
                transpose_item(a.in[14], 2 * DFF, kb * 64, ((sb >> 2) ? DFF : 0) + 128 * pn + 32 * (sb & 3), a.in[13], Wgu_t, DM, rb * 32, kb * 64, scr, lane); continue; } r -= I_GU;
            { const int kb = r >> 5, rb = r & 31; transpose_item(a.in[15], DM, kb * 64, rb * 32, nullptr, Wdn_t, DFF, rb * 32, kb * 64, scr, lane); }
        }
        for (int m0 = gw * 4; m0 < MTOK; m0 += NGW * 4) {
            f32x4 v[4][4]; float s[4];
#pragma unroll
            for (int r = 0; r < 4; ++r) { const f32x4* xr = (const f32x4*)(x + (size_t)(m0 + r) * DM) + lane;
#pragma unroll
                for (int j = 0; j < 4; ++j) v[r][j] = __builtin_nontemporal_load(&xr[64 * j]); }
#pragma unroll
            for (int r = 0; r < 4; ++r) { s[r] = 0.f;
#pragma unroll
                for (int j = 0; j < 4; ++j) s[r] += (v[r][j][0] * v[r][j][0] + v[r][j][1] * v[r][j][1]) + (v[r][j][2] * v[r][j][2] + v[r][j][3] * v[r][j][3]);
                s[r] = wave_sum(s[r]); }
            if (lane < 4) rs1[m0 + lane] = __builtin_amdgcn_rsqf((lane == 0 ? s[0] : lane == 1 ? s[1] : lane == 2 ? s[2] : s[3]) * (1.f / DM) + NORM_EPS);
#pragma unroll
            for (int r = 0; r < 4; ++r) { unsigned long long* o8 = (unsigned long long*)(HB + (size_t)(m0 + r) * DM) + lane; const float rsr = __builtin_amdgcn_rsqf(s[r] * (1.f / DM) + NORM_EPS);
#pragma unroll
                for (int j = 0; j < 4; ++j) { const f32x4 q = v[r][j] * rsr; o8[64 * j] = (unsigned long long)pg8::cvt_pk_bf16(q[0], q[1]) | ((unsigned long long)pg8::cvt_pk_bf16(q[2], q[3]) << 32); } }
        }
        for (int job = bx; job < 256; job += G) {
            LAS float* hm = (LAS float*)L; LAS float* red = (LAS float*)(L + 65536);
            __syncthreads();
#pragma unroll
            for (int rr = 0; rr < 2; ++rr) { const int r = wave * 2 + rr; const f32x4* mr = (const f32x4*)(a.in[1] + (size_t)r * DM) + lane; f32x4 v[4]; float s = 0.f;
#pragma unroll
                for (int j = 0; j < 4; ++j) { v[j] = mr[64 * j]; s += (v[j][0] * v[j][0] + v[j][1] * v[j][1]) + (v[j][2] * v[j][2] + v[j][3] * v[j][3]); }
                const float rs = __builtin_amdgcn_rsqf(wave_sum(s) * (1.f / DM) + NORM_EPS);
#pragma unroll
                for (int j = 0; j < 4; ++j) { const f32x4 wv = ((const f32x4*)a.in[2])[lane + 64 * j];
#pragma unroll
                    for (int k = 0; k < 4; ++k) hm[(4 * lane + 256 * j + k) * 16 + r] = v[j][k] * rs * wv[k]; } }
            __syncthreads();
            const int col = tid & 15, ksp = tid >> 4, pcol = job * 16 + col, src = pcol < 2048 ? 1024 + pcol : 4096 + (pcol - 2048);
            float acc[16];
#pragma unroll
            for (int r = 0; r < 16; ++r) acc[r] = 0.f;
#pragma unroll 8
            for (int dd = 0; dd < 32; ++dd) { const int d = ksp * 32 + dd; const float wv = w_in[(size_t)d * INC + src];
                const f32x4 h0 = *(const LAS f32x4*)(hm + d * 16), h1 = *(const LAS f32x4*)(hm + d * 16 + 4), h2 = *(const LAS f32x4*)(hm + d * 16 + 8), h3 = *(const LAS f32x4*)(hm + d * 16 + 12);
#pragma unroll
                for (int k = 0; k < 4; ++k) { acc[k] += h0[k] * wv; acc[4 + k] += h1[k] * wv; acc[8 + k] += h2[k] * wv; acc[12 + k] += h3[k] * wv; } }
#pragma unroll
            for (int r = 0; r < 16; ++r) red[(ksp * 16 + r) * 16 + col] = acc[r];
            __syncthreads();
            if (tid < 256) { const int r = tid >> 4, c = tid & 15; float s = 0.f;
#pragma unroll 8
                for (int k = 0; k < 32; ++k) s += red[(k * 16 + r) * 16 + c];
                PM[r * 4096 + job * 16 + c] = s; }
        }
        __syncthreads();
    }
    GSYNC();
    const XcdBarrier xbar = xcd_barrier_post((unsigned*)(ws + WS_BAR), (volatile LAS unsigned*)(L + LDS_BARST));

    for (int rep_ = 0; rep_ < 1 + ((REPMASK >> 1) & 1); ++rep_) if ((PHMASK >> 1) & 1) {
        PIN_TID();
        for (int rm_ = 0; rm_ < 1 + ((REPMASK >> 8) & 1); ++rm_)
        for (int i = gtid; i < NB * 16 * 256; i += GT) { const int ch = i & 255, r = (i >> 8) & 15, b = i >> 12; const bool isv = ch >= 128; const int c = (ch & 127) * 8;
            f32x4 o0, o1;
            if (!isv) { const int d = c & 63, base = c - d, dl = d & 31; const float* plo = PM + r * 4096 + base + dl; const float* phi = plo + 32;
#pragma unroll
                for (int k = 0; k < 8; ++k) { float cs, sn; rope_cs((float)r, inv_freq(dl + k), cs, sn); const float xl = plo[k], xh = phi[k]; const float y = d < 32 ? xl * cs - xh * sn : xh * cs + xl * sn;
                    if (k < 4) o0[k] = y; else o1[k - 4] = y; }
            } else { o0 = *(const f32x4*)(PM + r * 4096 + 1024 + c); o1 = *(const f32x4*)(PM + r * 4096 + 1024 + c + 4); }
            *(v4u*)((isv ? VB : KB) + ((size_t)b * KROWS + r) * DM + c) = pack8(o0, o1); }
        pg8::Gemm g{HB, HB, Win_t, DM, DM, DM / 64}; pg8::StaticOrder S; S.init(MTOK, INC, G, bx);
        pg8::EpiInProj E{rs1, QO, KB, VB, CB, U, SGA, SGB};
        for (int rg_ = 0; rg_ < 1 + ((REPMASK >> 9) & 1); ++rg_)
        pg8::gemm_phase<pg8::EpiInProj, pg8::StaticOrder, true, true>(L, g, S, E);
    }
    XSYNC();

    for (int rep_ = 0; rep_ < 1 + ((REPMASK >> 2) & 1); ++rep_) if ((PHMASK >> 2) & 1) {
        PIN_TID();
        const float* cw = a.in[9]; bf16* OAp = (bf16*)a.out + (size_t)MTOK * DM; bf16* OBp = CB;
        float lam;
        { const float s1 = wave_sum(a.in[4][lane] * a.in[5][lane]), s2 = wave_sum(a.in[6][lane] * a.in[7][lane]); lam = __uint_as_float(__builtin_amdgcn_readfirstlane(__float_as_uint(expf(s1) - expf(s2) + LAMBDA_INIT))); }
        const float* subw = a.in[8];
        const int conv_grp = (bx >> 3) & 3, conv_before = conv_grp == 0 ? 0 : conv_grp == 1 ? 4 : conv_grp == 2 ? 6 : 7;
        for (int bh = vcu; bh < NB * 8; bh += G) { const int b = bh >> 3, hh = bh & 7;
            for (int qb = 0; qb < 8; ++qb) {
                if (bh == vcu && qb == conv_before) { int gt2 = gtid; asm volatile("" : "+v"(gt2));
                    for (int it = gt2; it < (MTOK / 16) * 128; it += GT) { const int ch = it & 127, rb = it >> 7, g0 = rb * 16, c = ch * 8;
                        const f32x4 w00 = *(const f32x4*)(cw + c), w01 = *(const f32x4*)(cw + c + 4), w10 = *(const f32x4*)(cw + DM + c), w11 = *(const f32x4*)(cw + DM + c + 4), w20 = *(const f32x4*)(cw + 2 * DM + c), w21 = *(const f32x4*)(cw + 2 * DM + c + 4);
                        f32x4 p0, p1, q0, q1;
                        if ((g0 & (SEQ - 1)) == 0) { const float* m14 = PM + 14 * 4096 + 2048 + c; const float* m15 = PM + 15 * 4096 + 2048 + c;
                            p0 = *(const f32x4*)m14 * *(const f32x4*)(m14 + 1024); p1 = *(const f32x4*)(m14 + 4) * *(const f32x4*)(m14 + 1028);
                            q0 = *(const f32x4*)m15 * *(const f32x4*)(m15 + 1024); q1 = *(const f32x4*)(m15 + 4) * *(const f32x4*)(m15 + 1028);
                        } else { unpack8(*(const v4u*)(U + (size_t)(g0 - 2) * DM + c), p0, p1); unpack8(*(const v4u*)(U + (size_t)(g0 - 1) * DM + c), q0, q1); }
#pragma unroll 4
                        for (int j = 0; j < 16; ++j) { const size_t off = (size_t)(g0 + j) * DM + c; f32x4 u0, u1, b0, b1; unpack8(*(const v4u*)(U + off), u0, u1); unpack8(*(const v4u*)(CB + off), b0, b1);
                            *(v4u*)(OBp + off) = pack8(b0 * (w00 * p0 + w10 * q0 + w20 * u0), b1 * (w01 * p1 + w11 * q1 + w21 * u1));
                            p0 = q0; p1 = q1; q0 = u0; q1 = u1; }
                    }
                }
                for (int m = 0; m < 2; ++m) {
                    const attn_body::bf16* Qw = (const attn_body::bf16*)QO + ((size_t)b * SEQ + qb * 256 + wave * 32) * DM + hh * 128 + m * 64;
                    const attn_body::bf16* Kh = (const attn_body::bf16*)KB + (size_t)b * KROWS * DM + hh * 128 + m * 64;
                    const attn_body::bf16* Vh = (const attn_body::bf16*)VB + (size_t)b * KROWS * DM + hh * 128;
                    const attn_body::bf16* Khn = (const attn_body::bf16*)KB + (size_t)b * KROWS * DM + hh * 128 + (1 - m) * 64;
                    attn_body::attn_pass<8>(Qw, Kh, Vh, 4 * qb + 5, m, lam, (char*)lds, Khn, !(qb == 7 && m == 1), !(qb == 0 && m == 0));
                }
                { int ln = lane; asm volatile("" : "+v"(ln)); const LAS unsigned char* Hw = L + attn_body::LDS_H + wave * 8192; const int row = ln >> 1, half = ln & 1; float s = 0.f;
#pragma unroll
                    for (int j = 0; j < 8; ++j) { const int chunk = half * 8 + j; f32x4 v0, v1; unpack8(*(const LAS v4u*)(Hw + row * 256 + ((chunk ^ (row & 15)) << 4)), v0, v1);
                        s += (v0[0] * v0[0] + v0[1] * v0[1]) + (v0[2] * v0[2] + v0[3] * v0[3]) + (v1[0] * v1[0] + v1[1] * v1[1]) + (v1[2] * v1[2] + v1[3] * v1[3]); }
                    s += __uint_as_float((unsigned)__builtin_amdgcn_mov_dpp((int)__float_as_uint(s), 0xB1, 0xF, 0xF, true));
                    const float rn = __builtin_amdgcn_rsqf(s * (1.f / 128.f) + NORM_EPS) * (1.f - LAMBDA_INIT);
                    bf16* Ow = OAp + ((size_t)b * SEQ + qb * 256 + wave * 32 + row) * DM + hh * 128 + half * 64;
#pragma unroll
                    for (int j = 0; j < 8; ++j) { const int chunk = half * 8 + j; f32x4 v0, v1; unpack8(*(const LAS v4u*)(Hw + row * 256 + ((chunk ^ (row & 15)) << 4)), v0, v1);
                        const f32x4 w0 = *(const f32x4*)(subw + chunk * 8), w1 = *(const f32x4*)(subw + chunk * 8 + 4);
                        *(v4u*)(Ow + j * 8) = pack8(v0 * w0 * rn, v1 * w1 * rn); }
                    asm volatile("s_waitcnt lgkmcnt(0)" ::: "memory");
                }
            }
        }
        asm volatile("s_waitcnt vmcnt(0)" ::: "memory"); __syncthreads();
    }
    XSYNC();

    for (int rep_ = 0; rep_ < 1 + ((REPMASK >> 3) & 1); ++rep_) if ((PHMASK >> 3) & 1) {
        pg8::Gemm g{(bf16*)a.out + (size_t)MTOK * DM, CB, Wp_t, DM, 2 * DM, DM / 64}; pg8::StaticOrder S; S.init(MTOK, DM, G, bx);
        pg8::EpiMerge E{SGA, SGB, MG};
        pg8::gemm_phase<pg8::EpiMerge, pg8::StaticOrder, true, true>(L, g, S, E);
    }
    XSYNC();
    for (int rep_ = 0; rep_ < 1 + ((REPMASK >> 4) & 1); ++rep_) if ((PHMASK >> 4) & 1) {
        pg8::Gemm g{MG, MG, Wout_t, DM, DM, DM / 64}; pg8::StaticOrder S; S.init(MTOK, DM, G, bx);
        pg8::EpiResid<true> E{HB, H2B, ss2, rs1};
        pg8::gemm_phase<pg8::EpiResid<true>, pg8::StaticOrder, true, true>(L, g, S, E);
    }
    XSYNC();
    for (int rep_ = 0; rep_ < 1 + ((REPMASK >> 5) & 1); ++rep_) if ((PHMASK >> 5) & 1) {
        pg8::Gemm g{H2B, H2B, Wgu_t, DM, DM, DM / 64}; pg8::StaticOrder S; S.init(MTOK, 2 * DFF, G, bx);
        pg8::EpiGateUp E{ss2, ACT};
        pg8::gemm_phase<pg8::EpiGateUp, pg8::StaticOrder, true, true>(L, g, S, E);
    }
    XSYNC();
    for (int rep_ = 0; rep_ < 1 + ((REPMASK >> 6) & 1); ++rep_) if ((PHMASK >> 6) & 1) {
        pg8::Gemm g{ACT, ACT, Wdn_t, DFF, DFF, DFF / 64}; pg8::StaticOrder S; S.init(MTOK, DM, G, bx);
        pg8::EpiResid<true> E{H2B, H3B, ss3, nullptr};
        pg8::gemm_phase<pg8::EpiResid<true>, pg8::StaticOrder, true, true>(L, g, S, E);
    }
    XSYNC();
    for (int rep_ = 0; rep_ < 1 + ((REPMASK >> 7) & 1); ++rep_) if ((PHMASK >> 7) & 1) {
        PIN_TID();
        const int gw = vcu * 8 + wave, NGW = G * 8; const float* wf = a.in[16];
        f32x4 wv[4];
#pragma unroll
        for (int j = 0; j < 4; ++j) wv[j] = ((const f32x4*)wf)[lane + 64 * j];
        for (int m0 = gw * 4; m0 < MTOK; m0 += NGW * 4) {
            unsigned long long w[4][4]; float r3[4];
#pragma unroll
            for (int r = 0; r < 4; ++r) { const unsigned long long* i8 = (const unsigned long long*)(H3B + (size_t)(m0 + r) * DM) + lane; r3[r] = ss3[m0 + r];
#pragma unroll
                for (int j = 0; j < 4; ++j) w[r][j] = __builtin_nontemporal_load(&i8[64 * j]); }
#pragma unroll
            for (int r = 0; r < 4; ++r) { f32x4* orow = (f32x4*)(a.out + (size_t)(m0 + r) * DM) + lane; const float rr = __builtin_amdgcn_rsqf(r3[r] * (1.f / DM) + NORM_EPS);
#pragma unroll
                for (int j = 0; j < 4; ++j) { const unsigned lo = (unsigned)w[r][j], hi = (unsigned)(w[r][j] >> 32);
                    __builtin_nontemporal_store((f32x4){bf_lo(lo), bf_hi(lo), bf_lo(hi), bf_hi(hi)} * wv[j] * rr, &orow[64 * j]); } }
        }
    }
#undef GSYNC
#undef XSYNC
}
#undef Win_t
#undef Wp_t
#undef Wout_t
#undef Wgu_t
#undef Wdn_t
#undef QO
#undef CB
#undef U
#undef SGA
#undef SGB
#undef KB
#undef VB
#undef MG
#undef H2B
#undef ACT
#undef H3B
#undef ss2
#undef ss3
#undef rs1
#undef PM

extern "C" void kernel_launch(void* const* d_in, const int* in_sizes, int n_in, void* d_out, int out_size, void* d_ws, size_t ws_size, hipStream_t stream) {
    static int grid = 0;
    if (grid == 0) {
        if (n_in != 17 || in_sizes[0] != MTOK * DM || out_size != MTOK * DM || ws_size < WS_END) { fprintf(stderr, "kernel_launch: unexpected shapes / workspace (n_in %d, ws %zu)\n", n_in, ws_size); grid = -1; return; }
        int dev = 0, cus = 0, per_cu = 0;
        if (hipGetDevice(&dev) != hipSuccess || hipDeviceGetAttribute(&cus, hipDeviceAttributeMultiprocessorCount, dev) != hipSuccess) { grid = -1; return; }
        if (hipFuncSetAttribute((const void*)fwd_kernel, hipFuncAttributeMaxDynamicSharedMemorySize, LDS_BYTES) != hipSuccess) { fprintf(stderr, "kernel_launch: hipFuncSetAttribute failed\n"); grid = -1; return; }
        if (hipOccupancyMaxActiveBlocksPerMultiprocessor(&per_cu, (const void*)fwd_kernel, 512, LDS_BYTES) != hipSuccess || per_cu < 1) per_cu = 1;
        (void)hipGetLastError();
        grid = cus * per_cu;
    }
    if (grid < 0) return;
    Args a{};
    for (int i = 0; i < 17; ++i) a.in[i] = (const float*)d_in[i];
    a.out = (float*)d_out; a.ws = (unsigned char*)d_ws;
    void* args[] = {&a};
    hipError_t e = hipLaunchCooperativeKernel((const void*)fwd_kernel, dim3(grid), dim3(512), args, LDS_BYTES, stream);
    if (e != hipSuccess) fprintf(stderr, "kernel_launch: cooperative launch failed: %s (grid %d)\n", hipGetErrorString(e), grid);
}
```

```cpp
#include <hip/hip_runtime.h>
#include <hip/hip_cooperative_groups.h>
#include <hip/hip_bf16.h>
#include <cstdio>
#include <cstdint>
#include <cmath>
namespace pg8 {
#define PG8_LAS __attribute__((address_space(3)))
typedef unsigned short bf16_t;
typedef short bf16x8 __attribute__((ext_vector_type(8)));
typedef float f32x4 __attribute__((ext_vector_type(4)));
typedef unsigned u32x4 __attribute__((ext_vector_type(4)));
constexpr int BM = 256, BK = 64, HALF = 128, HTB = HALF * BK * 2  , STAGE_BYTES = 8 * HTB, NXCD = 8, WGM = 8;

__host__ __device__ __forceinline__ int lds_byte(int r, int c) { const int st = (r >> 4) * 2 + (c >> 5), rr = r & 15, cc = c & 31, ob = rr * 64 + cc * 2; return st * 1024 + (ob ^ (((ob >> 9) & 1) << 5)); }
__host__ __device__ __forceinline__ void stage_rc(int b, int& R, int& C) { const int st = b / 1024, sb = b % 1024, swz = sb ^ (((sb >> 9) & 1) << 5); R = (st >> 1) * 16 + swz / 64; C = (st & 1) * 32 + (swz % 64) / 2; }
__host__ __device__ __forceinline__ int perm32(int rho) { const int n = rho >> 4, i = rho & 15; return 8 * (i >> 2) + 4 * n + (i & 3); }

struct Unit { int pm, pn; };
struct Gemm { const bf16_t* A; const bf16_t* A2; const bf16_t* Bt; int lda, K, ks; };

struct StaticOrder {
    int nM, nN, nwg, G, c;
    __host__ __device__ void init(int M, int N, int G_, int c_) { nM = M / BM; nN = N / BM; nwg = nM * nN; G = G_; c = c_; }
    __host__ __device__ bool next(int i, Unit& u) const {
        const long L = (long)i * G + c; if (L >= nwg) return false;
        int wgid = (int)L; { const int q = nwg / NXCD, r = nwg % NXCD, xcd = wgid % NXCD, off = wgid / NXCD; wgid = (xcd < r ? xcd * (q + 1) : r * (q + 1) + (xcd - r) * q) + off; }
        const int nig = WGM * nN, gid = wgid / nig, fm = gid * WGM, gsz = (nM - fm) < WGM ? (nM - fm) : WGM;
        u.pm = fm + ((wgid % nig) % gsz); u.pn = (wgid % nig) / gsz; return true;
    }
    __device__ __forceinline__ void a_ready(const Unit&) const {}
    __device__ __forceinline__ void done(const Unit&) const {}
};

typedef float cvt_f32x2_t __attribute__((ext_vector_type(2))); typedef __bf16 cvt_bf16x2_t __attribute__((ext_vector_type(2)));
__device__ __forceinline__ unsigned cvt_pk_bf16(float lo, float hi) { const cvt_f32x2_t v = {lo, hi}; const cvt_bf16x2_t b = __builtin_convertvector(v, cvt_bf16x2_t); return __builtin_bit_cast(unsigned, b); }
template <class Epi, class Sched, bool ALIGN_EPI = false, bool SP2 = false>
__device__ __forceinline__ void gemm_phase(PG8_LAS unsigned char* lds, const Gemm g, const Sched& S, const Epi& E) {
    int tid_ = threadIdx.x; asm volatile("" : "+v"(tid_));
    const int tid = tid_, wid = __builtin_amdgcn_readfirstlane(tid >> 6), lane = tid & 63, wr = wid >> 2, wc = wid & 3, fr = lane & 15, fq = lane >> 4;
    const int K = g.K, nt = K / BK, ks = g.ks, lda = g.lda;
    unsigned voffA[2], voffB[2];
#pragma unroll
    for (int i = 0; i < 2; ++i) { int R, C; stage_rc(tid * 16 + i * 8192, R, C); const int Rb = Epi::PERM ? ((R & ~31) + perm32(R & 31)) : R;
        voffA[i] = (unsigned)(R * lda + C) * 2u; voffB[i] = (unsigned)(Rb * K + C) * 2u; }
    const size_t kstep = (size_t)(BK * 2);
    const size_t hstepA = (size_t)HALF * lda * 2, hstepB = (size_t)HALF * K * 2;
    const size_t tstepA = 2 * hstepA, tstepB = 2 * hstepB;
    const unsigned ldsw = (unsigned)wid * 1024u;
    const int aoff = lds_byte(wr * 64 + fr, fq * 8), boff = lds_byte(wc * 32 + fr, fq * 8);
#define PG8_SA(b, h) (((b) * 2 + (h)) * HTB)
#define PG8_SB(b, h) ((4 + (b) * 2 + (h)) * HTB)
#define PG8_STAGE(bufoff, gbase, voff) do { _Pragma("unroll") for (int _i = 0; _i < 2; ++_i) \
        __builtin_amdgcn_global_load_lds((const unsigned*)((const char*)(gbase) + (voff)[_i]), (PG8_LAS unsigned*)(lds + (bufoff) + ldsw + _i * 8192), 16, 0, 0); } while (0)
#define PG8_LDA(dst, b, h) do { _Pragma("unroll") for (int m = 0; m < 4; ++m) _Pragma("unroll") for (int k = 0; k < 2; ++k) dst[m][k] = *(const PG8_LAS bf16x8*)(lds + PG8_SA(b, h) + aoff + m * 2048 + k * 1024); } while (0)
#define PG8_LDB(dst, b, h) do { _Pragma("unroll") for (int n = 0; n < 2; ++n) _Pragma("unroll") for (int k = 0; k < 2; ++k) dst[n][k] = *(const PG8_LAS bf16x8*)(lds + PG8_SB(b, h) + boff + n * 2048 + k * 1024); } while (0)
#define PG8_MMA(ai, bj, At, Bt) do { __builtin_amdgcn_s_setprio(1); _Pragma("unroll") for (int m = 0; m < 4; ++m) _Pragma("unroll") for (int n = 0; n < 2; ++n) _Pragma("unroll") for (int k = 0; k < 2; ++k) \
        acc[ai][bj][m][n] = __builtin_amdgcn_mfma_f32_16x16x32_bf16(Bt[n][k], At[m][k], acc[ai][bj][m][n], 0, 0, 0); __builtin_amdgcn_s_setprio(0); } while (0)
#define PG8_WAIT_V(n) asm volatile("s_waitcnt vmcnt(" #n ")" ::: "memory")
#define PG8_WAIT_L(n) asm volatile("s_waitcnt lgkmcnt(" #n ")" ::: "memory")
#define PG8_BAR __builtin_amdgcn_s_barrier()
#define PG8_SCHED __builtin_amdgcn_sched_barrier(0)
    Unit cur, nxt; int ui = 0;
    if (!S.next(0, cur)) return;
    f32x4 acc[2][2][4][2];
#pragma unroll
    for (int a = 0; a < 2; ++a)
#pragma unroll
        for (int b = 0; b < 2; ++b)
#pragma unroll
            for (int m = 0; m < 4; ++m)
#pragma unroll
                for (int n = 0; n < 2; ++n) acc[a][b][m][n] = (f32x4){0.f, 0.f, 0.f, 0.f};
    bf16x8 At[4][2], B0[2][2], B1[2][2];
    const char* cA = (const char*)g.A + (size_t)cur.pm * tstepA; const char* cA2 = (const char*)g.A2 + (size_t)cur.pm * tstepA; const char* cB = (const char*)g.Bt + (size_t)cur.pn * tstepB;
    S.a_ready(cur);
    if constexpr (SP2) {
        PG8_STAGE(PG8_SB(0, 0), cB, voffB); PG8_STAGE(PG8_SB(0, 1), cB + hstepB, voffB); PG8_STAGE(PG8_SA(0, 0), cA, voffA); PG8_STAGE(PG8_SA(0, 1), cA + hstepA, voffA);
        if (wr == 1) PG8_BAR;
        PG8_WAIT_V(2); PG8_BAR;
        PG8_STAGE(PG8_SB(1, 0), cB + kstep, voffB); PG8_STAGE(PG8_SA(1, 0), cA + kstep, voffA); PG8_STAGE(PG8_SB(1, 1), cB + hstepB + kstep, voffB);
        PG8_WAIT_V(6); PG8_BAR;
    } else {
        PG8_STAGE(PG8_SB(0, 0), cB, voffB); PG8_STAGE(PG8_SA(0, 0), cA, voffA); PG8_STAGE(PG8_SB(0, 1), cB + hstepB, voffB); PG8_STAGE(PG8_SA(0, 1), cA + hstepA, voffA);
        if (wr == 1) PG8_BAR;
        PG8_WAIT_V(4); PG8_BAR;
        PG8_STAGE(PG8_SB(1, 0), cB + kstep, voffB); PG8_STAGE(PG8_SA(1, 0), cA + kstep, voffA); PG8_STAGE(PG8_SB(1, 1), cB + hstepB + kstep, voffB);
        PG8_WAIT_V(6); PG8_BAR;
    }
    for (;;) {
        const bool has_next = S.next(ui + 1, nxt);
        const char* nA = has_next ? (const char*)g.A + (size_t)nxt.pm * tstepA : cA; const char* nA2 = has_next ? (const char*)g.A2 + (size_t)nxt.pm * tstepA : cA2; const char* nB = has_next ? (const char*)g.Bt + (size_t)nxt.pn * tstepB : cB;
        for (int t = 0; t < nt; t += 2) {
            const bool last = (t == nt - 2);
#define PG8_ATILE(tt) ((tt) < ks ? cA + (size_t)(tt) * kstep : cA2 + (size_t)((tt) - ks) * kstep)
            if constexpr (Epi::MID) { if (t == ks) E.mid(acc, cur, wr, wc, fr, fq); }
            const char* a1 = PG8_ATILE(t + 1);
            const char* a2 = last ? nA : PG8_ATILE(t + 2); const char* b2 = last ? nB : cB + (size_t)(t + 2) * kstep;
            const char* a3 = last ? nA + kstep : PG8_ATILE(t + 3); const char* b3 = b2 + kstep;
            if (last && has_next) S.a_ready(nxt);
            if constexpr (SP2) {
            PG8_LDB(B0, 0, 0); PG8_LDB(B1, 0, 1); PG8_SCHED; PG8_LDA(At, 0, 0); PG8_STAGE(PG8_SA(1, 1), a1 + hstepA, voffA);
            PG8_WAIT_V(8); PG8_WAIT_L(0); PG8_BAR; PG8_MMA(0, 0, At, B0); PG8_MMA(0, 1, At, B1); PG8_BAR; PG8_SCHED;
            PG8_LDA(At, 0, 1); PG8_STAGE(PG8_SB(0, 0), b2, voffB); PG8_STAGE(PG8_SB(0, 1), b2 + hstepB, voffB); PG8_STAGE(PG8_SA(0, 0), a2, voffA);
            PG8_WAIT_V(8); PG8_WAIT_L(0); PG8_BAR; PG8_MMA(1, 0, At, B0); PG8_MMA(1, 1, At, B1); PG8_BAR; PG8_SCHED;
            PG8_LDB(B0, 1, 0); PG8_LDB(B1, 1, 1); PG8_SCHED; PG8_LDA(At, 1, 0); PG8_STAGE(PG8_SA(0, 1), a2 + hstepA, voffA);
            PG8_WAIT_V(8); PG8_WAIT_L(0); PG8_BAR; PG8_MMA(0, 0, At, B0); PG8_MMA(0, 1, At, B1); PG8_BAR; PG8_SCHED;
            PG8_LDA(At, 1, 1); PG8_STAGE(PG8_SB(1, 0), b3, voffB); PG8_STAGE(PG8_SB(1, 1), b3 + hstepB, voffB); PG8_STAGE(PG8_SA(1, 0), a3, voffA);
            PG8_WAIT_V(8); PG8_WAIT_L(0); PG8_BAR; PG8_MMA(1, 0, At, B0); PG8_MMA(1, 1, At, B1); PG8_BAR; PG8_SCHED;
            } else {
            PG8_LDB(B0, 0, 0); PG8_SCHED; PG8_LDA(At, 0, 0); PG8_STAGE(PG8_SA(1, 1), a1 + hstepA, voffA);
            PG8_WAIT_L(8); PG8_BAR; PG8_WAIT_L(0); PG8_MMA(0, 0, At, B0); PG8_BAR; PG8_SCHED;
            PG8_LDB(B1, 0, 1); PG8_STAGE(PG8_SB(0, 0), b2, voffB);
            PG8_BAR; PG8_WAIT_L(0); PG8_MMA(0, 1, At, B1); PG8_BAR;
            PG8_LDA(At, 0, 1); PG8_STAGE(PG8_SA(0, 0), a2, voffA);
            PG8_BAR; PG8_WAIT_L(0); PG8_MMA(1, 0, At, B0); PG8_BAR; PG8_SCHED;
            PG8_STAGE(PG8_SB(0, 1), b2 + hstepB, voffB);
            PG8_WAIT_V(6); PG8_BAR; PG8_MMA(1, 1, At, B1); PG8_BAR;
            PG8_LDB(B0, 1, 0); PG8_SCHED; PG8_LDA(At, 1, 0); PG8_STAGE(PG8_SA(0, 1), a2 + hstepA, voffA);
            PG8_WAIT_L(8); PG8_BAR; PG8_WAIT_L(0); PG8_MMA(0, 0, At, B0); PG8_BAR; PG8_SCHED;
            PG8_LDB(B1, 1, 1); PG8_STAGE(PG8_SB(1, 0), b3, voffB);
            PG8_BAR; PG8_WAIT_L(0); PG8_MMA(0, 1, At, B1); PG8_BAR;
            PG8_LDA(At, 1, 1); PG8_STAGE(PG8_SA(1, 0), a3, voffA);
            PG8_BAR; PG8_WAIT_L(0); PG8_MMA(1, 0, At, B0); PG8_BAR; PG8_SCHED;
            PG8_STAGE(PG8_SB(1, 1), b3 + hstepB, voffB);
            PG8_WAIT_V(6); PG8_BAR; PG8_MMA(1, 1, At, B1); PG8_BAR;
            }
        }
        if constexpr (ALIGN_EPI) { if (wr == 0) PG8_BAR; }
        if constexpr (!Epi::AFTER_DRAIN) { E(acc, cur, wr, wc, fr, fq); S.done(cur); }
        if (!has_next) break;
#pragma unroll
        for (int a = 0; a < 2; ++a)
#pragma unroll
            for (int b = 0; b < 2; ++b)
#pragma unroll
                for (int m = 0; m < 4; ++m)
#pragma unroll
                    for (int n = 0; n < 2; ++n) acc[a][b][m][n] = (f32x4){0.f, 0.f, 0.f, 0.f};
        cur = nxt; cA = nA; cA2 = nA2; cB = nB; ++ui;
        if constexpr (ALIGN_EPI) { if (wr == 1) PG8_BAR; }
    }
    PG8_WAIT_V(0);
    if constexpr (!ALIGN_EPI) { if (wr == 0) PG8_BAR; }
    PG8_BAR;
    if constexpr (Epi::AFTER_DRAIN) { E.fused(acc, cur, wr, wc, fr, fq, lds, wid, lane); S.done(cur); }
#undef PG8_SA
#undef PG8_ATILE
#undef PG8_SB
#undef PG8_STAGE
#undef PG8_LDA
#undef PG8_LDB
#undef PG8_MMA
#undef PG8_WAIT_V
#undef PG8_WAIT_L
#undef PG8_BAR
#undef PG8_SCHED
}
}

namespace attn_body {
using bf16=__hip_bfloat16;
using bf16x8=__attribute__((ext_vector_type(8)))short;
using s16x4=__attribute__((ext_vector_type(4)))short;
using f32x16=__attribute__((ext_vector_type(16)))float;
using u32x4=__attribute__((ext_vector_type(4)))unsigned;
constexpr int D=64,DM=1024;
constexpr int NW=8,QBLK=32,QB=QBLK*NW,KVBLK=64;
constexpr int ATTN_PITCH=DM, ATTN_UNIT_ROWS=QB;
__device__ __forceinline__ int crow(int r,int hi){return (r&3)+8*(r>>2)+4*hi;}
#define SBAR() __builtin_amdgcn_sched_barrier(0)
__device__ __forceinline__ void cmask(f32x16&p0,f32x16&p1,int jb,int qrel,int hi){
  const float NEG=-INFINITY; int kb=64*jb+4*hi;
  #pragma unroll
  for(int r=0;r<16;++r){int kv=kb+(r&3)+8*(r>>2); if(kv>qrel)p0[r]=NEG; if(kv+32>qrel)p1[r]=NEG;}
}

constexpr int NSLOT=3, SLOTB=8192;
constexpr int LDS_K=0, LDS_V=NSLOT*SLOTB, LDS_WS=LDS_V+2*NSLOT*SLOTB, LDS_H=LDS_WS+NW*64*4, LDS_BYTES=LDS_H+NW*8192;
constexpr float C2=0.125f*1.4426950408889634f;
__device__ __forceinline__ void glds16(const void*gsrc,unsigned lds_dst){unsigned keep;
  asm volatile("s_mov_b32 %0, m0\n\ts_mov_b32 m0, %2\n\ts_nop 0\n\tglobal_load_lds_dwordx4 %1, off\n\ts_mov_b32 m0, %0":"=&s"(keep):"v"(gsrc),"s"(lds_dst):"memory");}
__device__ __forceinline__ void glds16s(const void*sbase,unsigned voff,unsigned lds_dst){unsigned keep;
  asm volatile("s_nop 4\n\ts_mov_b32 %0, m0\n\ts_mov_b32 m0, %2\n\ts_nop 0\n\tglobal_load_lds_dwordx4 %1, %3\n\ts_mov_b32 m0, %0":"=&s"(keep):"v"(voff),"s"(lds_dst),"s"(sbase):"memory");}
__device__ __forceinline__ float max3f(float a,float b,float c){float r;asm("v_max3_f32 %0, %1, %2, %3":"=v"(r):"v"(a),"v"(b),"v"(c));return r;}
__device__ __forceinline__ float max2f(float a,float b){float r;asm("v_max_f32_e32 %0, %1, %2":"=v"(r):"v"(a),"v"(b));return r;}
__device__ __forceinline__ float fadd_s(float a,float b){float r;asm("v_add_f32_e32 %0, %1, %2":"=v"(r):"v"(a),"v"(b));return r;}
__device__ __forceinline__ float fsub_s(float a,float b){float r;asm("v_sub_f32_e32 %0, %1, %2":"=v"(r):"v"(a),"v"(b));return r;}
typedef float f32x2_t __attribute__((ext_vector_type(2))); typedef __bf16 bf16x2_t __attribute__((ext_vector_type(2)));
__device__ __forceinline__ unsigned cvtpk_s(float lo,float hi){f32x2_t v={lo,hi};bf16x2_t b=__builtin_convertvector(v,bf16x2_t);return __builtin_bit_cast(unsigned,b);}
#define WAIT_BAR(N) asm volatile("s_waitcnt vmcnt(" #N ") lgkmcnt(0)\n\ts_barrier":::"memory")

__device__ __forceinline__ void qkt(f32x16&p0,f32x16&p1,const char*Kslot,const bf16x8*qr,int r32,int hi){ const f32x16 zc=f32x16{};
  const char*kb=Kslot+hi*1024+r32*16;
  #pragma unroll
  for(int d0=0;d0<4;++d0){
    const bf16x8 b0=*reinterpret_cast<const bf16x8*>(kb+d0*2048);
    const bf16x8 b1=*reinterpret_cast<const bf16x8*>(kb+d0*2048+512);
    if(d0==0){p0=__builtin_amdgcn_mfma_f32_32x32x16_bf16(b0,qr[0],zc,0,0,0);p1=__builtin_amdgcn_mfma_f32_32x32x16_bf16(b1,qr[0],zc,0,0,0);}
    else{p0=__builtin_amdgcn_mfma_f32_32x32x16_bf16(b0,qr[d0],p0,0,0,0);p1=__builtin_amdgcn_mfma_f32_32x32x16_bf16(b1,qr[d0],p1,0,0,0);}}
}
typedef __attribute__((address_space(3))) const char* lds_cptr;
typedef short v4i16_t __attribute__((ext_vector_type(4)));
__device__ __forceinline__ void kload8(bf16x8*kf,lds_cptr kp){
  kf[0]=*(const __attribute__((address_space(3))) bf16x8*)(kp);      kf[1]=*(const __attribute__((address_space(3))) bf16x8*)(kp+512);
  kf[2]=*(const __attribute__((address_space(3))) bf16x8*)(kp+2048); kf[3]=*(const __attribute__((address_space(3))) bf16x8*)(kp+2560);
  kf[4]=*(const __attribute__((address_space(3))) bf16x8*)(kp+4096); kf[5]=*(const __attribute__((address_space(3))) bf16x8*)(kp+4608);
  kf[6]=*(const __attribute__((address_space(3))) bf16x8*)(kp+6144); kf[7]=*(const __attribute__((address_space(3))) bf16x8*)(kp+6656);
}
__device__ __forceinline__ void kload2(bf16x8*kf,lds_cptr kp,int j){ kf[2*j]=*(const __attribute__((address_space(3))) bf16x8*)(kp+j*2048); kf[2*j+1]=*(const __attribute__((address_space(3))) bf16x8*)(kp+j*2048+512); }
__device__ __forceinline__ s16x4 vtr(lds_cptr p){ return __builtin_bit_cast(s16x4,__builtin_amdgcn_ds_read_tr16_b64_v4i16((__attribute__((address_space(3))) v4i16_t*)p)); }
__device__ __forceinline__ float rowmax(const f32x16&p0,const f32x16&p1){
  float a=max3f(p0[0],p0[1],p1[0]),b=max3f(p0[2],p0[3],p1[1]);a=max3f(a,p1[2],p1[3]);
  #pragma unroll
  for(int r=4;r<16;r+=4){a=max3f(a,p0[r],p0[r+1]);b=max3f(b,p0[r+2],p0[r+3]);a=max3f(a,p1[r],p1[r+1]);b=max3f(b,p1[r+2],p1[r+3]);}
  const float m=max2f(a,b);
  auto rr=__builtin_amdgcn_permlane32_swap(__float_as_uint(m),__float_as_uint(m),false,false);
  return max2f(__uint_as_float(rr[0]),__uint_as_float(rr[1]));
}
__device__ __forceinline__ void pv(f32x16*o,int vb,bf16x8 pa0,bf16x8 pa1,bf16x8 pa2,bf16x8 pa3){
  #pragma unroll
  for(int d0=0;d0<2;++d0){s16x4 lo[4],hi[4];
    #pragma unroll
    for(int ks=0;ks<4;++ks){
      asm volatile("ds_read_b64_tr_b16 %0,%1 offset:%c2":"=&v"(lo[ks]):"v"(vb),"i"(d0*4096+ks*1024):"memory");
      asm volatile("ds_read_b64_tr_b16 %0,%1 offset:%c2":"=&v"(hi[ks]):"v"(vb),"i"(d0*4096+ks*1024+512):"memory");}
    asm volatile("s_waitcnt lgkmcnt(0)":::"memory");SBAR();
    #define PK(k) (bf16x8){lo[k][0],lo[k][1],lo[k][2],lo[k][3],hi[k][0],hi[k][1],hi[k][2],hi[k][3]}
    o[d0]=__builtin_amdgcn_mfma_f32_32x32x16_bf16(pa0,PK(0),o[d0],0,0,0);
    o[d0]=__builtin_amdgcn_mfma_f32_32x32x16_bf16(pa1,PK(1),o[d0],0,0,0);
    o[d0]=__builtin_amdgcn_mfma_f32_32x32x16_bf16(pa2,PK(2),o[d0],0,0,0);
    o[d0]=__builtin_amdgcn_mfma_f32_32x32x16_bf16(pa3,PK(3),o[d0],0,0,0);
    #undef PK
  }
}

#ifndef ATTN_STORE16
#define ATTN_STORE16(p,v) (*(u32x4*)(p)=(v))
#endif
template<int THRL> __device__ __forceinline__ void attn_pass(const bf16*Qw,const bf16*__restrict__ Kh,const bf16*__restrict__ Vh,int NT,int m_sub,float lam,char*shm,const bf16*Kh_next,bool has_next,bool prefetched){
  const int tid=threadIdx.x; int lane_=tid&63; asm volatile("":"+v"(lane_));
  const int lane=lane_,r32=lane&31,hi=lane>>5; const int wid=__builtin_amdgcn_readfirstlane(tid>>6);
  if(wid>=4)__builtin_amdgcn_s_setprio(1);
  const unsigned lds0=(unsigned)(uintptr_t)shm;
  float*wsf=(float*)(shm+LDS_WS)+wid*64;
  const bf16*ksrc=Kh+wid*8; const unsigned koff=(unsigned)lane*(DM*2);
  const bf16*vsrc=Vh+(long)(16*(wid&3))*DM+(wid>>2)*32; const unsigned voff=(unsigned)(lane>>2)*(DM*2)+(unsigned)(lane&3)*16;
  const unsigned kdst=lds0+LDS_K+wid*1024, vdst=lds0+LDS_V+wid*1024;
  #define DMA_K(t,slot) glds16s(ksrc+(long)(t)*KVBLK*DM,koff,(unsigned)__builtin_amdgcn_readfirstlane(kdst+(slot)))
  #define DMA_V(t,slot) do{ glds16s(vsrc+(long)(t)*KVBLK*DM,voff,(unsigned)__builtin_amdgcn_readfirstlane(vdst+2*(slot))); glds16s(vsrc+(long)(t)*KVBLK*DM+64,voff,(unsigned)__builtin_amdgcn_readfirstlane(vdst+2*(slot)+8192)); }while(0)
  const int vb0=(int)(lds0+LDS_V)+((lane>>4)&1)*32+(lane&3)*8+(4*hi+((lane&15)>>2))*64;
  const char*Kbase=shm+LDS_K; bf16x8 kf[8];
  const lds_cptr shm3=(lds_cptr)shm; const lds_cptr kp0=shm3+LDS_K+hi*1024+r32*16; const lds_cptr vp0=shm3+LDS_V+((lane>>4)&1)*32+(lane&3)*8+(4*hi+((lane&15)>>2))*64;
  if(!prefetched){DMA_K(0,0);DMA_V(0,0);DMA_K(1,SLOTB);}
  bf16x8 qr[4];
  #pragma unroll
  for(int d0=0;d0<4;++d0)qr[d0]=*reinterpret_cast<const bf16x8*>(&Qw[(long)r32*DM+d0*16+hi*8]);
  float mhat=0.f,l_reg=0.f;f32x16 o[4]; { float z_; asm volatile("v_mov_b32 %0, 0":"=v"(z_)); _Pragma("unroll") for(int r=0;r<16;++r){o[0][r]=z_;o[1][r]=z_;o[2][r]=z_;o[3][r]=z_;} }
  const int qrel=wid*QBLK+r32;
  #define CMASK(P0,P1,t) do{int jb_=(t)-(NT-4); if(jb_>=0)cmask(P0,P1,jb_,qrel,hi);}while(0)
  bool resc=false;
  #define START(P0,P1) do{ const float rm=rowmax(P0,P1); resc=false; \
    { const float dl=rm; mhat=fadd_s(mhat,dl); \
      _Pragma("unroll") for(int r=0;r<16;++r){P0[r]=fsub_s(P0[r],dl);P1[r]=fsub_s(P1[r],dl);} \
      } \
    _Pragma("unroll") for(int r=0;r<16;++r)P0[r]=__builtin_amdgcn_exp2f(P0[r]); }while(0)
  #define RESC() do{ if(resc){ asm volatile("s_waitcnt lgkmcnt(0)":::"memory"); \
      _Pragma("unroll") for(int d_=0;d_<4;++d_) _Pragma("unroll") for(int r=0;r<16;++r)o[d_][r]*=wsf[crow(r,hi)]; } }while(0)
  f32x16 pA0,pA1,pB0,pB1;
  int sl_prev=0,sl_cur=0,sl_next=SLOTB;
  #define ROT() do{sl_prev=sl_cur;sl_cur=sl_next;sl_next=(sl_next==(NSLOT-1)*SLOTB)?0:sl_next+SLOTB;}while(0)
  DMA_K(2,2*SLOTB);
  WAIT_BAR(4);
  qkt(pA0,pA1,Kbase,qr,r32,hi);asm volatile("s_nop 15\n\ts_nop 7":"+v"(pA0),"+v"(pA1));
  { _Pragma("unroll") for(int r=8;r<16;++r)pA0[r]=-INFINITY; _Pragma("unroll") for(int r=0;r<16;++r)pA1[r]=-INFINITY; }
  START(pA0,pA1);
  _Pragma("unroll") for(int r=0;r<16;++r)pA1[r]=__builtin_amdgcn_exp2f(pA1[r]);
  WAIT_BAR(0);
  DMA_K(3,0);DMA_V(1,SLOTB);
  ROT();
  kload8(kf,kp0+sl_cur);
  WAIT_BAR(3);
  s16x4 vlo[8],vhi[8]; u32x4 pw0,pw1,pw2,pw3;
  #define PKW(P,B) cvtpk_s(P[B],P[B+1])
  #define PAF(k) __builtin_bit_cast(bf16x8,pw##k)
  #define VFR(i) (bf16x8){vlo[i][0],vlo[i][1],vlo[i][2],vlo[i][3],vhi[i][0],vhi[i][1],vhi[i][2],vhi[i][3]}
  #define PIN(x) asm volatile("":"+v"(x))
  #define MX3(a,b,c) __builtin_fmaxf(__builtin_fmaxf((a),(b)),(c))
  #define GAPA(MF,A0,A1,A2,A3,W0,W1,PW) do{ MF; sacc+=A0; sacc+=A1; sacc+=A2; sacc+=A3; PIN(sacc); W0; W1; PIN(PW); SBAR(); }while(0)
  #define EX(v) __builtin_amdgcn_exp2f(v)
  #define GAPB(MF,X,B) do{ MF; X[B]=EX(X[B]); X[B+1]=EX(X[B+1]); X[B+2]=EX(X[B+2]); X[B+3]=EX(X[B+3]); PIN(X); SBAR(); }while(0)
  #define GAPB2(MF,RD,X,B) do{ MF; RD; X[B]=EX(X[B]); X[B+1]=EX(X[B+1]); PIN(X); SBAR(); }while(0)
  #define VRD2(i) do{ vlo[i]=vtr(vp2_+(((i)>>2)*4096+((i)&3)*1024)); vhi[i]=vtr(vp2_+(((i)>>2)*4096+((i)&3)*1024+512)); }while(0)
  #define VRD(i) do{ vlo[i]=vtr(vp_+(((i)>>2)*4096+((i)&3)*1024)); vhi[i]=vtr(vp_+(((i)>>2)*4096+((i)&3)*1024+512)); }while(0)
  #define KRD(G,j) do{ if(G){ kload2(kf,kp0+sl_next,j); SBAR(); } }while(0)
  #define STEP(C0,C1,P0,P1,t,GK,GV,GL) do{ SBAR(); \
    const lds_cptr vp_=vp0+2*sl_prev; \
    VRD(0); SBAR(); float sacc=(P0[0]+P0[1]); \
    GAPA(C0=__builtin_amdgcn_mfma_f32_32x32x16_bf16(kf[0],qr[0],f32x16{},0,0,0), P0[2],P0[3],P0[4],P0[5],     pw0[0]=PKW(P0,0), pw0[1]=PKW(P0,2), pw0); \
    VRD(4); SBAR(); GAPA(C1=__builtin_amdgcn_mfma_f32_32x32x16_bf16(kf[1],qr[0],f32x16{},0,0,0), P0[6],P0[7],P0[8],P0[9],     pw0[2]=PKW(P0,4), pw0[3]=PKW(P0,6), pw0); \
    VRD(1); SBAR(); GAPA(C0=__builtin_amdgcn_mfma_f32_32x32x16_bf16(kf[2],qr[1],C0,0,0,0),   P0[10],P0[11],P0[12],P0[13], pw1[0]=PKW(P0,8), pw1[1]=PKW(P0,10), pw1); \
    VRD(5); SBAR(); GAPA(C1=__builtin_amdgcn_mfma_f32_32x32x16_bf16(kf[3],qr[1],C1,0,0,0),   P0[14],P0[15],P1[0],P1[1],   pw1[2]=PKW(P0,12),pw1[3]=PKW(P0,14), pw1); \
    VRD(2); SBAR(); GAPA(C0=__builtin_amdgcn_mfma_f32_32x32x16_bf16(kf[4],qr[2],C0,0,0,0),   P1[2],P1[3],P1[4],P1[5],     pw2[0]=PKW(P1,0), pw2[1]=PKW(P1,2), pw2); \
    VRD(6); SBAR(); GAPA(C1=__builtin_amdgcn_mfma_f32_32x32x16_bf16(kf[5],qr[2],C1,0,0,0),   P1[6],P1[7],P1[8],P1[9],     pw2[2]=PKW(P1,4), pw2[3]=PKW(P1,6), pw2); \
    VRD(3); SBAR(); GAPA(C0=__builtin_amdgcn_mfma_f32_32x32x16_bf16(kf[6],qr[3],C0,0,0,0),   P1[10],P1[11],P1[12],P1[13], pw3[0]=PKW(P1,8), pw3[1]=PKW(P1,10), pw3); \
    VRD(7); SBAR(); GAPA(C1=__builtin_amdgcn_mfma_f32_32x32x16_bf16(kf[7],qr[3],C1,0,0,0),   P1[14],P1[15],0.f,0.f,       pw3[2]=PKW(P1,12),pw3[3]=PKW(P1,14), pw3); \
    l_reg+=sacc; \
    _Pragma("unroll") for(int r=0;r<16;++r){C0[r]-=mhat;C1[r]-=mhat;} \
    if(GK){DMA_K((t)+3,sl_cur);} if(GV){DMA_V((t)+1,sl_next);} \
    CMASK(C0,C1,t); \
    { float a=MX3(C0[0],C0[1],C1[0]),b=MX3(C0[2],C0[3],C1[1]); a=MX3(a,C1[2],C1[3]); \
      _Pragma("unroll") for(int r=4;r<16;r+=4){a=MX3(a,C0[r],C0[r+1]);b=MX3(b,C0[r+2],C0[r+3]);a=MX3(a,C1[r],C1[r+1]);b=MX3(b,C1[r+2],C1[r+3]);} \
      float rm=__builtin_fmaxf(a,b); { auto rr=__builtin_amdgcn_permlane32_swap(__float_as_uint(rm),__float_as_uint(rm),false,false); rm=__builtin_fmaxf(__uint_as_float(rr[0]),__uint_as_float(rr[1])); } \
      resc=false; \
      if(__builtin_expect(__any(rm>(float)THRL),0)){ const float dl=__builtin_fmaxf(rm,0.f); mhat+=dl; \
        _Pragma("unroll") for(int r=0;r<16;++r){C0[r]-=dl;C1[r]-=dl;} \
        const float f=__builtin_amdgcn_exp2f(-dl); l_reg*=f; if(hi==0)wsf[r32]=f; resc=true; } } \
    SBAR(); \
    const lds_cptr vp2_=vp0+2*sl_prev+8192; \
    GAPB2(o[0]=__builtin_amdgcn_mfma_f32_32x32x16_bf16(PAF(0),VFR(0),o[0],0,0,0), VRD2(0), C0,0); \
    GAPB2(o[1]=__builtin_amdgcn_mfma_f32_32x32x16_bf16(PAF(0),VFR(4),o[1],0,0,0), VRD2(4), C0,2); \
    GAPB2(o[0]=__builtin_amdgcn_mfma_f32_32x32x16_bf16(PAF(1),VFR(1),o[0],0,0,0), VRD2(1), C0,4); \
    GAPB2(o[1]=__builtin_amdgcn_mfma_f32_32x32x16_bf16(PAF(1),VFR(5),o[1],0,0,0), VRD2(5), C0,6); \
    GAPB2(o[0]=__builtin_amdgcn_mfma_f32_32x32x16_bf16(PAF(2),VFR(2),o[0],0,0,0), VRD2(2), C0,8); \
    GAPB2(o[1]=__builtin_amdgcn_mfma_f32_32x32x16_bf16(PAF(2),VFR(6),o[1],0,0,0), VRD2(6), C0,10); \
    GAPB2(o[0]=__builtin_amdgcn_mfma_f32_32x32x16_bf16(PAF(3),VFR(3),o[0],0,0,0), VRD2(3), C0,12); \
    GAPB2(o[1]=__builtin_amdgcn_mfma_f32_32x32x16_bf16(PAF(3),VFR(7),o[1],0,0,0), VRD2(7), C0,14); \
    KRD(GL,0); GAPB2(o[2]=__builtin_amdgcn_mfma_f32_32x32x16_bf16(PAF(0),VFR(0),o[2],0,0,0), (void)0, C1,0); \
    KRD(GL,1); GAPB2(o[3]=__builtin_amdgcn_mfma_f32_32x32x16_bf16(PAF(0),VFR(4),o[3],0,0,0), (void)0, C1,2); \
    KRD(GL,2); GAPB2(o[2]=__builtin_amdgcn_mfma_f32_32x32x16_bf16(PAF(1),VFR(1),o[2],0,0,0), (void)0, C1,4); \
    KRD(GL,3); GAPB2(o[3]=__builtin_amdgcn_mfma_f32_32x32x16_bf16(PAF(1),VFR(5),o[3],0,0,0), (void)0, C1,6); \
    GAPB2(o[2]=__builtin_amdgcn_mfma_f32_32x32x16_bf16(PAF(2),VFR(2),o[2],0,0,0), (void)0, C1,8); \
    GAPB2(o[3]=__builtin_amdgcn_mfma_f32_32x32x16_bf16(PAF(2),VFR(6),o[3],0,0,0), (void)0, C1,10); \
    GAPB2(o[2]=__builtin_amdgcn_mfma_f32_32x32x16_bf16(PAF(3),VFR(3),o[2],0,0,0), (void)0, C1,12); \
    GAPB2(o[3]=__builtin_amdgcn_mfma_f32_32x32x16_bf16(PAF(3),VFR(7),o[3],0,0,0), (void)0, C1,14); \
    }while(0)
  int t=1;
  #undef CMASK
  #define CMASK(P0,P1,t) do{}while(0)
  for(;t+5<NT;t+=2){
    STEP(pB0,pB1,pA0,pA1,t,true,true,true);     WAIT_BAR(3); RESC(); ROT();
    STEP(pA0,pA1,pB0,pB1,t+1,true,true,true);   WAIT_BAR(3); RESC(); ROT();
  }
  #undef CMASK
  #define CMASK(P0,P1,t) do{int jb_=(t)-(NT-4); if(jb_>=0)cmask(P0,P1,jb_,qrel,hi);}while(0)
  #define ENDW(tt) do{ if((tt)+3<NT){WAIT_BAR(3);} else if((tt)+2<NT){WAIT_BAR(2);} else {WAIT_BAR(0);} }while(0)
  for(;t+3<NT;t+=2){
    STEP(pB0,pB1,pA0,pA1,t,(t+3<NT),(t+1<NT),(t+1<NT));       ENDW(t);   RESC(); ROT();
    STEP(pA0,pA1,pB0,pB1,t+1,(t+4<NT),(t+2<NT),(t+2<NT));     ENDW(t+1); RESC(); ROT();
  }
  STEP(pB0,pB1,pA0,pA1,NT-2,false,true,true);  WAIT_BAR(0); RESC(); ROT();
  STEP(pA0,pA1,pB0,pB1,NT-1,false,false,false); RESC();
  { float sacc=pA0[0]+pA0[1]; _Pragma("unroll") for(int r=2;r<16;++r)sacc+=pA0[r]; _Pragma("unroll") for(int r=0;r<16;++r)sacc+=pA1[r]; l_reg+=sacc;
    pw0=(u32x4){PKW(pA0,0),PKW(pA0,2),PKW(pA0,4),PKW(pA0,6)};pw1=(u32x4){PKW(pA0,8),PKW(pA0,10),PKW(pA0,12),PKW(pA0,14)};pw2=(u32x4){PKW(pA1,0),PKW(pA1,2),PKW(pA1,4),PKW(pA1,6)};pw3=(u32x4){PKW(pA1,8),PKW(pA1,10),PKW(pA1,12),PKW(pA1,14)};
    SBAR(); pv(o,vb0+2*sl_cur,PAF(0),PAF(1),PAF(2),PAF(3)); pv(o+2,vb0+2*sl_cur+8192,PAF(0),PAF(1),PAF(2),PAF(3)); }
  asm volatile("s_waitcnt lgkmcnt(0)\n\ts_barrier":::"memory");
  if(has_next){ const bf16*ksrc_n=Kh_next+wid*8;
    glds16s(ksrc_n,koff,(unsigned)__builtin_amdgcn_readfirstlane(kdst)); DMA_V(0,0); glds16s(ksrc_n+(long)KVBLK*DM,koff,(unsigned)__builtin_amdgcn_readfirstlane(kdst+SLOTB)); }
  #undef PKW
  #undef PAF
  #undef VFR
  #undef PIN
  #undef MX3
  #undef GAPA
  #undef GAPB
  #undef GAPB2
  #undef VRD2
  #undef EX
  #undef VRD
  #undef KRD
  #undef STEP
  #undef ENDW
  {auto rr=__builtin_amdgcn_permlane32_swap(__float_as_uint(l_reg),__float_as_uint(l_reg),false,false);l_reg=__uint_as_float(rr[0])+__uint_as_float(rr[1]);}
  if(hi==0)wsf[32+r32]=l_reg;asm volatile("s_waitcnt lgkmcnt(0)":::"memory");
  float rli[16];
  #pragma unroll
  for(int r=0;r<16;++r)rli[r]=__builtin_amdgcn_rcpf(wsf[32+crow(r,hi)]);
  { typedef __attribute__((address_space(3))) unsigned short* lds_u16p;
    int ln=lane; asm volatile("":"+v"(ln));
    const int r32e=ln&31, hie=ln>>5; const int bc=hie*4+(r32e>>3); const int lb=hie*512+(r32e&7);
    const lds_u16p Hw=(lds_u16p)(shm3+LDS_H+wid*8192);
    #pragma unroll
    for(int r=0;r<16;++r){
      #pragma unroll
      for(int d0=0;d0<4;++d0){ const int idx=lb+((r&3)+8*(r>>2))*128+((bc^(((((r>>2)&1)<<3)|(r&3))^(d0<<2)))<<3);
        float val=o[d0][r]*rli[r];
        if(m_sub){ const float old=__uint_as_float(((unsigned)Hw[idx])<<16); val=old-lam*val; }
        Hw[idx]=(unsigned short)(cvtpk_s(val,0.f)&0xffffu); } } }
  asm volatile("s_waitcnt lgkmcnt(0)":::"memory");
  __builtin_amdgcn_s_setprio(0);
  #undef DMA_K
  #undef DMA_V
  #undef CMASK
  #undef START
  #undef RESC
  #undef ROT
}
constexpr int ATTN_LDS_BYTES=LDS_BYTES;
#undef SBAR
#undef WAIT_BAR
}

namespace cg = cooperative_groups;
#define GAS __attribute__((address_space(1)))
#define LAS __attribute__((address_space(3)))
typedef unsigned short bf16;
typedef unsigned v4u __attribute__((ext_vector_type(4)));
typedef float f32x4 __attribute__((ext_vector_type(4)));

constexpr int NB = 32, SEQ = 2048, DM = 1024, MTOK = NB * SEQ;
constexpr int INC = 8192, DFF = 2816, KROWS = 64 + SEQ;
constexpr float NORM_EPS = 1e-5f, LAMBDA_INIT = 0.2f;
constexpr float QSCALE = 0.125f * 1.4426950408889634f;
constexpr size_t MiB = 1u << 20;
constexpr size_t WS_SS2 = 0, WS_SS3 = 256 * 1024, WS_RS1 = 512 * 1024, WS_PM = 768 * 1024;
constexpr size_t WS_WIN = 2 * MiB, WS_WP = 18 * MiB, WS_WOUT = 22 * MiB, WS_WGU = 24 * MiB, WS_WDN = 35 * MiB;
constexpr size_t WS_QO = 48 * MiB, WS_CB = 176 * MiB, WS_U = 304 * MiB, WS_SGA = 432 * MiB, WS_SGB = 560 * MiB, WS_KB = 688 * MiB, WS_VB = 820 * MiB, WS_END = 952 * MiB;
constexpr size_t WS_MG = WS_KB, WS_H2B = WS_VB, WS_ACT = WS_QO;
static_assert(WS_ACT + (size_t)MTOK * DFF * 2 <= WS_SGA + 128 * MiB && WS_KB + (size_t)NB * KROWS * DM * 2 <= WS_VB && WS_VB + (size_t)NB * KROWS * DM * 2 <= WS_END, "ws map");
constexpr int LDS_BYTES = 147456;
static_assert(attn_body::ATTN_LDS_BYTES <= LDS_BYTES, "attention LDS");
constexpr size_t WS_BAR = 1 * MiB;
constexpr int LDS_BARST = LDS_BYTES - 256;
static_assert(attn_body::ATTN_LDS_BYTES <= LDS_BARST, "attention LDS vs barrier words");
#define RLX_AGENT __ATOMIC_RELAXED, __HIP_MEMORY_SCOPE_AGENT
#define XB_TMO      128
#define XB_XCNT(j)  (256  + 64 * (j))
#define XB_XSUB(j)  (1280 + 64 * (j))
#define XB_XGEN(j)  (2304 + 64 * (j))
#define XB_TOP      3328
#define XB_TOPGEN   3392
#define XCD_BAR_WORDS 3456
#define XB_SPIN_CAP (1u << 18)

__device__ __forceinline__ unsigned xb_ld(unsigned* p)              { return __hip_atomic_load(p, __ATOMIC_RELAXED, __HIP_MEMORY_SCOPE_AGENT); }
__device__ __forceinline__ unsigned xb_add(unsigned* p, unsigned v) { return __hip_atomic_fetch_add(p, v, __ATOMIC_RELAXED, __HIP_MEMORY_SCOPE_AGENT); }
__device__ __forceinline__ unsigned xb_xcc_id() { return (unsigned)__builtin_amdgcn_s_getreg((3 << 11) | 20) & 0xFu; }
#define XB_SPIN(cond, bar) do { unsigned _sp = 0; while (cond) { __builtin_amdgcn_s_sleep(1); \
    if ((++_sp & 255u) == 0u) { if (xb_ld(&(bar)[XB_TMO])) break; if (_sp > XB_SPIN_CAP) { atomicAdd(&(bar)[XB_TMO], 1u); break; } } } } while (0)

struct XcdBarrier {
    unsigned* bar; unsigned x;
    volatile LAS unsigned* st;
};

__device__ __forceinline__ XcdBarrier xcd_barrier_post(unsigned* bar, volatile LAS unsigned* st) {
    XcdBarrier b; b.bar = bar; b.x = xb_xcc_id(); b.st = st;
    if (threadIdx.x == 0) (void)xb_add(&bar[XB_XCNT(b.x)], 1u);
    return b;
}
__device__ __forceinline__ void xcd_barrier_complete(unsigned* bar, unsigned x, unsigned& nloc, unsigned& nx) {
    const unsigned G = gridDim.x * gridDim.y * gridDim.z;
    unsigned sum, cnt, mine, sp = 0u;
    for (;;) {
        sum = 0u; cnt = 0u; mine = 0u;
#pragma unroll
        for (unsigned j = 0; j < 16; ++j) { const unsigned c = xb_ld(&bar[XB_XCNT(j)]); sum += c; cnt += (c > 0u) ? 1u : 0u; mine = (j == x) ? c : mine; }
        if (sum == G) break;
        __builtin_amdgcn_s_sleep(1);
        if ((++sp & 255u) == 0u) { if (xb_ld(&bar[XB_TMO])) break; if (sp > XB_SPIN_CAP) { atomicAdd(&bar[XB_TMO], 1u); break; } }
    }
    nloc = mine > 0u ? mine : 1u; nx = cnt > 0u ? cnt : 1u;
}

__device__ __forceinline__ void xcd_barrier(const XcdBarrier& b) {
    asm volatile("s_waitcnt vmcnt(0)" ::: "memory");
    __syncthreads();
    if (threadIdx.x == 0) {
        unsigned* bar = b.bar;
        __builtin_amdgcn_s_waitcnt(0);
        unsigned nloc = b.st[0], nx = b.st[1];
        if (nloc == 0u) { xcd_barrier_complete(bar, b.x, nloc, nx); b.st[0] = nloc; b.st[1] = nx; }
        const unsigned old = xb_add(&bar[XB_XSUB(b.x)], 1u);
        const unsigned gen = old / nloc;
        if (old + 1u == (gen + 1u) * nloc) {
            __builtin_amdgcn_fence(__ATOMIC_RELEASE, "agent");
            asm volatile("s_waitcnt vmcnt(0)" ::: "memory");
            const unsigned og = xb_add(&bar[XB_TOP], 1u);
            const unsigned tg = og / nx;
            if (og + 1u == (tg + 1u) * nx) xb_add(&bar[XB_TOPGEN], 1u);
            else XB_SPIN(xb_ld(&bar[XB_TOPGEN]) == tg, bar);
            __builtin_amdgcn_fence(__ATOMIC_ACQUIRE, "agent");
            xb_add(&bar[XB_XGEN(b.x)], 1u);
            asm volatile("s_waitcnt vmcnt(0)" ::: "memory");
        } else {
            XB_SPIN(xb_ld(&bar[XB_XGEN(b.x)]) == gen, bar);
            __builtin_amdgcn_fence(__ATOMIC_ACQUIRE, "agent");
            asm volatile("s_waitcnt vmcnt(0)" ::: "memory");
        }
    }
    __syncthreads();
}


template <int K> __device__ __forceinline__ float xor_swz(float v) { return __uint_as_float((unsigned)__builtin_amdgcn_ds_swizzle((int)__float_as_uint(v), (K << 10) | 0x1f)); }
__device__ __forceinline__ float xor32_sum(float v) { auto rr = __builtin_amdgcn_permlane32_swap(__float_as_uint(v), __float_as_uint(v), false, false); return __uint_as_float(rr[0]) + __uint_as_float(rr[1]); }
__device__ __forceinline__ float wave_sum(float v) { v += xor_swz<1>(v); v += xor_swz<2>(v); v += xor_swz<4>(v); v += xor_swz<8>(v); v += xor_swz<16>(v); return xor32_sum(v); }
__device__ __forceinline__ float bf_lo(unsigned w) { return __uint_as_float(w << 16); }
__device__ __forceinline__ float bf_hi(unsigned w) { return __uint_as_float(w & 0xffff0000u); }
__device__ __forceinline__ v4u pack8(f32x4 a, f32x4 b) { v4u w; w.x = pg8::cvt_pk_bf16(a[0], a[1]); w.y = pg8::cvt_pk_bf16(a[2], a[3]); w.z = pg8::cvt_pk_bf16(b[0], b[1]); w.w = pg8::cvt_pk_bf16(b[2], b[3]); return w; }
__device__ __forceinline__ void unpack8(v4u w, f32x4& a, f32x4& b) { a = (f32x4){bf_lo(w.x), bf_hi(w.x), bf_lo(w.y), bf_hi(w.y)}; b = (f32x4){bf_lo(w.z), bf_hi(w.z), bf_lo(w.w), bf_hi(w.w)}; }
__device__ __forceinline__ float sigm(float x) { return __builtin_amdgcn_rcpf(1.f + __builtin_amdgcn_exp2f(-1.4426950408889634f * x)); }
__device__ __forceinline__ float inv_freq(int d) { return exp2f(-(float)d * (13.287712379549449f / 32.f)); }
__device__ __forceinline__ void rope_cs(float pos, float invf, float& c, float& s) {
    const float ang = pos * invf; float rev = ang * 0.15915494309189535f; rev = __builtin_amdgcn_fractf(rev);
    s = __builtin_amdgcn_sinf(rev); c = __builtin_amdgcn_cosf(rev);
}

namespace pg8 {
#define NTST(ptr, val) (*(v4u*)(ptr) = (val))
struct EpiInProj {
    static constexpr bool PERM = true, AFTER_DRAIN = false, MID = false;
    const float* rs1; bf16_t *QO, *KB, *VB, *CB, *U, *SGA, *SGB;
    __device__ __forceinline__ void operator()(const f32x4 (&acc)[2][2][4][2], const Unit& u, int wr, int wc, int fr, int fq) const {
        int frp = fr; asm volatile("" : "+v"(frp)); const int pn = u.pn, row0 = u.pm * BM + wr * 64 + frp;
        const size_t kvshift = (size_t)64 * ((u.pm >> 3) + 1);
        if (pn < 8) {
            const bool isq = pn < 4; bf16_t* base = isq ? QO : KB; const float s0 = isq ? QSCALE : 1.f;
            const int colt = (pn & 3) * 256 + wc * 64 + 8 * fq;
            float invf[8];
#pragma unroll
            for (int k = 0; k < 8; ++k) invf[k] = inv_freq(8 * fq + k);
#pragma unroll
            for (int ai = 0; ai < 2; ++ai)
#pragma unroll
                for (int m = 0; m < 4; ++m) {
                    const int row = row0 + ai * HALF + m * 16; const float pos = (float)(16 + (row & (SEQ - 1))); const float sc = s0;
                    const size_t orow = isq ? (size_t)row : (size_t)row + kvshift;
                    f32x4 lo[2], hi[2], ylo[2], yhi[2];
                    lo[0] = acc[ai][0][m][0] * sc; lo[1] = acc[ai][0][m][1] * sc; hi[0] = acc[ai][1][m][0] * sc; hi[1] = acc[ai][1][m][1] * sc;
#pragma unroll
                    for (int n = 0; n < 2; ++n)
#pragma unroll
                        for (int k = 0; k < 4; ++k) { float c, s; rope_cs(pos, invf[4 * n + k], c, s); ylo[n][k] = lo[n][k] * c - hi[n][k] * s; yhi[n][k] = hi[n][k] * c + lo[n][k] * s; }
                    bf16_t* p = base + orow * DM + colt;
                    NTST(p, pack8(ylo[0], ylo[1])); NTST((p + 32), pack8(yhi[0], yhi[1]));
                }
        } else if (pn < 16) {
            const bool isv = pn < 12; bf16_t* base = isv ? VB : CB; const int colt = (pn & 3) * 256 + wc * 32 + 8 * fq;
#pragma unroll
            for (int ai = 0; ai < 2; ++ai)
#pragma unroll
                for (int m = 0; m < 4; ++m) {
                    const int row = row0 + ai * HALF + m * 16; const float sc = 1.f; const size_t orow = isv ? (size_t)row + kvshift : (size_t)row;
                    bf16_t* p = base + orow * DM + colt;
#pragma unroll
                    for (int bj = 0; bj < 2; ++bj) NTST((p + bj * HALF), pack8(acc[ai][bj][m][0] * sc, acc[ai][bj][m][1] * sc));
                }
        } else if (pn < 24) {
            const int colt = (pn - 16) * 128 + wc * 32 + 8 * fq;
#pragma unroll
            for (int ai = 0; ai < 2; ++ai)
#pragma unroll
                for (int m = 0; m < 4; ++m) {
                    const int row = row0 + ai * HALF + m * 16; const float sc2 = 1.f;
                    NTST((U + (size_t)row * DM + colt), pack8(acc[ai][0][m][0] * acc[ai][1][m][0] * sc2, acc[ai][0][m][1] * acc[ai][1][m][1] * sc2));
                }
        } else {
            const int colt = (pn - 24) * 128 + wc * 32 + 8 * fq;
#pragma unroll
            for (int ai = 0; ai < 2; ++ai)
#pragma unroll
                for (int m = 0; m < 4; ++m) {
                    const int row = row0 + ai * HALF + m * 16; f32x4 ra[2], sb[2];
#pragma unroll
                    for (int n = 0; n < 2; ++n)
#pragma unroll
                        for (int k = 0; k < 4; ++k) { const float ea = __builtin_amdgcn_exp2f(fminf(-1.4426950408889634f * acc[ai][0][m][n][k], 80.f)), eb = __builtin_amdgcn_exp2f(fminf(-1.4426950408889634f * acc[ai][1][m][n][k], 80.f));
                            ra[n][k] = __builtin_amdgcn_rcpf(1.f + ea) * (1.f + eb); sb[n][k] = __builtin_amdgcn_rcpf(1.f + eb); }
                    NTST((SGA + (size_t)row * DM + colt), pack8(ra[0], ra[1])); NTST((SGB + (size_t)row * DM + colt), pack8(sb[0], sb[1]));
                }
        }
    }
};
struct EpiMerge {
    static constexpr bool PERM = true, AFTER_DRAIN = false, MID = true;
    const bf16_t *SGA, *SGB; bf16_t* MG;
    __device__ __forceinline__ void mid(f32x4 (&acc)[2][2][4][2], const Unit& u, int wr, int wc, int fr, int fq) const {
        int frp = fr; asm volatile("" : "+v"(frp)); const int row0 = u.pm * BM + wr * 64 + frp, col0 = u.pn * BM + wc * 32 + 8 * fq;
#pragma unroll
        for (int ai = 0; ai < 2; ++ai)
#pragma unroll
            for (int m = 0; m < 4; ++m) { const size_t off = (size_t)(row0 + ai * HALF + m * 16) * DM + col0;
#pragma unroll
                for (int bj = 0; bj < 2; ++bj) { f32x4 a0, a1; unpack8(*(const v4u*)(SGA + off + bj * HALF), a0, a1);
                    acc[ai][bj][m][0] *= a0; acc[ai][bj][m][1] *= a1; }
                if (m == 3) asm volatile("" ::: "memory"); }
    }
    __device__ __forceinline__ void operator()(const f32x4 (&acc)[2][2][4][2], const Unit& u, int wr, int wc, int fr, int fq) const {
        int frp = fr; asm volatile("" : "+v"(frp)); const int row0 = u.pm * BM + wr * 64 + frp, col0 = u.pn * BM + wc * 32 + 8 * fq;
#pragma unroll
        for (int ai = 0; ai < 2; ++ai)
#pragma unroll
            for (int m = 0; m < 4; ++m) { const size_t off = (size_t)(row0 + ai * HALF + m * 16) * DM + col0;
#pragma unroll
                for (int bj = 0; bj < 2; ++bj) { f32x4 b0, b1; unpack8(*(const v4u*)(SGB + off + bj * HALF), b0, b1);
                    NTST((MG + off + bj * HALF), pack8(acc[ai][bj][m][0] * b0, acc[ai][bj][m][1] * b1)); } }
    }
};
template <bool IN_BF16> struct EpiResid {
    static constexpr bool PERM = true, AFTER_DRAIN = false, MID = false;
    const void* hin; bf16_t* hb; float* ss; const float* rsn;
    __device__ __forceinline__ void operator()(const f32x4 (&acc)[2][2][4][2], const Unit& u, int wr, int wc, int fr, int fq) const {
        int frp = fr; asm volatile("" : "+v"(frp)); const int row0 = u.pm * BM + wr * 64 + frp, col0 = u.pn * BM + wc * 32 + 8 * fq;
#pragma unroll
        for (int ai = 0; ai < 2; ++ai)
#pragma unroll
            for (int m = 0; m < 4; ++m) { const int row = row0 + ai * HALF + m * 16; const size_t off = (size_t)row * DM + col0; float s = 0.f; const float rinv = rsn ? __builtin_amdgcn_rcpf(rsn[row]) : 1.f;
#pragma unroll
                for (int bj = 0; bj < 2; ++bj) { f32x4 h0, h1;
                    if (IN_BF16) unpack8(*(const v4u*)((const bf16_t*)hin + off + bj * HALF), h0, h1);
                    else { h0 = *(const f32x4*)((const float*)hin + off + bj * HALF); h1 = *(const f32x4*)((const float*)hin + off + bj * HALF + 4); }
                    if (rsn) { h0 = h0 * rinv; h1 = h1 * rinv; }
                    h0 += acc[ai][bj][m][0]; h1 += acc[ai][bj][m][1];
                    NTST((hb + off + bj * HALF), pack8(h0, h1));
                    s += (h0[0] * h0[0] + h0[1] * h0[1]) + (h0[2] * h0[2] + h0[3] * h0[3]) + (h1[0] * h1[0] + h1[1] * h1[1]) + (h1[2] * h1[2] + h1[3] * h1[3]); }
                s += xor_swz<16>(s); s = xor32_sum(s);
                if (fq == 0) (void)__hip_atomic_fetch_add(ss + row, s, __ATOMIC_RELAXED, __HIP_MEMORY_SCOPE_AGENT); }
    }
};
struct EpiGateUp {
    static constexpr bool PERM = true, AFTER_DRAIN = false, MID = false;
    const float* ss2; bf16_t* ACT;
    __device__ __forceinline__ void operator()(const f32x4 (&acc)[2][2][4][2], const Unit& u, int wr, int wc, int fr, int fq) const {
        int frp = fr; asm volatile("" : "+v"(frp)); const int row0 = u.pm * BM + wr * 64 + frp, col0 = u.pn * HALF + wc * 32 + 8 * fq;
#pragma unroll
        for (int ai = 0; ai < 2; ++ai)
#pragma unroll
            for (int m = 0; m < 4; ++m) { const int row = row0 + ai * HALF + m * 16; const float r2 = __builtin_amdgcn_rsqf(ss2[row] * (1.f / DM) + NORM_EPS);
                f32x4 o[2];
#pragma unroll
                for (int n = 0; n < 2; ++n) { const f32x4 g = acc[ai][0][m][n] * r2, uu = acc[ai][1][m][n] * r2;
#pragma unroll
                    for (int k = 0; k < 4; ++k) o[n][k] = g[k] * sigm(g[k]) * uu[k]; }
                NTST((ACT + (size_t)row * DFF + col0), pack8(o[0], o[1])); }
    }
};
}

__device__ __forceinline__ void transpose_item(const float* W, int N, int k0, int n0src, const float* ksc, bf16* WT, int ldk, int drow0, int dk0, LAS float* scr, int lane) {
#pragma unroll
    for (int i = 0; i < 32; ++i) { const int kk = 2 * i + (lane >> 5); float v = W[(size_t)(k0 + kk) * N + n0src + (lane & 31)]; if (ksc) v *= ksc[k0 + kk]; scr[kk * 33 + (lane & 31)] = v; }
    asm volatile("s_waitcnt lgkmcnt(0)" ::: "memory");
    const int c = lane & 7;
#pragma unroll
    for (int j = 0; j < 4; ++j) { const int n = (lane >> 3) + 8 * j; const LAS float* s = scr + (8 * c) * 33 + n;
        v4u o; o.x = pg8::cvt_pk_bf16(s[0 * 33], s[1 * 33]); o.y = pg8::cvt_pk_bf16(s[2 * 33], s[3 * 33]); o.z = pg8::cvt_pk_bf16(s[4 * 33], s[5 * 33]); o.w = pg8::cvt_pk_bf16(s[6 * 33], s[7 * 33]);
        *(v4u*)(WT + (size_t)(drow0 + n) * ldk + dk0 + 8 * c) = o; }
    asm volatile("s_waitcnt lgkmcnt(0)" ::: "memory");
}
__device__ __forceinline__ int win_src_col(int rb) {
    const int pn = rb >> 3, sb = rb & 7, bj = sb >> 2, wc = sb & 3;
    if (pn < 8) return pn * 256 + 64 * wc + 32 * bj;
    if (pn < 16) return pn * 256 + sb * 32;
    if (pn < 24) return (bj ? 5120 : 4096) + 128 * (pn - 16) + 32 * wc;
    return (bj ? 7168 : 6144) + 128 * (pn - 24) + 32 * wc;
}

#ifndef REPMASK
#define REPMASK 0
#endif
#ifndef PHMASK
#define PHMASK 0xFF
#endif
struct Args { const float* in[17]; float* out; unsigned char* ws; };

__global__ void __launch_bounds__(512, 2) fwd_kernel(Args a) {
    extern __shared__ __attribute__((aligned(16))) unsigned char lds[];
    cg::grid_group grid = cg::this_grid();
    const int wave = __builtin_amdgcn_readfirstlane((int)threadIdx.x >> 6);
#define PIN_TID() int tid_ = threadIdx.x; asm volatile("" : "+v"(tid_)); const int tid = tid_, lane = tid & 63, gtid = bx * 512 + tid; (void)lane; (void)gtid
    const int G = gridDim.x, bx = blockIdx.x;
    const int vcu = (G % 8 == 0) ? (bx % 8) * (G / 8) + bx / 8 : bx;
    LAS unsigned char* L = (LAS unsigned char*)lds;
    unsigned char* ws = a.ws;
    const float* x = a.in[0]; const float* w_in = a.in[3];
#define Win_t ((bf16*)(ws + WS_WIN))
#define Wp_t ((bf16*)(ws + WS_WP))
#define Wout_t ((bf16*)(ws + WS_WOUT))
#define Wgu_t ((bf16*)(ws + WS_WGU))
#define Wdn_t ((bf16*)(ws + WS_WDN))
#define QO ((bf16*)(ws + WS_QO))
#define CB ((bf16*)(ws + WS_CB))
#define U ((bf16*)(ws + WS_U))
#define SGA ((bf16*)(ws + WS_SGA))
#define SGB ((bf16*)(ws + WS_SGB))
#define KB ((bf16*)(ws + WS_KB))
#define VB ((bf16*)(ws + WS_VB))
#define MG ((bf16*)(ws + WS_MG))
#define H2B ((bf16*)(ws + WS_H2B))
#define ACT ((bf16*)(ws + WS_ACT))
#define H3B ((bf16*)(ws + WS_SGA))
#define ss2 ((float*)(ws + WS_SS2))
#define ss3 ((float*)(ws + WS_SS3))
#define rs1 ((float*)(ws + WS_RS1))
#define PM ((float*)(ws + WS_PM))
    bf16* HB = (bf16*)a.out;
    { volatile LAS unsigned* st0 = (volatile LAS unsigned*)(L + LDS_BARST); if (threadIdx.x < 2) st0[threadIdx.x] = 0u; __syncthreads(); }
#define XSYNC() xcd_barrier(xbar)
#define GSYNC() do { asm volatile("s_waitcnt vmcnt(0)" ::: "memory"); __syncthreads(); grid.sync(); \
    if (threadIdx.x == 0) { __builtin_amdgcn_fence(__ATOMIC_ACQUIRE, "agent"); asm volatile("s_waitcnt vmcnt(0)" ::: "memory"); } __syncthreads(); } while (0)
    const int GT = G * 512;
    for (int i = bx * 512 + (int)threadIdx.x; i < XCD_BAR_WORDS; i += GT) ((unsigned*)(ws + WS_BAR))[i] = 0u;
    GSYNC();
    const XcdBarrier xbar = xcd_barrier_post((unsigned*)(ws + WS_BAR), (volatile LAS unsigned*)(L + LDS_BARST));

    for (int rep_ = 0; rep_ < 1 + ((REPMASK >> 0) & 1); ++rep_) if ((PHMASK >> 0) & 1) {
        PIN_TID();
        const int gw = vcu * 8 + wave, NGW = G * 8;
        for (int i = gtid; i < 2 * MTOK / 4; i += GT) ((f32x4*)ss2)[i] = (f32x4){0.f, 0.f, 0.f, 0.f};
        for (int i = gtid; i < 2 * NB * 6144; i += GT) { const int buf = i / (NB * 6144), r = i % (NB * 6144), b = r / 6144, o = r % 6144;
            ((v4u*)((buf ? VB : KB) + ((size_t)b * KROWS + 16) * DM))[o] = (v4u){0u, 0u, 0u, 0u}; }
        LAS float* scr = (LAS float*)(L + wave * 16384);
        constexpr int I_IN = 16 * 256, I_P = 16 * 32, I_GU = 16 * 176, I_DN = 44 * 32, NITEMS = I_IN + 3 * I_P + I_GU + I_DN;
        for (int it = gw; it < NITEMS; it += NGW) {
            int r = it;
            if (r < I_IN) { const int kb = r >> 8, rb = r & 255; transpose_item(w_in, INC, kb * 64, win_src_col(rb), a.in[2], Win_t, DM, rb * 32, kb * 64, scr, lane); continue; } r -= I_IN;
            if (r < I_P) { const int kb = r >> 5, rb = r & 31; transpose_item(a.in[10], DM, kb * 64, rb * 32, nullptr, Wp_t, 2 * DM, rb * 32, kb * 64, scr, lane); continue; } r -= I_P;
            if (r < I_P) { const int kb = r >> 5, rb = r & 31; transpose_item(a.in[11], DM, kb * 64, rb * 32, nullptr, Wp_t, 2 * DM, rb * 32, DM + kb * 64, scr, lane); continue; } r -= I_P;
            if (r < I_P) { const int kb = r >> 5, rb = r & 31; transpose_item(a.in[12], DM, kb * 64, rb * 32, nullptr, Wout_t, DM, rb * 32, kb * 64, scr, lane); continue; } r -= I_P;
            if (r < I_GU) { const int kb = r / 176, rb = r % 176, pn = rb >> 3, sb = rb & 7;
                transpose_item(a.in[14], 2 * DFF, kb * 64, ((sb >> 2) ? DFF : 0) + 128 * pn + 32 * (sb & 3), a.in[13], Wgu_t, DM, rb * 32, kb * 64, scr, lane); continue; } r -= I_GU;
            { const int kb = r >> 5, rb = r & 31; transpose_item(a.in[15], DM, kb * 64, rb * 32, nullptr, Wdn_t, DFF, rb * 32, kb * 64, scr, lane); }
        }
        for (int m0 = gw * 4; m0 < MTOK; m0 += NGW * 4) {
            f32x4 v[4][4]; float s[4];
#pragma unroll
            for (int r = 0; r < 4; ++r) { const f32x4* xr = (const f32x4*)(x + (size_t)(m0 + r) * DM) + lane;
#pragma unroll
                for (int j = 0; j < 4; ++j) v[r][j] = __builtin_nontemporal_load(&xr[64 * j]); }
#pragma unroll
            for (int r = 0; r < 4; ++r) { s[r] = 0.f;
#pragma unroll
                for (int j = 0; j < 4; ++j) s[r] += (v[r][j][0] * v[r][j][0] + v[r][j][1] * v[r][j][1]) + (v[r][j][2] * v[r][j][2] + v[r][j][3] * v[r][j][3]);
                s[r] = wave_sum(s[r]); }
            if (lane < 4) rs1[m0 + lane] = __builtin_amdgcn_rsqf((lane == 0 ? s[0] : lane == 1 ? s[1] : lane == 2 ? s[2] : s[3]) * (1.f / DM) + NORM_EPS);
#pragma unroll
            for (int r = 0; r < 4; ++r) { unsigned long long* o8 = (unsigned long long*)(HB + (size_t)(m0 + r) * DM) + lane; const float rsr = __builtin_amdgcn_rsqf(s[r] * (1.f / DM) + NORM_EPS);
#pragma unroll
                for (int j = 0; j < 4; ++j) { const f32x4 q = v[r][j] * rsr; o8[64 * j] = (unsigned long long)pg8::cvt_pk_bf16(q[0], q[1]) | ((unsigned long long)pg8::cvt_pk_bf16(q[2], q[3]) << 32); } }
        }
        for (int job = bx; job < 256; job += G) {
            LAS float* hm = (LAS float*)L; LAS float* red = (LAS float*)(L + 65536);
            __syncthreads();
#pragma unroll
            for (int rr = 0; rr < 2; ++rr) { const int r = wave * 2 + rr; const f32x4* mr = (const f32x4*)(a.in[1] + (size_t)r * DM) + lane; f32x4 v[4]; float s = 0.f;
#pragma unroll
                for (int j = 0; j < 4; ++j) { v[j] = mr[64 * j]; s += (v[j][0] * v[j][0] + v[j][1] * v[j][1]) + (v[j][2] * v[j][2] + v[j][3] * v[j][3]); }
                const float rs = __builtin_amdgcn_rsqf(wave_sum(s) * (1.f / DM) + NORM_EPS);
#pragma unroll
                for (int j = 0; j < 4; ++j) { const f32x4 wv = ((const f32x4*)a.in[2])[lane + 64 * j];
#pragma unroll
                    for (int k = 0; k < 4; ++k) hm[(4 * lane + 256 * j + k) * 16 + r] = v[j][k] * rs * wv[k]; } }
            __syncthreads();
            const int col = tid & 15, ksp = tid >> 4, pcol = job * 16 + col, src = pcol < 2048 ? 1024 + pcol : 4096 + (pcol - 2048);
            float acc[16];
#pragma unroll
            for (int r = 0; r < 16; ++r) acc[r] = 0.f;
#pragma unroll 8
            for (int dd = 0; dd < 32; ++dd) { const int d = ksp * 32 + dd; const float wv = w_in[(size_t)d * INC + src];
                const f32x4 h0 = *(const LAS f32x4*)(hm + d * 16), h1 = *(const LAS f32x4*)(hm + d * 16 + 4), h2 = *(const LAS f32x4*)(hm + d * 16 + 8), h3 = *(const LAS f32x4*)(hm + d * 16 + 12);
#pragma unroll
                for (int k = 0; k < 4; ++k) { acc[k] += h0[k] * wv; acc[4 + k] += h1[k] * wv; acc[8 + k] += h2[k] * wv; acc[12 + k] += h3[k] * wv; } }
#pragma unroll
            for (int r = 0; r < 16; ++r) red[(ksp * 16 + r) * 16 + col] = acc[r];
            __syncthreads();
            if (tid < 256) { const int r = tid >> 4, c = tid & 15; float s = 0.f;
#pragma unroll 8
                for (int k = 0; k < 32; ++k) s += red[(k * 16 + r) * 16 + c];
                PM[r * 4096 + job * 16 + c] = s; }
        }
        __syncthreads();
    }
    XSYNC();

    for (int rep_ = 0; rep_ < 1 + ((REPMASK >> 1) & 1); ++rep_) if ((PHMASK >> 1) & 1) {
        PIN_TID();
        for (int rm_ = 0; rm_ < 1 + ((REPMASK >> 8) & 1); ++rm_)
        for (int i = gtid; i < NB * 16 * 256; i += GT) { const int ch = i & 255, r = (i >> 8) & 15, b = i >> 12; const bool isv = ch >= 128; const int c = (ch & 127) * 8;
            f32x4 o0, o1;
            if (!isv) { const int d = c & 63, base = c - d, dl = d & 31; const float* plo = PM + r * 4096 + base + dl; const float* phi = plo + 32;
#pragma unroll
                for (int k = 0; k < 8; ++k) { float cs, sn; rope_cs((float)r, inv_freq(dl + k), cs, sn); const float xl = plo[k], xh = phi[k]; const float y = d < 32 ? xl * cs - xh * sn : xh * cs + xl * sn;
                    if (k < 4) o0[k] = y; else o1[k - 4] = y; }
            } else { o0 = *(const f32x4*)(PM + r * 4096 + 1024 + c); o1 = *(const f32x4*)(PM + r * 4096 + 1024 + c + 4); }
            *(v4u*)((isv ? VB : KB) + ((size_t)b * KROWS + r) * DM + c) = pack8(o0, o1); }
        pg8::Gemm g{HB, HB, Win_t, DM, DM, DM / 64}; pg8::StaticOrder S; S.init(MTOK, INC, G, bx);
        pg8::EpiInProj E{rs1, QO, KB, VB, CB, U, SGA, SGB};
        for (int rg_ = 0; rg_ < 1 + ((REPMASK >> 9) & 1); ++rg_)
        pg8::gemm_phase<pg8::EpiInProj, pg8::StaticOrder, true, true>(L, g, S, E);
    }
    XSYNC();

    for (int rep_ = 0; rep_ < 1 + ((REPMASK >> 2) & 1); ++rep_) if ((PHMASK >> 2) & 1) {
        PIN_TID();
        const float* cw = a.in[9]; bf16* OAp = (bf16*)a.out + (size_t)MTOK * DM; bf16* OBp = CB;
        float lam;
        { const float s1 = wave_sum(a.in[4][lane] * a.in[5][lane]), s2 = wave_sum(a.in[6][lane] * a.in[7][lane]); lam = __uint_as_float(__builtin_amdgcn_readfirstlane(__float_as_uint(expf(s1) - expf(s2) + LAMBDA_INIT))); }
        const float* subw = a.in[8];
        const int conv_grp = (bx >> 3) & 3, conv_before = conv_grp == 0 ? 0 : conv_grp == 1 ? 4 : conv_grp == 2 ? 6 : 7;
        for (int bh = vcu; bh < NB * 8; bh += G) { const int b = bh >> 3, hh = bh & 7;
            for (int qb = 0; qb < 8; ++qb) {
                if (bh == vcu && qb == conv_before) { int gt2 = gtid; asm volatile("" : "+v"(gt2));
                    for (int it = gt2; it < (MTOK / 16) * 128; it += GT) { const int ch = it & 127, rb = it >> 7, g0 = rb * 16, c = ch * 8;
                        const f32x4 w00 = *(const f32x4*)(cw + c), w01 = *(const f32x4*)(cw + c + 4), w10 = *(const f32x4*)(cw + DM + c), w11 = *(const f32x4*)(cw + DM + c + 4), w20 = *(const f32x4*)(cw + 2 * DM + c), w21 = *(const f32x4*)(cw + 2 * DM + c + 4);
                        f32x4 p0, p1, q0, q1;
                        if ((g0 & (SEQ - 1)) == 0) { const float* m14 = PM + 14 * 4096 + 2048 + c; const float* m15 = PM + 15 * 4096 + 2048 + c;
                            p0 = *(const f32x4*)m14 * *(const f32x4*)(m14 + 1024); p1 = *(const f32x4*)(m14 + 4) * *(const f32x4*)(m14 + 1028);
                            q0 = *(const f32x4*)m15 * *(const f32x4*)(m15 + 1024); q1 = *(const f32x4*)(m15 + 4) * *(const f32x4*)(m15 + 1028);
                        } else { unpack8(*(const v4u*)(U + (size_t)(g0 - 2) * DM + c), p0, p1); unpack8(*(const v4u*)(U + (size_t)(g0 - 1) * DM + c), q0, q1); }
#pragma unroll 4
                        for (int j = 0; j < 16; ++j) { const size_t off = (size_t)(g0 + j) * DM + c; f32x4 u0, u1, b0, b1; unpack8(*(const v4u*)(U + off), u0, u1); unpack8(*(const v4u*)(CB + off), b0, b1);
                            *(v4u*)(OBp + off) = pack8(b0 * (w00 * p0 + w10 * q0 + w20 * u0), b1 * (w01 * p1 + w11 * q1 + w21 * u1));
                            p0 = q0; p1 = q1; q0 = u0; q1 = u1; }
                    }
                }
                for (int m = 0; m < 2; ++m) {
                    const attn_body::bf16* Qw = (const attn_body::bf16*)QO + ((size_t)b * SEQ + qb * 256 + wave * 32) * DM + hh * 128 + m * 64;
                    const attn_body::bf16* Kh = (const attn_body::bf16*)KB + (size_t)b * KROWS * DM + hh * 128 + m * 64;
                    const attn_body::bf16* Vh = (const attn_body::bf16*)VB + (size_t)b * KROWS * DM + hh * 128;
                    const attn_body::bf16* Khn = (const attn_body::bf16*)KB + (size_t)b * KROWS * DM + hh * 128 + (1 - m) * 64;
                    attn_body::attn_pass<8>(Qw, Kh, Vh, 4 * qb + 5, m, lam, (char*)lds, Khn, !(qb == 7 && m == 1), !(qb == 0 && m == 0));
                }
                { int ln = lane; asm volatile("" : "+v"(ln)); const LAS unsigned char* Hw = L + attn_body::LDS_H + wave * 8192; const int row = ln >> 1, half = ln & 1; float s = 0.f;
#pragma unroll
                    for (int j = 0; j < 8; ++j) { const int chunk = half * 8 + j; f32x4 v0, v1; unpack8(*(const LAS v4u*)(Hw + row * 256 + ((chunk ^ (row & 15)) << 4)), v0, v1);
                        s += (v0[0] * v0[0] + v0[1] * v0[1]) + (v0[2] * v0[2] + v0[3] * v0[3]) + (v1[0] * v1[0] + v1[1] * v1[1]) + (v1[2] * v1[2] + v1[3] * v1[3]); }
                    s += __uint_as_float((unsigned)__builtin_amdgcn_mov_dpp((int)__float_as_uint(s), 0xB1, 0xF, 0xF, true));
                    const float rn = __builtin_amdgcn_rsqf(s * (1.f / 128.f) + NORM_EPS) * (1.f - LAMBDA_INIT);
                    bf16* Ow = OAp + ((size_t)b * SEQ + qb * 256 + wave * 32 + row) * DM + hh * 128 + half * 64;
#pragma unroll
                    for (int j = 0; j < 8; ++j) { const int chunk = half * 8 + j; f32x4 v0, v1; unpack8(*(const LAS v4u*)(Hw + row * 256 + ((chunk ^ (row & 15)) << 4)), v0, v1);
                        const f32x4 w0 = *(const f32x4*)(subw + chunk * 8), w1 = *(const f32x4*)(subw + chunk * 8 + 4);
                        *(v4u*)(Ow + j * 8) = pack8(v0 * w0 * rn, v1 * w1 * rn); }
                    asm volatile("s_waitcnt lgkmcnt(0)" ::: "memory");
                }
            }
        }
        asm volatile("s_waitcnt vmcnt(0)" ::: "memory"); __syncthreads();
    }
    XSYNC();

    for (int rep_ = 0; rep_ < 1 + ((REPMASK >> 3) & 1); ++rep_) if ((PHMASK >> 3) & 1) {
        pg8::Gemm g{(bf16*)a.out + (size_t)MTOK * DM, CB, Wp_t, DM, 2 * DM, DM / 64}; pg8::StaticOrder S; S.init(MTOK, DM, G, bx);
        pg8::EpiMerge E{SGA, SGB, MG};
        pg8::gemm_phase<pg8::EpiMerge, pg8::StaticOrder, true, true>(L, g, S, E);
    }
    XSYNC();
    for (int rep_ = 0; rep_ < 1 + ((REPMASK >> 4) & 1); ++rep_) if ((PHMASK >> 4) & 1) {
        pg8::Gemm g{MG, MG, Wout_t, DM, DM, DM / 64}; pg8::StaticOrder S; S.init(MTOK, DM, G, bx);
        pg8::EpiResid<true> E{HB, H2B, ss2, rs1};
        pg8::gemm_phase<pg8::EpiResid<true>, pg8::StaticOrder, true, true>(L, g, S, E);
    }
    XSYNC();
    for (int rep_ = 0; rep_ < 1 + ((REPMASK >> 5) & 1); ++rep_) if ((PHMASK >> 5) & 1) {
        pg8::Gemm g{H2B, H2B, Wgu_t, DM, DM, DM / 64}; pg8::StaticOrder S; S.init(MTOK, 2 * DFF, G, bx);
        pg8::EpiGateUp E{ss2, ACT};
        pg8::gemm_phase<pg8::EpiGateUp, pg8::StaticOrder, true, true>(L, g, S, E);
    }
    XSYNC();
    for (int rep_ = 0; rep_ < 1 + ((REPMASK >> 6) & 1); ++rep_) if ((PHMASK >> 6) & 1) {
        pg8::Gemm g{ACT, ACT, Wdn_t, DFF, DFF, DFF / 64}; pg8::StaticOrder S; S.init(MTOK, DM, G, bx);
        pg8::EpiResid<true> E{H2B, H3B, ss3, nullptr};
        pg8::gemm_phase<pg8::EpiResid<true>, pg8::StaticOrder, true, true>(L, g, S, E);
    }
    XSYNC();
    for (int rep_ = 0; rep_ < 1 + ((REPMASK >> 7) & 1); ++rep_) if ((PHMASK >> 7) & 1) {
        PIN_TID();
        const int gw = vcu * 8 + wave, NGW = G * 8; const float* wf = a.in[16];
        f32x4 wv[4];
#pragma unroll
        for (int j = 0; j < 4; ++j) wv[j] = ((const f32x4*)wf)[lane + 64 * j];
        for (int m0 = gw * 4; m0 < MTOK; m0 += NGW * 4) {
            unsigned long long w[4][4]; float r3[4];
#pragma unroll
            for (int r = 0; r < 4; ++r) { const unsigned long long* i8 = (const unsigned long long*)(H3B + (size_t)(m0 + r) * DM) + lane; r3[r] = ss3[m0 + r];
#pragma unroll
                for (int j = 0; j < 4; ++j) w[r][j] = __builtin_nontemporal_load(&i8[64 * j]); }
#pragma unroll
            for (int r = 0; r < 4; ++r) { f32x4* orow = (f32x4*)(a.out + (size_t)(m0 + r) * DM) + lane; const float rr = __builtin_amdgcn_rsqf(r3[r] * (1.f / DM) + NORM_EPS);
#pragma unroll
                for (int j = 0; j < 4; ++j) { const unsigned lo = (unsigned)w[r][j], hi = (unsigned)(w[r][j] >> 32);
                    __builtin_nontemporal_store((f32x4){bf_lo(lo), bf_hi(lo), bf_lo(hi), bf_hi(hi)} * wv[j] * rr, &orow[64 * j]); } }
        }
    }
#undef GSYNC
#undef XSYNC
}
#undef Win_t
#undef Wp_t
#undef Wout_t
#undef Wgu_t
#undef Wdn_t
#undef QO
#undef CB
#undef U
#undef SGA
#undef SGB
#undef KB
#undef VB
#undef MG
#undef H2B
#undef ACT
#undef H3B
#undef ss2
#undef ss3
#undef rs1
#undef PM

extern "C" void kernel_launch(void* const* d_in, const int* in_sizes, int n_in, void* d_out, int out_size, void* d_ws, size_t ws_size, hipStream_t stream) {
    static int grid = 0;
    if (grid == 0) {
        if (n_in != 17 || in_sizes[0] != MTOK * DM || out_size != MTOK * DM || ws_size < WS_END) { fprintf(stderr, "kernel_launch: unexpected shapes / workspace (n_in %d, ws %zu)\n", n_in, ws_size); grid = -1; return; }
        int dev = 0, cus = 0, per_cu = 0;
        if (hipGetDevice(&dev) != hipSuccess || hipDeviceGetAttribute(&cus, hipDeviceAttributeMultiprocessorCount, dev) != hipSuccess) { grid = -1; return; }
        if (hipFuncSetAttribute((const void*)fwd_kernel, hipFuncAttributeMaxDynamicSharedMemorySize, LDS_BYTES) != hipSuccess) { fprintf(stderr, "kernel_launch: hipFuncSetAttribute failed\n"); grid = -1; return; }
        if (hipOccupancyMaxActiveBlocksPerMultiprocessor(&per_cu, (const void*)fwd_kernel, 512, LDS_BYTES) != hipSuccess || per_cu < 1) per_cu = 1;
        (void)hipGetLastError();
        grid = cus * per_cu;
    }
    if (grid < 0) return;
    Args a{};
    for (int i = 0; i < 17; ++i) a.in[i] = (const float*)d_in[i];
    a.out = (float*)d_out; a.ws = (unsigned char*)d_ws;
    void* args[] = {&a};
    hipError_t e = hipLaunchCooperativeKernel((const void*)fwd_kernel, dim3(grid), dim3(512), args, LDS_BYTES, stream);
    if (e != hipSuccess) fprintf(stderr, "kernel_launch: cooperative launch failed: %s (grid %d)\n", hipGetErrorString(e), grid);
}
```

```cpp
#include <hip/hip_runtime.h>
#include <hip/hip_cooperative_groups.h>
#include <hip/hip_bf16.h>
#include <cstdio>
#include <cstdint>
#include <cmath>
namespace pg8 {
#define PG8_LAS __attribute__((address_space(3)))
typedef unsigned short bf16_t;
typedef short bf16x8 __attribute__((ext_vector_type(8)));
typedef float f32x4 __attribute__((ext_vector_type(4)));
typedef unsigned u32x4 __attribute__((ext_vector_type(4)));
constexpr int BM = 256, BK = 64, HALF = 128, HTB = HALF * BK * 2  , STAGE_BYTES = 8 * HTB, NXCD = 8, WGM = 8;

__host__ __device__ __forceinline__ int lds_byte(int r, int c) { const int st = (r >> 4) * 2 + (c >> 5), rr = r & 15, cc = c & 31, ob = rr * 64 + cc * 2; return st * 1024 + (ob ^ (((ob >> 9) & 1) << 5)); }
__host__ __device__ __forceinline__ void stage_rc(int b, int& R, int& C) { const int st = b / 1024, sb = b % 1024, swz = sb ^ (((sb >> 9) & 1) << 5); R = (st >> 1) * 16 + swz / 64; C = (st & 1) * 32 + (swz % 64) / 2; }
__host__ __device__ __forceinline__ int perm32(int rho) { const int n = rho >> 4, i = rho & 15; return 8 * (i >> 2) + 4 * n + (i & 3); }

struct Unit { int pm, pn; };
struct Gemm { const bf16_t* A; const bf16_t* A2; const bf16_t* Bt; int lda, K, ks; };

struct StaticOrder {
    int nM, nN, nwg, G, c;
    __host__ __device__ void init(int M, int N, int G_, int c_) { nM = M / BM; nN = N / BM; nwg = nM * nN; G = G_; c = c_; }
    __host__ __device__ bool next(int i, Unit& u) const {
        const long L = (long)i * G + c; if (L >= nwg) return false;
        int wgid = (int)L; { const int q = nwg / NXCD, r = nwg % NXCD, xcd = wgid % NXCD, off = wgid / NXCD; wgid = (xcd < r ? xcd * (q + 1) : r * (q + 1) + (xcd - r) * q) + off; }
        const int nig = WGM * nN, gid = wgid / nig, fm = gid * WGM, gsz = (nM - fm) < WGM ? (nM - fm) : WGM;
        u.pm = fm + ((wgid % nig) % gsz); u.pn = (wgid % nig) / gsz; return true;
    }
    __device__ __forceinline__ void a_ready(const Unit&) const {}
    __device__ __forceinline__ void done(const Unit&) const {}
};

typedef float cvt_f32x2_t __attribute__((ext_vector_type(2))); typedef __bf16 cvt_bf16x2_t __attribute__((ext_vector_type(2)));
__device__ __forceinline__ unsigned cvt_pk_bf16(float lo, float hi) { const cvt_f32x2_t v = {lo, hi}; const cvt_bf16x2_t b = __builtin_convertvector(v, cvt_bf16x2_t); return __builtin_bit_cast(unsigned, b); }
template <class Epi, class Sched, bool ALIGN_EPI = false, bool SP2 = false>
__device__ __forceinline__ void gemm_phase(PG8_LAS unsigned char* lds, const Gemm g, const Sched& S, const Epi& E) {
    int tid_ = threadIdx.x; asm volatile("" : "+v"(tid_));
    const int tid = tid_, wid = __builtin_amdgcn_readfirstlane(tid >> 6), lane = tid & 63, wr = wid >> 2, wc = wid & 3, fr = lane & 15, fq = lane >> 4;
    const int K = g.K, nt = K / BK, ks = g.ks, lda = g.lda;
    unsigned voffA[2], voffB[2];
#pragma unroll
    for (int i = 0; i < 2; ++i) { int R, C; stage_rc(tid * 16 + i * 8192, R, C); const int Rb = Epi::PERM ? ((R & ~31) + perm32(R & 31)) : R;
        voffA[i] = (unsigned)(R * lda + C) * 2u; voffB[i] = (unsigned)(Rb * K + C) * 2u; }
    const size_t kstep = (size_t)(BK * 2);
    const size_t hstepA = (size_t)HALF * lda * 2, hstepB = (size_t)HALF * K * 2;
    const size_t tstepA = 2 * hstepA, tstepB = 2 * hstepB;
    const unsigned ldsw = (unsigned)wid * 1024u;
    const int aoff = lds_byte(wr * 64 + fr, fq * 8), boff = lds_byte(wc * 32 + fr, fq * 8);
#define PG8_SA(b, h) (((b) * 2 + (h)) * HTB)
#define PG8_SB(b, h) ((4 + (b) * 2 + (h)) * HTB)
#define PG8_STAGE(bufoff, gbase, voff) do { _Pragma("unroll") for (int _i = 0; _i < 2; ++_i) \
        __builtin_amdgcn_global_load_lds((const unsigned*)((const char*)(gbase) + (voff)[_i]), (PG8_LAS unsigned*)(lds + (bufoff) + ldsw + _i * 8192), 16, 0, 0); } while (0)
#define PG8_LDA(dst, b, h) do { _Pragma("unroll") for (int m = 0; m < 4; ++m) _Pragma("unroll") for (int k = 0; k < 2; ++k) dst[m][k] = *(const PG8_LAS bf16x8*)(lds + PG8_SA(b, h) + aoff + m * 2048 + k * 1024); } while (0)
#define PG8_LDB(dst, b, h) do { _Pragma("unroll") for (int n = 0; n < 2; ++n) _Pragma("unroll") for (int k = 0; k < 2; ++k) dst[n][k] = *(const PG8_LAS bf16x8*)(lds + PG8_SB(b, h) + boff + n * 2048 + k * 1024); } while (0)
#define PG8_MMA(ai, bj, At, Bt) do { __builtin_amdgcn_s_setprio(1); _Pragma("unroll") for (int m = 0; m < 4; ++m) _Pragma("unroll") for (int n = 0; n < 2; ++n) _Pragma("unroll") for (int k = 0; k < 2; ++k) \
        acc[ai][bj][m][n] = __builtin_amdgcn_mfma_f32_16x16x32_bf16(Bt[n][k], At[m][k], acc[ai][bj][m][n], 0, 0, 0); __builtin_amdgcn_s_setprio(0); } while (0)
#define PG8_WAIT_V(n) asm volatile("s_waitcnt vmcnt(" #n ")" ::: "memory")
#define PG8_WAIT_L(n) asm volatile("s_waitcnt lgkmcnt(" #n ")" ::: "memory")
#define PG8_BAR __builtin_amdgcn_s_barrier()
#define PG8_SCHED __builtin_amdgcn_sched_barrier(0)
    Unit cur, nxt; int ui = 0;
    if (!S.next(0, cur)) return;
    f32x4 acc[2][2][4][2];
#pragma unroll
    for (int a = 0; a < 2; ++a)
#pragma unroll
        for (int b = 0; b < 2; ++b)
#pragma unroll
            for (int m = 0; m < 4; ++m)
#pragma unroll
                for (int n = 0; n < 2; ++n) acc[a][b][m][n] = (f32x4){0.f, 0.f, 0.f, 0.f};
    bf16x8 At[4][2], B0[2][2], B1[2][2];
    const char* cA = (const char*)g.A + (size_t)cur.pm * tstepA; const char* cA2 = (const char*)g.A2 + (size_t)cur.pm * tstepA; const char* cB = (const char*)g.Bt + (size_t)cur.pn * tstepB;
    S.a_ready(cur);
    if constexpr (SP2) {
        PG8_STAGE(PG8_SB(0, 0), cB, voffB); PG8_STAGE(PG8_SB(0, 1), cB + hstepB, voffB); PG8_STAGE(PG8_SA(0, 0), cA, voffA); PG8_STAGE(PG8_SA(0, 1), cA + hstepA, voffA);
        if (wr == 1) PG8_BAR;
        PG8_WAIT_V(2); PG8_BAR;
        PG8_STAGE(PG8_SB(1, 0), cB + kstep, voffB); PG8_STAGE(PG8_SA(1, 0), cA + kstep, voffA); PG8_STAGE(PG8_SB(1, 1), cB + hstepB + kstep, voffB);
        PG8_WAIT_V(6); PG8_BAR;
    } else {
        PG8_STAGE(PG8_SB(0, 0), cB, voffB); PG8_STAGE(PG8_SA(0, 0), cA, voffA); PG8_STAGE(PG8_SB(0, 1), cB + hstepB, voffB); PG8_STAGE(PG8_SA(0, 1), cA + hstepA, voffA);
        if (wr == 1) PG8_BAR;
        PG8_WAIT_V(4); PG8_BAR;
        PG8_STAGE(PG8_SB(1, 0), cB + kstep, voffB); PG8_STAGE(PG8_SA(1, 0), cA + kstep, voffA); PG8_STAGE(PG8_SB(1, 1), cB + hstepB + kstep, voffB);
        PG8_WAIT_V(6); PG8_BAR;
    }
    for (;;) {
        const bool has_next = S.next(ui + 1, nxt);
        const char* nA = has_next ? (const char*)g.A + (size_t)nxt.pm * tstepA : cA; const char* nA2 = has_next ? (const char*)g.A2 + (size_t)nxt.pm * tstepA : cA2; const char* nB = has_next ? (const char*)g.Bt + (size_t)nxt.pn * tstepB : cB;
        for (int t = 0; t < nt; t += 2) {
            const bool last = (t == nt - 2);
#define PG8_ATILE(tt) ((tt) < ks ? cA + (size_t)(tt) * kstep : cA2 + (size_t)((tt) - ks) * kstep)
            if constexpr (Epi::MID) { if (t == ks) E.mid(acc, cur, wr, wc, fr, fq); }
            const char* a1 = PG8_ATILE(t + 1);
            const char* a2 = last ? nA : PG8_ATILE(t + 2); const char* b2 = last ? nB : cB + (size_t)(t + 2) * kstep;
            const char* a3 = last ? nA + kstep : PG8_ATILE(t + 3); const char* b3 = b2 + kstep;
            if (last && has_next) S.a_ready(nxt);
            if constexpr (SP2) {
            PG8_LDB(B0, 0, 0); PG8_LDB(B1, 0, 1); PG8_SCHED; PG8_LDA(At, 0, 0); PG8_STAGE(PG8_SA(1, 1), a1 + hstepA, voffA);
            PG8_WAIT_V(8); PG8_WAIT_L(0); PG8_BAR; PG8_MMA(0, 0, At, B0); PG8_MMA(0, 1, At, B1); PG8_BAR; PG8_SCHED;
            PG8_LDA(At, 0, 1); PG8_STAGE(PG8_SB(0, 0), b2, voffB); PG8_STAGE(PG8_SB(0, 1), b2 + hstepB, voffB); PG8_STAGE(PG8_SA(0, 0), a2, voffA);
            PG8_WAIT_V(8); PG8_WAIT_L(0); PG8_BAR; PG8_MMA(1, 0, At, B0); PG8_MMA(1, 1, At, B1); PG8_BAR; PG8_SCHED;
            PG8_LDB(B0, 1, 0); PG8_LDB(B1, 1, 1); PG8_SCHED; PG8_LDA(At, 1, 0); PG8_STAGE(PG8_SA(0, 1), a2 + hstepA, voffA);
            PG8_WAIT_V(8); PG8_WAIT_L(0); PG8_BAR; PG8_MMA(0, 0, At, B0); PG8_MMA(0, 1, At, B1); PG8_BAR; PG8_SCHED;
            PG8_LDA(At, 1, 1); PG8_STAGE(PG8_SB(1, 0), b3, voffB); PG8_STAGE(PG8_SB(1, 1), b3 + hstepB, voffB); PG8_STAGE(PG8_SA(1, 0), a3, voffA);
            PG8_WAIT_V(8); PG8_WAIT_L(0); PG8_BAR; PG8_MMA(1, 0, At, B0); PG8_MMA(1, 1, At, B1); PG8_BAR; PG8_SCHED;
            } else {
            PG8_LDB(B0, 0, 0); PG8_SCHED; PG8_LDA(At, 0, 0); PG8_STAGE(PG8_SA(1, 1), a1 + hstepA, voffA);
            PG8_WAIT_L(8); PG8_BAR; PG8_WAIT_L(0); PG8_MMA(0, 0, At, B0); PG8_BAR; PG8_SCHED;
            PG8_LDB(B1, 0, 1); PG8_STAGE(PG8_SB(0, 0), b2, voffB);
            PG8_BAR; PG8_WAIT_L(0); PG8_MMA(0, 1, At, B1); PG8_BAR;
            PG8_LDA(At, 0, 1); PG8_STAGE(PG8_SA(0, 0), a2, voffA);
            PG8_BAR; PG8_WAIT_L(0); PG8_MMA(1, 0, At, B0); PG8_BAR; PG8_SCHED;
            PG8_STAGE(PG8_SB(0, 1), b2 + hstepB, voffB);
            PG8_WAIT_V(6); PG8_BAR; PG8_MMA(1, 1, At, B1); PG8_BAR;
            PG8_LDB(B0, 1, 0); PG8_SCHED; PG8_LDA(At, 1, 0); PG8_STAGE(PG8_SA(0, 1), a2 + hstepA, voffA);
            PG8_WAIT_L(8); PG8_BAR; PG8_WAIT_L(0); PG8_MMA(0, 0, At, B0); PG8_BAR; PG8_SCHED;
            PG8_LDB(B1, 1, 1); PG8_STAGE(PG8_SB(1, 0), b3, voffB);
            PG8_BAR; PG8_WAIT_L(0); PG8_MMA(0, 1, At, B1); PG8_BAR;
            PG8_LDA(At, 1, 1); PG8_STAGE(PG8_SA(1, 0), a3, voffA);
            PG8_BAR; PG8_WAIT_L(0); PG8_MMA(1, 0, At, B0); PG8_BAR; PG8_SCHED;
            PG8_STAGE(PG8_SB(1, 1), b3 + hstepB, voffB);
            PG8_WAIT_V(6); PG8_BAR; PG8_MMA(1, 1, At, B1); PG8_BAR;
            }
        }
        if constexpr (ALIGN_EPI) { if (wr == 0) PG8_BAR; }
        if constexpr (!Epi::AFTER_DRAIN) { E(acc, cur, wr, wc, fr, fq); S.done(cur); }
        if (!has_next) break;
#pragma unroll
        for (int a = 0; a < 2; ++a)
#pragma unroll
            for (int b = 0; b < 2; ++b)
#pragma unroll
                for (int m = 0; m < 4; ++m)
#pragma unroll
                    for (int n = 0; n < 2; ++n) acc[a][b][m][n] = (f32x4){0.f, 0.f, 0.f, 0.f};
        cur = nxt; cA = nA; cA2 = nA2; cB = nB; ++ui;
        if constexpr (ALIGN_EPI) { if (wr == 1) PG8_BAR; }
    }
    PG8_WAIT_V(0);
    if constexpr (!ALIGN_EPI) { if (wr == 0) PG8_BAR; }
    PG8_BAR;
    if constexpr (Epi::AFTER_DRAIN) { E.fused(acc, cur, wr, wc, fr, fq, lds, wid, lane); S.done(cur); }
#undef PG8_SA
#undef PG8_ATILE
#undef PG8_SB
#undef PG8_STAGE
#undef PG8_LDA
#undef PG8_LDB
#undef PG8_MMA
#undef PG8_WAIT_V
#undef PG8_WAIT_L
#undef PG8_BAR
#undef PG8_SCHED
}
}

namespace attn_body {
using bf16=__hip_bfloat16;
using bf16x8=__attribute__((ext_vector_type(8)))short;
using s16x4=__attribute__((ext_vector_type(4)))short;
using f32x16=__attribute__((ext_vector_type(16)))float;
using u32x4=__attribute__((ext_vector_type(4)))unsigned;
constexpr int D=64,DM=1024;
constexpr int NW=8,QBLK=32,QB=QBLK*NW,KVBLK=64;
constexpr int ATTN_PITCH=DM, ATTN_UNIT_ROWS=QB;
__device__ __forceinline__ int crow(int r,int hi){return (r&3)+8*(r>>2)+4*hi;}
#define SBAR() __builtin_amdgcn_sched_barrier(0)
__device__ __forceinline__ void cmask(f32x16&p0,f32x16&p1,int jb,int qrel,int hi){
  const float NEG=-INFINITY; int kb=64*jb+4*hi;
  #pragma unroll
  for(int r=0;r<16;++r){int kv=kb+(r&3)+8*(r>>2); if(kv>qrel)p0[r]=NEG; if(kv+32>qrel)p1[r]=NEG;}
}

constexpr int NSLOT=3, SLOTB=8192;
constexpr int LDS_K=0, LDS_V=NSLOT*SLOTB, LDS_WS=LDS_V+2*NSLOT*SLOTB, LDS_H=LDS_WS+NW*64*4, LDS_BYTES=LDS_H+NW*8192;
constexpr float C2=0.125f*1.4426950408889634f;
__device__ __forceinline__ void glds16(const void*gsrc,unsigned lds_dst){unsigned keep;
  asm volatile("s_mov_b32 %0, m0\n\ts_mov_b32 m0, %2\n\ts_nop 0\n\tglobal_load_lds_dwordx4 %1, off\n\ts_mov_b32 m0, %0":"=&s"(keep):"v"(gsrc),"s"(lds_dst):"memory");}
__device__ __forceinline__ void glds16s(const void*sbase,unsigned voff,unsigned lds_dst){unsigned keep;
  asm volatile("s_nop 4\n\ts_mov_b32 %0, m0\n\ts_mov_b32 m0, %2\n\ts_nop 0\n\tglobal_load_lds_dwordx4 %1, %3\n\ts_mov_b32 m0, %0":"=&s"(keep):"v"(voff),"s"(lds_dst),"s"(sbase):"memory");}
__device__ __forceinline__ float max3f(float a,float b,float c){float r;asm("v_max3_f32 %0, %1, %2, %3":"=v"(r):"v"(a),"v"(b),"v"(c));return r;}
__device__ __forceinline__ float max2f(float a,float b){float r;asm("v_max_f32_e32 %0, %1, %2":"=v"(r):"v"(a),"v"(b));return r;}
__device__ __forceinline__ float fadd_s(float a,float b){float r;asm("v_add_f32_e32 %0, %1, %2":"=v"(r):"v"(a),"v"(b));return r;}
__device__ __forceinline__ float fsub_s(float a,float b){float r;asm("v_sub_f32_e32 %0, %1, %2":"=v"(r):"v"(a),"v"(b));return r;}
typedef float f32x2_t __attribute__((ext_vector_type(2))); typedef __bf16 bf16x2_t __attribute__((ext_vector_type(2)));
__device__ __forceinline__ unsigned cvtpk_s(float lo,float hi){f32x2_t v={lo,hi};bf16x2_t b=__builtin_convertvector(v,bf16x2_t);return __builtin_bit_cast(unsigned,b);}
#define WAIT_BAR(N) asm volatile("s_waitcnt vmcnt(" #N ") lgkmcnt(0)\n\ts_barrier":::"memory")

__device__ __forceinline__ void qkt(f32x16&p0,f32x16&p1,const char*Kslot,const bf16x8*qr,int r32,int hi){ const f32x16 zc=f32x16{};
  const char*kb=Kslot+hi*1024+r32*16;
  #pragma unroll
  for(int d0=0;d0<4;++d0){
    const bf16x8 b0=*reinterpret_cast<const bf16x8*>(kb+d0*2048);
    const bf16x8 b1=*reinterpret_cast<const bf16x8*>(kb+d0*2048+512);
    if(d0==0){p0=__builtin_amdgcn_mfma_f32_32x32x16_bf16(b0,qr[0],zc,0,0,0);p1=__builtin_amdgcn_mfma_f32_32x32x16_bf16(b1,qr[0],zc,0,0,0);}
    else{p0=__builtin_amdgcn_mfma_f32_32x32x16_bf16(b0,qr[d0],p0,0,0,0);p1=__builtin_amdgcn_mfma_f32_32x32x16_bf16(b1,qr[d0],p1,0,0,0);}}
}
typedef __attribute__((address_space(3))) const char* lds_cptr;
typedef short v4i16_t __attribute__((ext_vector_type(4)));
__device__ __forceinline__ void kload8(bf16x8*kf,lds_cptr kp){
  kf[0]=*(const __attribute__((address_space(3))) bf16x8*)(kp);      kf[1]=*(const __attribute__((address_space(3))) bf16x8*)(kp+512);
  kf[2]=*(const __attribute__((address_space(3))) bf16x8*)(kp+2048); kf[3]=*(const __attribute__((address_space(3))) bf16x8*)(kp+2560);
  kf[4]=*(const __attribute__((address_space(3))) bf16x8*)(kp+4096); kf[5]=*(const __attribute__((address_space(3))) bf16x8*)(kp+4608);
  kf[6]=*(const __attribute__((address_space(3))) bf16x8*)(kp+6144); kf[7]=*(const __attribute__((address_space(3))) bf16x8*)(kp+6656);
}
__device__ __forceinline__ void kload2(bf16x8*kf,lds_cptr kp,int j){ kf[2*j]=*(const __attribute__((address_space(3))) bf16x8*)(kp+j*2048); kf[2*j+1]=*(const __attribute__((address_space(3))) bf16x8*)(kp+j*2048+512); }
__device__ __forceinline__ s16x4 vtr(lds_cptr p){ return __builtin_bit_cast(s16x4,__builtin_amdgcn_ds_read_tr16_b64_v4i16((__attribute__((address_space(3))) v4i16_t*)p)); }
__device__ __forceinline__ float rowmax(const f32x16&p0,const f32x16&p1){
  float a=max3f(p0[0],p0[1],p1[0]),b=max3f(p0[2],p0[3],p1[1]);a=max3f(a,p1[2],p1[3]);
  #pragma unroll
  for(int r=4;r<16;r+=4){a=max3f(a,p0[r],p0[r+1]);b=max3f(b,p0[r+2],p0[r+3]);a=max3f(a,p1[r],p1[r+1]);b=max3f(b,p1[r+2],p1[r+3]);}
  const float m=max2f(a,b);
  auto rr=__builtin_amdgcn_permlane32_swap(__float_as_uint(m),__float_as_uint(m),false,false);
  return max2f(__uint_as_float(rr[0]),__uint_as_float(rr[1]));
}
__device__ __forceinline__ void pv(f32x16*o,int vb,bf16x8 pa0,bf16x8 pa1,bf16x8 pa2,bf16x8 pa3){
  #pragma unroll
  for(int d0=0;d0<2;++d0){s16x4 lo[4],hi[4];
    #pragma unroll
    for(int ks=0;ks<4;++ks){
      asm volatile("ds_read_b64_tr_b16 %0,%1 offset:%c2":"=&v"(lo[ks]):"v"(vb),"i"(d0*4096+ks*1024):"memory");
      asm volatile("ds_read_b64_tr_b16 %0,%1 offset:%c2":"=&v"(hi[ks]):"v"(vb),"i"(d0*4096+ks*1024+512):"memory");}
    asm volatile("s_waitcnt lgkmcnt(0)":::"memory");SBAR();
    #define PK(k) (bf16x8){lo[k][0],lo[k][1],lo[k][2],lo[k][3],hi[k][0],hi[k][1],hi[k][2],hi[k][3]}
    o[d0]=__builtin_amdgcn_mfma_f32_32x32x16_bf16(pa0,PK(0),o[d0],0,0,0);
    o[d0]=__builtin_amdgcn_mfma_f32_32x32x16_bf16(pa1,PK(1),o[d0],0,0,0);
    o[d0]=__builtin_amdgcn_mfma_f32_32x32x16_bf16(pa2,PK(2),o[d0],0,0,0);
    o[d0]=__builtin_amdgcn_mfma_f32_32x32x16_bf16(pa3,PK(3),o[d0],0,0,0);
    #undef PK
  }
}

#ifndef ATTN_STORE16
#define ATTN_STORE16(p,v) (*(u32x4*)(p)=(v))
#endif
template<int THRL> __device__ __forceinline__ void attn_pass(const bf16*Qw,const bf16*__restrict__ Kh,const bf16*__restrict__ Vh,int NT,int m_sub,float lam,char*shm,const bf16*Kh_next,bool has_next,bool prefetched){
  const int tid=threadIdx.x; int lane_=tid&63; asm volatile("":"+v"(lane_));
  const int lane=lane_,r32=lane&31,hi=lane>>5; const int wid=__builtin_amdgcn_readfirstlane(tid>>6);
  if(wid>=4)__builtin_amdgcn_s_setprio(1);
  const unsigned lds0=(unsigned)(uintptr_t)shm;
  float*wsf=(float*)(shm+LDS_WS)+wid*64;
  const bf16*ksrc=Kh+wid*8; const unsigned koff=(unsigned)lane*(DM*2);
  const bf16*vsrc=Vh+(long)(16*(wid&3))*DM+(wid>>2)*32; const unsigned voff=(unsigned)(lane>>2)*(DM*2)+(unsigned)(lane&3)*16;
  const unsigned kdst=lds0+LDS_K+wid*1024, vdst=lds0+LDS_V+wid*1024;
  #define DMA_K(t,slot) glds16s(ksrc+(long)(t)*KVBLK*DM,koff,(unsigned)__builtin_amdgcn_readfirstlane(kdst+(slot)))
  #define DMA_V(t,slot) do{ glds16s(vsrc+(long)(t)*KVBLK*DM,voff,(unsigned)__builtin_amdgcn_readfirstlane(vdst+2*(slot))); glds16s(vsrc+(long)(t)*KVBLK*DM+64,voff,(unsigned)__builtin_amdgcn_readfirstlane(vdst+2*(slot)+8192)); }while(0)
  const int vb0=(int)(lds0+LDS_V)+((lane>>4)&1)*32+(lane&3)*8+(4*hi+((lane&15)>>2))*64;
  const char*Kbase=shm+LDS_K; bf16x8 kf[8];
  const lds_cptr shm3=(lds_cptr)shm; const lds_cptr kp0=shm3+LDS_K+hi*1024+r32*16; const lds_cptr vp0=shm3+LDS_V+((lane>>4)&1)*32+(lane&3)*8+(4*hi+((lane&15)>>2))*64;
  if(!prefetched){DMA_K(0,0);DMA_V(0,0);DMA_K(1,SLOTB);}
  bf16x8 qr[4];
  #pragma unroll
  for(int d0=0;d0<4;++d0)qr[d0]=*reinterpret_cast<const bf16x8*>(&Qw[(long)r32*DM+d0*16+hi*8]);
  float mhat=0.f,l_reg=0.f;f32x16 o[4]; { float z_; asm volatile("v_mov_b32 %0, 0":"=v"(z_)); _Pragma("unroll") for(int r=0;r<16;++r){o[0][r]=z_;o[1][r]=z_;o[2][r]=z_;o[3][r]=z_;} }
  const int qrel=wid*QBLK+r32;
  #define CMASK(P0,P1,t) do{int jb_=(t)-(NT-4); if(jb_>=0)cmask(P0,P1,jb_,qrel,hi);}while(0)
  bool resc=false;
  #define START(P0,P1) do{ const float rm=rowmax(P0,P1); resc=false; \
    { const float dl=rm; mhat=fadd_s(mhat,dl); \
      _Pragma("unroll") for(int r=0;r<16;++r){P0[r]=fsub_s(P0[r],dl);P1[r]=fsub_s(P1[r],dl);} \
      } \
    _Pragma("unroll") for(int r=0;r<16;++r)P0[r]=__builtin_amdgcn_exp2f(P0[r]); }while(0)
  #define RESC() do{ if(resc){ asm volatile("s_waitcnt lgkmcnt(0)":::"memory"); \
      _Pragma("unroll") for(int d_=0;d_<4;++d_) _Pragma("unroll") for(int r=0;r<16;++r)o[d_][r]*=wsf[crow(r,hi)]; } }while(0)
  f32x16 pA0,pA1,pB0,pB1;
  int sl_prev=0,sl_cur=0,sl_next=SLOTB;
  #define ROT() do{sl_prev=sl_cur;sl_cur=sl_next;sl_next=(sl_next==(NSLOT-1)*SLOTB)?0:sl_next+SLOTB;}while(0)
  DMA_K(2,2*SLOTB);
  WAIT_BAR(4);
  qkt(pA0,pA1,Kbase,qr,r32,hi);asm volatile("s_nop 15\n\ts_nop 7":"+v"(pA0),"+v"(pA1));
  { _Pragma("unroll") for(int r=8;r<16;++r)pA0[r]=-INFINITY; _Pragma("unroll") for(int r=0;r<16;++r)pA1[r]=-INFINITY; }
  START(pA0,pA1);
  _Pragma("unroll") for(int r=0;r<16;++r)pA1[r]=__builtin_amdgcn_exp2f(pA1[r]);
  WAIT_BAR(0);
  DMA_K(3,0);DMA_V(1,SLOTB);
  ROT();
  kload8(kf,kp0+sl_cur);
  WAIT_BAR(3);
  s16x4 vlo[8],vhi[8]; u32x4 pw0,pw1,pw2,pw3;
  #define PKW(P,B) cvtpk_s(P[B],P[B+1])
  #define PAF(k) __builtin_bit_cast(bf16x8,pw##k)
  #define VFR(i) (bf16x8){vlo[i][0],vlo[i][1],vlo[i][2],vlo[i][3],vhi[i][0],vhi[i][1],vhi[i][2],vhi[i][3]}
  #define PIN(x) asm volatile("":"+v"(x))
  #define MX3(a,b,c) __builtin_fmaxf(__builtin_fmaxf((a),(b)),(c))
  #define GAPA(MF,A0,A1,A2,A3,W0,W1,PW) do{ MF; sacc+=A0; sacc+=A1; sacc+=A2; sacc+=A3; PIN(sacc); W0; W1; PIN(PW); SBAR(); }while(0)
  #define EX(v) __builtin_amdgcn_exp2f(v)
  #define GAPB(MF,X,B) do{ MF; X[B]=EX(X[B]); X[B+1]=EX(X[B+1]); X[B+2]=EX(X[B+2]); X[B+3]=EX(X[B+3]); PIN(X); SBAR(); }while(0)
  #define GAPB2(MF,RD,X,B) do{ MF; RD; X[B]=EX(X[B]); X[B+1]=EX(X[B+1]); PIN(X); SBAR(); }while(0)
  #define VRD2(i) do{ vlo[i]=vtr(vp2_+(((i)>>2)*4096+((i)&3)*1024)); vhi[i]=vtr(vp2_+(((i)>>2)*4096+((i)&3)*1024+512)); }while(0)
  #define VRD(i) do{ vlo[i]=vtr(vp_+(((i)>>2)*4096+((i)&3)*1024)); vhi[i]=vtr(vp_+(((i)>>2)*4096+((i)&3)*1024+512)); }while(0)
  #define KRD(G,j) do{ if(G){ kload2(kf,kp0+sl_next,j); SBAR(); } }while(0)
  #define STEP(C0,C1,P0,P1,t,GK,GV,GL) do{ SBAR(); \
    const lds_cptr vp_=vp0+2*sl_prev; \
    VRD(0); SBAR(); float sacc=(P0[0]+P0[1]); \
    GAPA(C0=__builtin_amdgcn_mfma_f32_32x32x16_bf16(kf[0],qr[0],f32x16{},0,0,0), P0[2],P0[3],P0[4],P0[5],     pw0[0]=PKW(P0,0), pw0[1]=PKW(P0,2), pw0); \
    VRD(4); SBAR(); GAPA(C1=__builtin_amdgcn_mfma_f32_32x32x16_bf16(kf[1],qr[0],f32x16{},0,0,0), P0[6],P0[7],P0[8],P0[9],     pw0[2]=PKW(P0,4), pw0[3]=PKW(P0,6), pw0); \
    VRD(1); SBAR(); GAPA(C0=__builtin_amdgcn_mfma_f32_32x32x16_bf16(kf[2],qr[1],C0,0,0,0),   P0[10],P0[11],P0[12],P0[13], pw1[0]=PKW(P0,8), pw1[1]=PKW(P0,10), pw1); \
    VRD(5); SBAR(); GAPA(C1=__builtin_amdgcn_mfma_f32_32x32x16_bf16(kf[3],qr[1],C1,0,0,0),   P0[14],P0[15],P1[0],P1[1],   pw1[2]=PKW(P0,12),pw1[3]=PKW(P0,14), pw1); \
    VRD(2); SBAR(); GAPA(C0=__builtin_amdgcn_mfma_f32_32x32x16_bf16(kf[4],qr[2],C0,0,0,0),   P1[2],P1[3],P1[4],P1[5],     pw2[0]=PKW(P1,0), pw2[1]=PKW(P1,2), pw2); \
    VRD(6); SBAR(); GAPA(C1=__builtin_amdgcn_mfma_f32_32x32x16_bf16(kf[5],qr[2],C1,0,0,0),   P1[6],P1[7],P1[8],P1[9],     pw2[2]=PKW(P1,4), pw2[3]=PKW(P1,6), pw2); \
    VRD(3); SBAR(); GAPA(C0=__builtin_amdgcn_mfma_f32_32x32x16_bf16(kf[6],qr[3],C0,0,0,0),   P1[10],P1[11],P1[12],P1[13], pw3[0]=PKW(P1,8), pw3[1]=PKW(P1,10), pw3); \
    VRD(7); SBAR(); GAPA(C1=__builtin_amdgcn_mfma_f32_32x32x16_bf16(kf[7],qr[3],C1,0,0,0),   P1[14],P1[15],0.f,0.f,       pw3[2]=PKW(P1,12),pw3[3]=PKW(P1,14), pw3); \
    l_reg+=sacc; \
    _Pragma("unroll") for(int r=0;r<16;++r){C0[r]-=mhat;C1[r]-=mhat;} \
    if(GK){DMA_K((t)+3,sl_cur);} if(GV){DMA_V((t)+1,sl_next);} \
    CMASK(C0,C1,t); \
    { float a=MX3(C0[0],C0[1],C1[0]),b=MX3(C0[2],C0[3],C1[1]); a=MX3(a,C1[2],C1[3]); \
      _Pragma("unroll") for(int r=4;r<16;r+=4){a=MX3(a,C0[r],C0[r+1]);b=MX3(b,C0[r+2],C0[r+3]);a=MX3(a,C1[r],C1[r+1]);b=MX3(b,C1[r+2],C1[r+3]);} \
      float rm=__builtin_fmaxf(a,b); { auto rr=__builtin_amdgcn_permlane32_swap(__float_as_uint(rm),__float_as_uint(rm),false,false); rm=__builtin_fmaxf(__uint_as_float(rr[0]),__uint_as_float(rr[1])); } \
      resc=false; \
      if(__builtin_expect(__any(rm>(float)THRL),0)){ const float dl=__builtin_fmaxf(rm,0.f); mhat+=dl; \
        _Pragma("unroll") for(int r=0;r<16;++r){C0[r]-=dl;C1[r]-=dl;} \
        const float f=__builtin_amdgcn_exp2f(-dl); l_reg*=f; if(hi==0)wsf[r32]=f; resc=true; } } \
    SBAR(); \
    const lds_cptr vp2_=vp0+2*sl_prev+8192; \
    GAPB2(o[0]=__builtin_amdgcn_mfma_f32_32x32x16_bf16(PAF(0),VFR(0),o[0],0,0,0), VRD2(0), C0,0); \
    GAPB2(o[1]=__builtin_amdgcn_mfma_f32_32x32x16_bf16(PAF(0),VFR(4),o[1],0,0,0), VRD2(4), C0,2); \
    GAPB2(o[0]=__builtin_amdgcn_mfma_f32_32x32x16_bf16(PAF(1),VFR(1),o[0],0,0,0), VRD2(1), C0,4); \
    GAPB2(o[1]=__builtin_amdgcn_mfma_f32_32x32x16_bf16(PAF(1),VFR(5),o[1],0,0,0), VRD2(5), C0,6); \
    GAPB2(o[0]=__builtin_amdgcn_mfma_f32_32x32x16_bf16(PAF(2),VFR(2),o[0],0,0,0), VRD2(2), C0,8); \
    GAPB2(o[1]=__builtin_amdgcn_mfma_f32_32x32x16_bf16(PAF(2),VFR(6),o[1],0,0,0), VRD2(6), C0,10); \
    GAPB2(o[0]=__builtin_amdgcn_mfma_f32_32x32x16_bf16(PAF(3),VFR(3),o[0],0,0,0), VRD2(3), C0,12); \
    GAPB2(o[1]=__builtin_amdgcn_mfma_f32_32x32x16_bf16(PAF(3),VFR(7),o[1],0,0,0), VRD2(7), C0,14); \
    KRD(GL,0); GAPB2(o[2]=__builtin_amdgcn_mfma_f32_32x32x16_bf16(PAF(0),VFR(0),o[2],0,0,0), (void)0, C1,0); \
    KRD(GL,1); GAPB2(o[3]=__builtin_amdgcn_mfma_f32_32x32x16_bf16(PAF(0),VFR(4),o[3],0,0,0), (void)0, C1,2); \
    KRD(GL,2); GAPB2(o[2]=__builtin_amdgcn_mfma_f32_32x32x16_bf16(PAF(1),VFR(1),o[2],0,0,0), (void)0, C1,4); \
    KRD(GL,3); GAPB2(o[3]=__builtin_amdgcn_mfma_f32_32x32x16_bf16(PAF(1),VFR(5),o[3],0,0,0), (void)0, C1,6); \
    GAPB2(o[2]=__builtin_amdgcn_mfma_f32_32x32x16_bf16(PAF(2),VFR(2),o[2],0,0,0), (void)0, C1,8); \
    GAPB2(o[3]=__builtin_amdgcn_mfma_f32_32x32x16_bf16(PAF(2),VFR(6),o[3],0,0,0), (void)0, C1,10); \
    GAPB2(o[2]=__builtin_amdgcn_mfma_f32_32x32x16_bf16(PAF(3),VFR(3),o[2],0,0,0), (void)0, C1,12); \
    GAPB2(o[3]=__builtin_amdgcn_mfma_f32_32x32x16_bf16(PAF(3),VFR(7),o[3],0,0,0), (void)0, C1,14); \
    }while(0)
  int t=1;
  #undef CMASK
  #define CMASK(P0,P1,t) do{}while(0)
  for(;t+5<NT;t+=2){
    STEP(pB0,pB1,pA0,pA1,t,true,true,true);     WAIT_BAR(3); RESC(); ROT();
    STEP(pA0,pA1,pB0,pB1,t+1,true,true,true);   WAIT_BAR(3); RESC(); ROT();
  }
  #undef CMASK
  #define CMASK(P0,P1,t) do{int jb_=(t)-(NT-4); if(jb_>=0)cmask(P0,P1,jb_,qrel,hi);}while(0)
  #define ENDW(tt) do{ if((tt)+3<NT){WAIT_BAR(3);} else if((tt)+2<NT){WAIT_BAR(2);} else {WAIT_BAR(0);} }while(0)
  for(;t+3<NT;t+=2){
    STEP(pB0,pB1,pA0,pA1,t,(t+3<NT),(t+1<NT),(t+1<NT));       ENDW(t);   RESC(); ROT();
    STEP(pA0,pA1,pB0,pB1,t+1,(t+4<NT),(t+2<NT),(t+2<NT));     ENDW(t+1); RESC(); ROT();
  }
  STEP(pB0,pB1,pA0,pA1,NT-2,false,true,true);  WAIT_BAR(0); RESC(); ROT();
  STEP(pA0,pA1,pB0,pB1,NT-1,false,false,false); RESC();
  { float sacc=pA0[0]+pA0[1]; _Pragma("unroll") for(int r=2;r<16;++r)sacc+=pA0[r]; _Pragma("unroll") for(int r=0;r<16;++r)sacc+=pA1[r]; l_reg+=sacc;
    pw0=(u32x4){PKW(pA0,0),PKW(pA0,2),PKW(pA0,4),PKW(pA0,6)};pw1=(u32x4){PKW(pA0,8),PKW(pA0,10),PKW(pA0,12),PKW(pA0,14)};pw2=(u32x4){PKW(pA1,0),PKW(pA1,2),PKW(pA1,4),PKW(pA1,6)};pw3=(u32x4){PKW(pA1,8),PKW(pA1,10),PKW(pA1,12),PKW(pA1,14)};
    SBAR(); pv(o,vb0+2*sl_cur,PAF(0),PAF(1),PAF(2),PAF(3)); pv(o+2,vb0+2*sl_cur+8192,PAF(0),PAF(1),PAF(2),PAF(3)); }
  asm volatile("s_waitcnt lgkmcnt(0)\n\ts_barrier":::"memory");
  if(has_next){ const bf16*ksrc_n=Kh_next+wid*8;
    glds16s(ksrc_n,koff,(unsigned)__builtin_amdgcn_readfirstlane(kdst)); DMA_V(0,0); glds16s(ksrc_n+(long)KVBLK*DM,koff,(unsigned)__builtin_amdgcn_readfirstlane(kdst+SLOTB)); }
  #undef PKW
  #undef PAF
  #undef VFR
  #undef PIN
  #undef MX3
  #undef GAPA
  #undef GAPB
  #undef GAPB2
  #undef VRD2
  #undef EX
  #undef VRD
  #undef KRD
  #undef STEP
  #undef ENDW
  {auto rr=__builtin_amdgcn_permlane32_swap(__float_as_uint(l_reg),__float_as_uint(l_reg),false,false);l_reg=__uint_as_float(rr[0])+__uint_as_float(rr[1]);}
  if(hi==0)wsf[32+r32]=l_reg;asm volatile("s_waitcnt lgkmcnt(0)":::"memory");
  float rli[16];
  #pragma unroll
  for(int r=0;r<16;++r)rli[r]=__builtin_amdgcn_rcpf(wsf[32+crow(r,hi)]);
  { typedef __attribute__((address_space(3))) unsigned short* lds_u16p;
    int ln=lane; asm volatile("":"+v"(ln));
    const int r32e=ln&31, hie=ln>>5; const int bc=hie*4+(r32e>>3); const int lb=hie*512+(r32e&7);
    const lds_u16p Hw=(lds_u16p)(shm3+LDS_H+wid*8192);
    #pragma unroll
    for(int r=0;r<16;++r){
      #pragma unroll
      for(int d0=0;d0<4;++d0){ const int idx=lb+((r&3)+8*(r>>2))*128+((bc^(((((r>>2)&1)<<3)|(r&3))^(d0<<2)))<<3);
        float val=o[d0][r]*rli[r];
        if(m_sub){ const float old=__uint_as_float(((unsigned)Hw[idx])<<16); val=old-lam*val; }
        Hw[idx]=(unsigned short)(cvtpk_s(val,0.f)&0xffffu); } } }
  asm volatile("s_waitcnt lgkmcnt(0)":::"memory");
  __builtin_amdgcn_s_setprio(0);
  #undef DMA_K
  #undef DMA_V
  #undef CMASK
  #undef START
  #undef RESC
  #undef ROT
}
constexpr int ATTN_LDS_BYTES=LDS_BYTES;
#undef SBAR
#undef WAIT_BAR
}

namespace cg = cooperative_groups;
#define GAS __attribute__((address_space(1)))
#define LAS __attribute__((address_space(3)))
typedef unsigned short bf16;
typedef unsigned v4u __attribute__((ext_vector_type(4)));
typedef float f32x4 __attribute__((ext_vector_type(4)));

constexpr int NB = 32, SEQ = 2048, DM = 1024, MTOK = NB * SEQ;
constexpr int INC = 8192, DFF = 2816, KROWS = 64 + SEQ;
constexpr float NORM_EPS = 1e-5f, LAMBDA_INIT = 0.2f;
constexpr float QSCALE = 0.125f * 1.4426950408889634f;
constexpr size_t MiB = 1u << 20;
constexpr size_t WS_SS2 = 0, WS_SS3 = 256 * 1024, WS_RS1 = 512 * 1024, WS_PM = 768 * 1024;
constexpr size_t WS_WIN = 2 * MiB, WS_WP = 18 * MiB, WS_WOUT = 22 * MiB, WS_WGU = 24 * MiB, WS_WDN = 35 * MiB;
constexpr size_t WS_QO = 48 * MiB, WS_CB = 176 * MiB, WS_U = 304 * MiB, WS_SGA = 432 * MiB, WS_SGB = 560 * MiB, WS_KB = 688 * MiB, WS_VB = 820 * MiB, WS_END = 952 * MiB;
constexpr size_t WS_MG = WS_KB, WS_H2B = WS_VB, WS_ACT = WS_QO;
static_assert(WS_ACT + (size_t)MTOK * DFF * 2 <= WS_SGA + 128 * MiB && WS_KB + (size_t)NB * KROWS * DM * 2 <= WS_VB && WS_VB + (size_t)NB * KROWS * DM * 2 <= WS_END, "ws map");
constexpr int LDS_BYTES = 147456;
static_assert(attn_body::ATTN_LDS_BYTES <= LDS_BYTES, "attention LDS");
constexpr size_t WS_BAR = 1 * MiB;
constexpr int LDS_BARST = LDS_BYTES - 256;
static_assert(attn_body::ATTN_LDS_BYTES <= LDS_BARST, "attention LDS vs barrier words");
#define RLX_AGENT __ATOMIC_RELAXED, __HIP_MEMORY_SCOPE_AGENT
#define XB_TMO      128
#define XB_XCNT(j)  (256  + 64 * (j))
#define XB_XSUB(j)  (1280 + 64 * (j))
#define XB_XGEN(j)  (2304 + 64 * (j))
#define XB_TOP      3328
#define XB_TOPGEN   3392
#define XCD_BAR_WORDS 3456
#define XB_SPIN_CAP (1u << 18)

__device__ __forceinline__ unsigned xb_ld(unsigned* p)              { return __hip_atomic_load(p, __ATOMIC_RELAXED, __HIP_MEMORY_SCOPE_AGENT); }
__device__ __forceinline__ unsigned xb_add(unsigned* p, unsigned v) { return __hip_atomic_fetch_add(p, v, __ATOMIC_RELAXED, __HIP_MEMORY_SCOPE_AGENT); }
__device__ __forceinline__ unsigned xb_xcc_id() { return (unsigned)__builtin_amdgcn_s_getreg((3 << 11) | 20) & 0xFu; }
#define XB_SPIN(cond, bar) do { unsigned _sp = 0; while (cond) { __builtin_amdgcn_s_sleep(1); \
    if ((++_sp & 255u) == 0u) { if (xb_ld(&(bar)[XB_TMO])) break; if (_sp > XB_SPIN_CAP) { atomicAdd(&(bar)[XB_TMO], 1u); break; } } } } while (0)

struct XcdBarrier {
    unsigned* bar; unsigned x;
    volatile LAS unsigned* st;
};

__device__ __forceinline__ XcdBarrier xcd_barrier_post(unsigned* bar, volatile LAS unsigned* st) {
    XcdBarrier b; b.bar = bar; b.x = xb_xcc_id(); b.st = st;
    if (threadIdx.x == 0) (void)xb_add(&bar[XB_XCNT(b.x)], 1u);
    return b;
}
__device__ __forceinline__ void xcd_barrier_complete(unsigned* bar, unsigned x, unsigned& nloc, unsigned& nx) {
    const unsigned G = gridDim.x * gridDim.y * gridDim.z;
    unsigned sum, cnt, mine, sp = 0u;
    for (;;) {
        sum = 0u; cnt = 0u; mine = 0u;
#pragma unroll
        for (unsigned j = 0; j < 16; ++j) { const unsigned c = xb_ld(&bar[XB_XCNT(j)]); sum += c; cnt += (c > 0u) ? 1u : 0u; mine = (j == x) ? c : mine; }
        if (sum == G) break;
        __builtin_amdgcn_s_sleep(1);
        if ((++sp & 255u) == 0u) { if (xb_ld(&bar[XB_TMO])) break; if (sp > XB_SPIN_CAP) { atomicAdd(&bar[XB_TMO], 1u); break; } }
    }
    nloc = mine > 0u ? mine : 1u; nx = cnt > 0u ? cnt : 1u;
}

__device__ __forceinline__ void xcd_barrier(const XcdBarrier& b) {
    asm volatile("s_waitcnt vmcnt(0)" ::: "memory");
    __syncthreads();
    if (threadIdx.x == 0) {
        unsigned* bar = b.bar;
        __builtin_amdgcn_s_waitcnt(0);
        unsigned nloc = b.st[0], nx = b.st[1];
        if (nloc == 0u) { xcd_barrier_complete(bar, b.x, nloc, nx); b.st[0] = nloc; b.st[1] = nx; }
        const unsigned old = xb_add(&bar[XB_XSUB(b.x)], 1u);
        const unsigned gen = old / nloc;
        if (old + 1u == (gen + 1u) * nloc) {
            __builtin_amdgcn_fence(__ATOMIC_RELEASE, "agent");
            asm volatile("s_waitcnt vmcnt(0)" ::: "memory");
            const unsigned og = xb_add(&bar[XB_TOP], 1u);
            const unsigned tg = og / nx;
            if (og + 1u == (tg + 1u) * nx) xb_add(&bar[XB_TOPGEN], 1u);
            else XB_SPIN(xb_ld(&bar[XB_TOPGEN]) == tg, bar);
            __builtin_amdgcn_fence(__ATOMIC_ACQUIRE, "agent");
            xb_add(&bar[XB_XGEN(b.x)], 1u);
            asm volatile("s_waitcnt vmcnt(0)" ::: "memory");
        } else {
            XB_SPIN(xb_ld(&bar[XB_XGEN(b.x)]) == gen, bar);
            __builtin_amdgcn_fence(__ATOMIC_ACQUIRE, "agent");
            asm volatile("s_waitcnt vmcnt(0)" ::: "memory");
        }
    }
    __syncthreads();
}


template <int K> __device__ __forceinline__ float xor_swz(float v) { return __uint_as_float((unsigned)__builtin_amdgcn_ds_swizzle((int)__float_as_uint(v), (K << 10) | 0x1f)); }
__device__ __forceinline__ float xor32_sum(float v) { auto rr = __builtin_amdgcn_permlane32_swap(__float_as_uint(v), __float_as_uint(v), false, false); return __uint_as_float(rr[0]) + __uint_as_float(rr[1]); }
__device__ __forceinline__ float wave_sum(float v) { v += xor_swz<1>(v); v += xor_swz<2>(v); v += xor_swz<4>(v); v += xor_swz<8>(v); v += xor_swz<16>(v); return xor32_sum(v); }
__device__ __forceinline__ float bf_lo(unsigned w) { return __uint_as_float(w << 16); }
__device__ __forceinline__ float bf_hi(unsigned w) { return __uint_as_float(w & 0xffff0000u); }
__device__ __forceinline__ v4u pack8(f32x4 a, f32x4 b) { v4u w; w.x = pg8::cvt_pk_bf16(a[0], a[1]); w.y = pg8::cvt_pk_bf16(a[2], a[3]); w.z = pg8::cvt_pk_bf16(b[0], b[1]); w.w = pg8::cvt_pk_bf16(b[2], b[3]); return w; }
__device__ __forceinline__ void unpack8(v4u w, f32x4& a, f32x4& b) { a = (f32x4){bf_lo(w.x), bf_hi(w.x), bf_lo(w.y), bf_hi(w.y)}; b = (f32x4){bf_lo(w.z), bf_hi(w.z), bf_lo(w.w), bf_hi(w.w)}; }
__device__ __forceinline__ float sigm(float x) { return __builtin_amdgcn_rcpf(1.f + __builtin_amdgcn_exp2f(-1.4426950408889634f * x)); }
__device__ __forceinline__ float inv_freq(int d) { return exp2f(-(float)d * (13.287712379549449f / 32.f)); }
__device__ __forceinline__ void rope_cs(float pos, float invf, float& c, float& s) {
    const float ang = pos * invf; float rev = ang * 0.15915494309189535f; rev = __builtin_amdgcn_fractf(rev);
    s = __builtin_amdgcn_sinf(rev); c = __builtin_amdgcn_cosf(rev);
}

namespace pg8 {
#define NTST(ptr, val) (*(v4u*)(ptr) = (val))
struct EpiInProj {
    static constexpr bool PERM = true, AFTER_DRAIN = false, MID = false;
    const float* rs1; bf16_t *QO, *KB, *VB, *CB, *U, *SGA, *SGB;
    __device__ __forceinline__ void operator()(const f32x4 (&acc)[2][2][4][2], const Unit& u, int wr, int wc, int fr, int fq) const {
        int frp = fr; asm volatile("" : "+v"(frp)); const int pn = u.pn, row0 = u.pm * BM + wr * 64 + frp;
        const size_t kvshift = (size_t)64 * ((u.pm >> 3) + 1);
        if (pn < 8) {
            const bool isq = pn < 4; bf16_t* base = isq ? QO : KB; const float s0 = isq ? QSCALE : 1.f;
            const int colt = (pn & 3) * 256 + wc * 64 + 8 * fq;
            float invf[8];
#pragma unroll
            for (int k = 0; k < 8; ++k) invf[k] = inv_freq(8 * fq + k);
#pragma unroll
            for (int ai = 0; ai < 2; ++ai)
#pragma unroll
                for (int m = 0; m < 4; ++m) {
                    const int row = row0 + ai * HALF + m * 16; const float pos = (float)(16 + (row & (SEQ - 1))); const float sc = s0;
                    const size_t orow = isq ? (size_t)row : (size_t)row + kvshift;
                    f32x4 lo[2], hi[2], ylo[2], yhi[2];
                    lo[0] = acc[ai][0][m][0] * sc; lo[1] = acc[ai][0][m][1] * sc; hi[0] = acc[ai][1][m][0] * sc; hi[1] = acc[ai][1][m][1] * sc;
#pragma unroll
                    for (int n = 0; n < 2; ++n)
#pragma unroll
                        for (int k = 0; k < 4; ++k) { float c, s; rope_cs(pos, invf[4 * n + k], c, s); ylo[n][k] = lo[n][k] * c - hi[n][k] * s; yhi[n][k] = hi[n][k] * c + lo[n][k] * s; }
                    bf16_t* p = base + orow * DM + colt;
                    NTST(p, pack8(ylo[0], ylo[1])); NTST((p + 32), pack8(yhi[0], yhi[1]));
                }
        } else if (pn < 16) {
            const bool isv = pn < 12; bf16_t* base = isv ? VB : CB; const int colt = (pn & 3) * 256 + wc * 32 + 8 * fq;
#pragma unroll
            for (int ai = 0; ai < 2; ++ai)
#pragma unroll
                for (int m = 0; m < 4; ++m) {
                    const int row = row0 + ai * HALF + m * 16; const float sc = 1.f; const size_t orow = isv ? (size_t)row + kvshift : (size_t)row;
                    bf16_t* p = base + orow * DM + colt;
#pragma unroll
                    for (int bj = 0; bj < 2; ++bj) NTST((p + bj * HALF), pack8(acc[ai][bj][m][0] * sc, acc[ai][bj][m][1] * sc));
                }
        } else if (pn < 24) {
            const int colt = (pn - 16) * 128 + wc * 32 + 8 * fq;
#pragma unroll
            for (int ai = 0; ai < 2; ++ai)
#pragma unroll
                for (int m = 0; m < 4; ++m) {
                    const int row = row0 + ai * HALF + m * 16; const float sc2 = 1.f;
                    NTST((U + (size_t)row * DM + colt), pack8(acc[ai][0][m][0] * acc[ai][1][m][0] * sc2, acc[ai][0][m][1] * acc[ai][1][m][1] * sc2));
                }
        } else {
            const int colt = (pn - 24) * 128 + wc * 32 + 8 * fq;
#pragma unroll
            for (int ai = 0; ai < 2; ++ai)
#pragma unroll
                for (int m = 0; m < 4; ++m) {
                    const int row = row0 + ai * HALF + m * 16; f32x4 ra[2], sb[2];
#pragma unroll
                    for (int n = 0; n < 2; ++n)
#pragma unroll
                        for (int k = 0; k < 4; ++k) { const float ea = __builtin_amdgcn_exp2f(fminf(-1.4426950408889634f * acc[ai][0][m][n][k], 80.f)), eb = __builtin_amdgcn_exp2f(fminf(-1.4426950408889634f * acc[ai][1][m][n][k], 80.f));
                            ra[n][k] = __builtin_amdgcn_rcpf(1.f + ea) * (1.f + eb); sb[n][k] = __builtin_amdgcn_rcpf(1.f + eb); }
                    NTST((SGA + (size_t)row * DM + colt), pack8(ra[0], ra[1])); NTST((SGB + (size_t)row * DM + colt), pack8(sb[0], sb[1]));
                }
        }
    }
};
struct EpiMerge {
    static constexpr bool PERM = true, AFTER_DRAIN = false, MID = true;
    const bf16_t *SGA, *SGB; bf16_t* MG;
    __device__ __forceinline__ void mid(f32x4 (&acc)[2][2][4][2], const Unit& u, int wr, int wc, int fr, int fq) const {
        int frp = fr; asm volatile("" : "+v"(frp)); const int row0 = u.pm * BM + wr * 64 + frp, col0 = u.pn * BM + wc * 32 + 8 * fq;
#pragma unroll
        for (int ai = 0; ai < 2; ++ai)
#pragma unroll
            for (int m = 0; m < 4; ++m) { const size_t off = (size_t)(row0 + ai * HALF + m * 16) * DM + col0;
#pragma unroll
                for (int bj = 0; bj < 2; ++bj) { f32x4 a0, a1; unpack8(*(const v4u*)(SGA + off + bj * HALF), a0, a1);
                    acc[ai][bj][m][0] *= a0; acc[ai][bj][m][1] *= a1; }
                if (m == 3) asm volatile("" ::: "memory"); }
    }
    __device__ __forceinline__ void operator()(const f32x4 (&acc)[2][2][4][2], const Unit& u, int wr, int wc, int fr, int fq) const {
        int frp = fr; asm volatile("" : "+v"(frp)); const int row0 = u.pm * BM + wr * 64 + frp, col0 = u.pn * BM + wc * 32 + 8 * fq;
#pragma unroll
        for (int ai = 0; ai < 2; ++ai)
#pragma unroll
            for (int m = 0; m < 4; ++m) { const size_t off = (size_t)(row0 + ai * HALF + m * 16) * DM + col0;
#pragma unroll
                for (int bj = 0; bj < 2; ++bj) { f32x4 b0, b1; unpack8(*(const v4u*)(SGB + off + bj * HALF), b0, b1);
                    NTST((MG + off + bj * HALF), pack8(acc[ai][bj][m][0] * b0, acc[ai][bj][m][1] * b1)); } }
    }
};
template <bool IN_BF16> struct EpiResid {
    static constexpr bool PERM = true, AFTER_DRAIN = false, MID = false;
    const void* hin; bf16_t* hb; float* ss; const float* rsn;
    __device__ __forceinline__ void operator()(const f32x4 (&acc)[2][2][4][2], const Unit& u, int wr, int wc, int fr, int fq) const {
        int frp = fr; asm volatile("" : "+v"(frp)); const int row0 = u.pm * BM + wr * 64 + frp, col0 = u.pn * BM + wc * 32 + 8 * fq;
#pragma unroll
        for (int ai = 0; ai < 2; ++ai)
#pragma unroll
            for (int m = 0; m < 4; ++m) { const int row = row0 + ai * HALF + m * 16; const size_t off = (size_t)row * DM + col0; float s = 0.f; const float rinv = rsn ? __builtin_amdgcn_rcpf(rsn[row]) : 1.f;
#pragma unroll
                for (int bj = 0; bj < 2; ++bj) { f32x4 h0, h1;
                    if (IN_BF16) unpack8(*(const v4u*)((const bf16_t*)hin + off + bj * HALF), h0, h1);
                    else { h0 = *(const f32x4*)((const float*)hin + off + bj * HALF); h1 = *(const f32x4*)((const float*)hin + off + bj * HALF + 4); }
                    if (rsn) { h0 = h0 * rinv; h1 = h1 * rinv; }
                    h0 += acc[ai][bj][m][0]; h1 += acc[ai][bj][m][1];
                    NTST((hb + off + bj * HALF), pack8(h0, h1));
                    s += (h0[0] * h0[0] + h0[1] * h0[1]) + (h0[2] * h0[2] + h0[3] * h0[3]) + (h1[0] * h1[0] + h1[1] * h1[1]) + (h1[2] * h1[2] + h1[3] * h1[3]); }
                s += xor_swz<16>(s); s = xor32_sum(s);
                if (fq == 0) (void)__hip_atomic_fetch_add(ss + row, s, __ATOMIC_RELAXED, __HIP_MEMORY_SCOPE_AGENT); }
    }
};
struct EpiGateUp {
    static constexpr bool PERM = true, AFTER_DRAIN = false, MID = false;
    const float* ss2; bf16_t* ACT; mutable float r2v[2][4]; mutable int last_pm;
    __device__ __forceinline__ void operator()(const f32x4 (&acc)[2][2][4][2], const Unit& u, int wr, int wc, int fr, int fq) const {
        int frp = fr; asm volatile("" : "+v"(frp)); const int row0 = u.pm * BM + wr * 64 + frp, col0 = u.pn * HALF + wc * 32 + 8 * fq;
        if (u.pm != last_pm) { last_pm = u.pm;
#pragma unroll
            for (int ai = 0; ai < 2; ++ai)
#pragma unroll
                for (int m = 0; m < 4; ++m) r2v[ai][m] = __builtin_amdgcn_rsqf(ss2[row0 + ai * HALF + m * 16] * (1.f / DM) + NORM_EPS);
#pragma unroll
            for (int ai = 0; ai < 2; ++ai)
#pragma unroll
                for (int m = 0; m < 4; ++m) asm volatile("" : "+v"(r2v[ai][m]));
        }
#pragma unroll
        for (int ai = 0; ai < 2; ++ai)
#pragma unroll
            for (int m = 0; m < 4; ++m) { const int row = row0 + ai * HALF + m * 16; const float r2 = r2v[ai][m];
                f32x4 o[2];
#pragma unroll
                for (int n = 0; n < 2; ++n) { const f32x4 g = acc[ai][0][m][n] * r2, uu = acc[ai][1][m][n] * r2;
#pragma unroll
                    for (int k = 0; k < 4; ++k) o[n][k] = g[k] * sigm(g[k]) * uu[k]; }
                NTST((ACT + (size_t)row * DFF + col0), pack8(o[0], o[1])); }
    }
};
}

__device__ __forceinline__ void transpose_item(const float* W, int N, int k0, int n0src, const float* ksc, bf16* WT, int ldk, int drow0, int dk0, LAS float* scr, int lane) {
#pragma unroll
    for (int i = 0; i < 32; ++i) { const int kk = 2 * i + (lane >> 5); float v = W[(size_t)(k0 + kk) * N + n0src + (lane & 31)]; if (ksc) v *= ksc[k0 + kk]; scr[kk * 33 + (lane & 31)] = v; }
    asm volatile("s_waitcnt lgkmcnt(0)" ::: "memory");
    const int c = lane & 7;
#pragma unroll
    for (int j = 0; j < 4; ++j) { const int n = (lane >> 3) + 8 * j; const LAS float* s = scr + (8 * c) * 33 + n;
        v4u o; o.x = pg8::cvt_pk_bf16(s[0 * 33], s[1 * 33]); o.y = pg8::cvt_pk_bf16(s[2 * 33], s[3 * 33]); o.z = pg8::cvt_pk_bf16(s[4 * 33], s[5 * 33]); o.w = pg8::cvt_pk_bf16(s[6 * 33], s[7 * 33]);
        *(v4u*)(WT + (size_t)(drow0 + n) * ldk + dk0 + 8 * c) = o; }
    asm volatile("s_waitcnt lgkmcnt(0)" ::: "memory");
}
__device__ __forceinline__ int win_src_col(int rb) {
    const int pn = rb >> 3, sb = rb & 7, bj = sb >> 2, wc = sb & 3;
    if (pn < 8) return pn * 256 + 64 * wc + 32 * bj;
    if (pn < 16) return pn * 256 + sb * 32;
    if (pn < 24) return (bj ? 5120 : 4096) + 128 * (pn - 16) + 32 * wc;
    return (bj ? 7168 : 6144) + 128 * (pn - 24) + 32 * wc;
}

#ifndef REPMASK
#define REPMASK 0
#endif
#ifndef PHMASK
#define PHMASK 0xFF
#endif
struct Args { const float* in[17]; float* out; unsigned char* ws; };

__global__ void __launch_bounds__(512, 2) fwd_kernel(Args a) {
    extern __shared__ __attribute__((aligned(16))) unsigned char lds[];
    cg::grid_group grid = cg::this_grid();
    const int wave = __builtin_amdgcn_readfirstlane((int)threadIdx.x >> 6);
#define PIN_TID() int tid_ = threadIdx.x; asm volatile("" : "+v"(tid_)); const int tid = tid_, lane = tid & 63, gtid = bx * 512 + tid; (void)lane; (void)gtid
    const int G = gridDim.x, bx = blockIdx.x;
    const int vcu = (G % 8 == 0) ? (bx % 8) * (G / 8) + bx / 8 : bx;
    LAS unsigned char* L = (LAS unsigned char*)lds;
    unsigned char* ws = a.ws;
    const float* x = a.in[0]; const float* w_in = a.in[3];
#define Win_t ((bf16*)(ws + WS_WIN))
#define Wp_t ((bf16*)(ws + WS_WP))
#define Wout_t ((bf16*)(ws + WS_WOUT))
#define Wgu_t ((bf16*)(ws + WS_WGU))
#define Wdn_t ((bf16*)(ws + WS_WDN))
#define QO ((bf16*)(ws + WS_QO))
#define CB ((bf16*)(ws + WS_CB))
#define U ((bf16*)(ws + WS_U))
#define SGA ((bf16*)(ws + WS_SGA))
#define SGB ((bf16*)(ws + WS_SGB))
#define KB ((bf16*)(ws + WS_KB))
#define VB ((bf16*)(ws + WS_VB))
#define MG ((bf16*)(ws + WS_MG))
#define H2B ((bf16*)(ws + WS_H2B))
#define ACT ((bf16*)(ws + WS_ACT))
#define H3B ((bf16*)(ws + WS_SGA))
#define ss2 ((float*)(ws + WS_SS2))
#define ss3 ((float*)(ws + WS_SS3))
#define rs1 ((float*)(ws + WS_RS1))
#define PM ((float*)(ws + WS_PM))
    bf16* HB = (bf16*)a.out;
    { volatile LAS unsigned* st0 = (volatile LAS unsigned*)(L + LDS_BARST); if (threadIdx.x < 2) st0[threadIdx.x] = 0u; __syncthreads(); }
#define XSYNC() xcd_barrier(xbar)
#define GSYNC() do { asm volatile("s_waitcnt vmcnt(0)" ::: "memory"); __syncthreads(); grid.sync(); \
    if (threadIdx.x == 0) { __builtin_amdgcn_fence(__ATOMIC_ACQUIRE, "agent"); asm volatile("s_waitcnt vmcnt(0)" ::: "memory"); } __syncthreads(); } while (0)
    const int GT = G * 512;

    for (int rep_ = 0; rep_ < 1 + ((REPMASK >> 0) & 1); ++rep_) if ((PHMASK >> 0) & 1) {
        PIN_TID();
        const int gw = vcu * 8 + wave, NGW = G * 8;
        for (int i = gtid; i < 2 * MTOK / 4; i += GT) ((f32x4*)ss2)[i] = (f32x4){0.f, 0.f, 0.f, 0.f};
        for (int i = gtid; i < XCD_BAR_WORDS; i += GT) ((unsigned*)(ws + WS_BAR))[i] = 0u;
        for (int i = gtid; i < 2 * NB * 6144; i += GT) { const int buf = i / (NB * 6144), r = i % (NB * 6144), b = r / 6144, o = r % 6144;
            ((v4u*)((buf ? VB : KB) + ((size_t)b * KROWS + 16) * DM))[o] = (v4u){0u, 0u, 0u, 0u}; }
        LAS float* scr = (LAS float*)(L + wave * 16384);
        constexpr int I_IN = 16 * 256, I_P = 16 * 32, I_GU = 16 * 176, I_DN = 44 * 32, NITEMS = I_IN + 3 * I_P + I_GU + I_DN;
        for (int it = gw; it < NITEMS; it += NGW) {
            int r = it;
            if (r < I_IN) { const int kb = r >> 8, rb = r & 255; transpose_item(w_in, INC, kb * 64, win_src_col(rb), a.in[2], Win_t, DM, rb * 32, kb * 64, scr, lane); continue; } r -= I_IN;
            if (r < I_P) { const int kb = r >> 5, rb = r & 31; transpose_item(a.in[10], DM, kb * 64, rb * 32, nullptr, Wp_t, 2 * DM, rb * 32, kb * 64, scr, lane); continue; } r -= I_P;
            if (r < I_P) { const int kb = r >> 5, rb = r & 31; transpose_item(a.in[11], DM, kb * 64, rb * 32, nullptr, Wp_t, 2 * DM, rb * 32, DM + kb * 64, scr, lane); continue; } r -= I_P;
            if (r < I_P) { const int kb = r >> 5, rb = r & 31; transpose_item(a.in[12], DM, kb * 64, rb * 32, nullptr, Wout_t, DM, rb * 32, kb * 64, scr, lane); continue; } r -= I_P;
            if (r < I_GU) { const int kb = r / 176, rb = r % 176, pn = rb >> 3, sb = rb & 7;
                transpose_item(a.in[14], 2 * DFF, kb * 64, ((sb >> 2) ? DFF : 0) + 128 * pn + 32 * (sb & 3), a.in[13], Wgu_t, DM, rb * 32, kb * 64, scr, lane); continue; } r -= I_GU;
            { const int kb = r >> 5, rb = r & 31; transpose_item(a.in[15], DM, kb * 64, rb * 32, nullptr, Wdn_t, DFF, rb * 32, kb * 64, scr, lane); }
        }
        for (int m0 = gw * 4; m0 < MTOK; m0 += NGW * 4) {
            f32x4 v[4][4]; float s[4];
#pragma unroll
            for (int r = 0; r < 4; ++r) { const f32x4* xr = (const f32x4*)(x + (size_t)(m0 + r) * DM) + lane;
#pragma unroll
                for (int j = 0; j < 4; ++j) v[r][j] = __builtin_nontemporal_load(&xr[64 * j]); }
#pragma unroll
            for (int r = 0; r < 4; ++r) { s[r] = 0.f;
#pragma unroll
                for (int j = 0; j < 4; ++j) s[r] += (v[r][j][0] * v[r][j][0] + v[r][j][1] * v[r][j][1]) + (v[r][j][2] * v[r][j][2] + v[r][j][3] * v[r][j][3]);
                s[r] = wave_sum(s[r]); }
            if (lane < 4) rs1[m0 + lane] = __builtin_amdgcn_rsqf((lane == 0 ? s[0] : lane == 1 ? s[1] : lane == 2 ? s[2] : s[3]) * (1.f / DM) + NORM_EPS);
#pragma unroll
            for (int r = 0; r < 4; ++r) { unsigned long long* o8 = (unsigned long long*)(HB + (size_t)(m0 + r) * DM) + lane; const float rsr = __builtin_amdgcn_rsqf(s[r] * (1.f / DM) + NORM_EPS);
#pragma unroll
                for (int j = 0; j < 4; ++j) { const f32x4 q = v[r][j] * rsr; o8[64 * j] = (unsigned long long)pg8::cvt_pk_bf16(q[0], q[1]) | ((unsigned long long)pg8::cvt_pk_bf16(q[2], q[3]) << 32); } }
        }
        for (int job = bx; job < 256; job += G) {
            LAS float* hm = (LAS float*)L; LAS float* red = (LAS float*)(L + 65536);
            __syncthreads();
#pragma unroll
            for (int rr = 0; rr < 2; ++rr) { const int r = wave * 2 + rr; const f32x4* mr = (const f32x4*)(a.in[1] + (size_t)r * DM) + lane; f32x4 v[4]; float s = 0.f;
#pragma unroll
                for (int j = 0; j < 4; ++j) { v[j] = mr[64 * j]; s += (v[j][0] * v[j][0] + v[j][1] * v[j][1]) + (v[j][2] * v[j][2] + v[j][3] * v[j][3]); }
                const float rs = __builtin_amdgcn_rsqf(wave_sum(s) * (1.f / DM) + NORM_EPS);
#pragma unroll
                for (int j = 0; j < 4; ++j) { const f32x4 wv = ((const f32x4*)a.in[2])[lane + 64 * j];
#pragma unroll
                    for (int k = 0; k < 4; ++k) hm[(4 * lane + 256 * j + k) * 16 + r] = v[j][k] * rs * wv[k]; } }
            __syncthreads();
            const int col = tid & 15, ksp = tid >> 4, pcol = job * 16 + col, src = pcol < 2048 ? 1024 + pcol : 4096 + (pcol - 2048);
            float acc[16];
#pragma unroll
            for (int r = 0; r < 16; ++r) acc[r] = 0.f;
#pragma unroll 8
            for (int dd = 0; dd < 32; ++dd) { const int d = ksp * 32 + dd; const float wv = w_in[(size_t)d * INC + src];
                const f32x4 h0 = *(const LAS f32x4*)(hm + d * 16), h1 = *(const LAS f32x4*)(hm + d * 16 + 4), h2 = *(const LAS f32x4*)(hm + d * 16 + 8), h3 = *(const LAS f32x4*)(hm + d * 16 + 12);
#pragma unroll
                for (int k = 0; k < 4; ++k) { acc[k] += h0[k] * wv; acc[4 + k] += h1[k] * wv; acc[8 + k] += h2[k] * wv; acc[12 + k] += h3[k] * wv; } }
#pragma unroll
            for (int r = 0; r < 16; ++r) red[(ksp * 16 + r) * 16 + col] = acc[r];
            __syncthreads();
            if (tid < 256) { const int r = tid >> 4, c = tid & 15; float s = 0.f;
#pragma unroll 8
                for (int k = 0; k < 32; ++k) s += red[(k * 16 + r) * 16 + c];
                PM[r * 4096 + job * 16 + c] = s; }
        }
        __syncthreads();
    }
    GSYNC();
    const XcdBarrier xbar = xcd_barrier_post((unsigned*)(ws + WS_BAR), (volatile LAS unsigned*)(L + LDS_BARST));

    for (int rep_ = 0; rep_ < 1 + ((REPMASK >> 1) & 1); ++rep_) if ((PHMASK >> 1) & 1) {
        PIN_TID();
        for (int rm_ = 0; rm_ < 1 + ((REPMASK >> 8) & 1); ++rm_)
        for (int i = gtid; i < NB * 16 * 256; i += GT) { const int ch = i & 255, r = (i >> 8) & 15, b = i >> 12; const bool isv = ch >= 128; const int c = (ch & 127) * 8;
            f32x4 o0, o1;
            if (!isv) { const int d = c & 63, base = c - d, dl = d & 31; const float* plo = PM + r * 4096 + base + dl; const float* phi = plo + 32;
#pragma unroll
                for (int k = 0; k < 8; ++k) { float cs, sn; rope_cs((float)r, inv_freq(dl + k), cs, sn); const float xl = plo[k], xh = phi[k]; const float y = d < 32 ? xl * cs - xh * sn : xh * cs + xl * sn;
                    if (k < 4) o0[k] = y; else o1[k - 4] = y; }
            } else { o0 = *(const f32x4*)(PM + r * 4096 + 1024 + c); o1 = *(const f32x4*)(PM + r * 4096 + 1024 + c + 4); }
            *(v4u*)((isv ? VB : KB) + ((size_t)b * KROWS + r) * DM + c) = pack8(o0, o1); }
        pg8::Gemm g{HB, HB, Win_t, DM, DM, DM / 64}; pg8::StaticOrder S; S.init(MTOK, INC, G, bx);
        pg8::EpiInProj E{rs1, QO, KB, VB, CB, U, SGA, SGB};
        for (int rg_ = 0; rg_ < 1 + ((REPMASK >> 9) & 1); ++rg_)
        pg8::gemm_phase<pg8::EpiInProj, pg8::StaticOrder, true, true>(L, g, S, E);
    }
    XSYNC();

    for (int rep_ = 0; rep_ < 1 + ((REPMASK >> 2) & 1); ++rep_) if ((PHMASK >> 2) & 1) {
        PIN_TID();
        const float* cw = a.in[9]; bf16* OAp = (bf16*)a.out + (size_t)MTOK * DM; bf16* OBp = CB;
        float lam;
        { const float s1 = wave_sum(a.in[4][lane] * a.in[5][lane]), s2 = wave_sum(a.in[6][lane] * a.in[7][lane]); lam = __uint_as_float(__builtin_amdgcn_readfirstlane(__float_as_uint(expf(s1) - expf(s2) + LAMBDA_INIT))); }
        const float* subw = a.in[8];
        const int conv_grp = (bx >> 3) & 3, conv_before = conv_grp == 0 ? 0 : conv_grp == 1 ? 4 : conv_grp == 2 ? 6 : 7;
        for (int bh = vcu; bh < NB * 8; bh += G) { const int b = bh >> 3, hh = bh & 7;
            for (int qb = 0; qb < 8; ++qb) {
                if (bh == vcu && qb == conv_before) { int gt2 = gtid; asm volatile("" : "+v"(gt2));
                    for (int it = gt2; it < (MTOK / 16) * 128; it += GT) { const int ch = it & 127, rb = it >> 7, g0 = rb * 16, c = ch * 8;
                        const f32x4 w00 = *(const f32x4*)(cw + c), w01 = *(const f32x4*)(cw + c + 4), w10 = *(const f32x4*)(cw + DM + c), w11 = *(const f32x4*)(cw + DM + c + 4), w20 = *(const f32x4*)(cw + 2 * DM + c), w21 = *(const f32x4*)(cw + 2 * DM + c + 4);
                        f32x4 p0, p1, q0, q1;
                        if ((g0 & (SEQ - 1)) == 0) { const float* m14 = PM + 14 * 4096 + 2048 + c; const float* m15 = PM + 15 * 4096 + 2048 + c;
                            p0 = *(const f32x4*)m14 * *(const f32x4*)(m14 + 1024); p1 = *(const f32x4*)(m14 + 4) * *(const f32x4*)(m14 + 1028);
                            q0 = *(const f32x4*)m15 * *(const f32x4*)(m15 + 1024); q1 = *(const f32x4*)(m15 + 4) * *(const f32x4*)(m15 + 1028);
                        } else { unpack8(*(const v4u*)(U + (size_t)(g0 - 2) * DM + c), p0, p1); unpack8(*(const v4u*)(U + (size_t)(g0 - 1) * DM + c), q0, q1); }
#pragma unroll 4
                        for (int j = 0; j < 16; ++j) { const size_t off = (size_t)(g0 + j) * DM + c; f32x4 u0, u1, b0, b1; unpack8(*(const v4u*)(U + off), u0, u1); unpack8(*(const v4u*)(CB + off), b0, b1);
                            *(v4u*)(OBp + off) = pack8(b0 * (w00 * p0 + w10 * q0 + w20 * u0), b1 * (w01 * p1 + w11 * q1 + w21 * u1));
                            p0 = q0; p1 = q1; q0 = u0; q1 = u1; }
                    }
                }
                for (int m = 0; m < 2; ++m) {
                    const attn_body::bf16* Qw = (const attn_body::bf16*)QO + ((size_t)b * SEQ + qb * 256 + wave * 32) * DM + hh * 128 + m * 64;
                    const attn_body::bf16* Kh = (const attn_body::bf16*)KB + (size_t)b * KROWS * DM + hh * 128 + m * 64;
                    const attn_body::bf16* Vh = (const attn_body::bf16*)VB + (size_t)b * KROWS * DM + hh * 128;
                    const attn_body::bf16* Khn = (const attn_body::bf16*)KB + (size_t)b * KROWS * DM + hh * 128 + (1 - m) * 64;
                    attn_body::attn_pass<8>(Qw, Kh, Vh, 4 * qb + 5, m, lam, (char*)lds, Khn, !(qb == 7 && m == 1), !(qb == 0 && m == 0));
                }
                { int ln = lane; asm volatile("" : "+v"(ln)); const LAS unsigned char* Hw = L + attn_body::LDS_H + wave * 8192; const int row = ln >> 1, half = ln & 1; float s = 0.f;
#pragma unroll
                    for (int j = 0; j < 8; ++j) { const int chunk = half * 8 + j; f32x4 v0, v1; unpack8(*(const LAS v4u*)(Hw + row * 256 + ((chunk ^ (row & 15)) << 4)), v0, v1);
                        s += (v0[0] * v0[0] + v0[1] * v0[1]) + (v0[2] * v0[2] + v0[3] * v0[3]) + (v1[0] * v1[0] + v1[1] * v1[1]) + (v1[2] * v1[2] + v1[3] * v1[3]); }
                    s += __uint_as_float((unsigned)__builtin_amdgcn_mov_dpp((int)__float_as_uint(s), 0xB1, 0xF, 0xF, true));
                    const float rn = __builtin_amdgcn_rsqf(s * (1.f / 128.f) + NORM_EPS) * (1.f - LAMBDA_INIT);
                    bf16* Ow = OAp + ((size_t)b * SEQ + qb * 256 + wave * 32 + row) * DM + hh * 128 + half * 64;
#pragma unroll
                    for (int j = 0; j < 8; ++j) { const int chunk = half * 8 + j; f32x4 v0, v1; unpack8(*(const LAS v4u*)(Hw + row * 256 + ((chunk ^ (row & 15)) << 4)), v0, v1);
                        const f32x4 w0 = *(const f32x4*)(subw + chunk * 8), w1 = *(const f32x4*)(subw + chunk * 8 + 4);
                        *(v4u*)(Ow + j * 8) = pack8(v0 * w0 * rn, v1 * w1 * rn); }
                    asm volatile("s_waitcnt lgkmcnt(0)" ::: "memory");
                }
            }
        }
        asm volatile("s_waitcnt vmcnt(0)" ::: "memory"); __syncthreads();
    }
    XSYNC();

    for (int rep_ = 0; rep_ < 1 + ((REPMASK >> 3) & 1); ++rep_) if ((PHMASK >> 3) & 1) {
        pg8::Gemm g{(bf16*)a.out + (size_t)MTOK * DM, CB, Wp_t, DM, 2 * DM, DM / 64}; pg8::StaticOrder S; S.init(MTOK, DM, G, bx);
        pg8::EpiMerge E{SGA, SGB, MG};
        pg8::gemm_phase<pg8::EpiMerge, pg8::StaticOrder, true, true>(L, g, S, E);
    }
    XSYNC();
    for (int rep_ = 0; rep_ < 1 + ((REPMASK >> 4) & 1); ++rep_) if ((PHMASK >> 4) & 1) {
        pg8::Gemm g{MG, MG, Wout_t, DM, DM, DM / 64}; pg8::StaticOrder S; S.init(MTOK, DM, G, bx);
        pg8::EpiResid<true> E{HB, H2B, ss2, rs1};
        pg8::gemm_phase<pg8::EpiResid<true>, pg8::StaticOrder, true, true>(L, g, S, E);
    }
    XSYNC();
    for (int rep_ = 0; rep_ < 1 + ((REPMASK >> 5) & 1); ++rep_) if ((PHMASK >> 5) & 1) {
        pg8::Gemm g{H2B, H2B, Wgu_t, DM, DM, DM / 64}; pg8::StaticOrder S; S.init(MTOK, 2 * DFF, G, bx);
        pg8::EpiGateUp E{ss2, ACT, {}, -1};
        pg8::gemm_phase<pg8::EpiGateUp, pg8::StaticOrder, true, true>(L, g, S, E);
    }
    XSYNC();
    for (int rep_ = 0; rep_ < 1 + ((REPMASK >> 6) & 1); ++rep_) if ((PHMASK >> 6) & 1) {
        pg8::Gemm g{ACT, ACT, Wdn_t, DFF, DFF, DFF / 64}; pg8::StaticOrder S; S.init(MTOK, DM, G, bx);
        pg8::EpiResid<true> E{H2B, H3B, ss3, nullptr};
        pg8::gemm_phase<pg8::EpiResid<true>, pg8::StaticOrder, true, true>(L, g, S, E);
    }
    XSYNC();
    for (int rep_ = 0; rep_ < 1 + ((REPMASK >> 7) & 1); ++rep_) if ((PHMASK >> 7) & 1) {
        PIN_TID();
        const int gw = vcu * 8 + wave, NGW = G * 8; const float* wf = a.in[16];
        f32x4 wv[4];
#pragma unroll
        for (int j = 0; j < 4; ++j) wv[j] = ((const f32x4*)wf)[lane + 64 * j];
        for (int m0 = gw * 4; m0 < MTOK; m0 += NGW * 4) {
            unsigned long long w[4][4]; float r3[4];
#pragma unroll
            for (int r = 0; r < 4; ++r) { const unsigned long long* i8 = (const unsigned long long*)(H3B + (size_t)(m0 + r) * DM) + lane; r3[r] = ss3[m0 + r];
#pragma unroll
                for (int j = 0; j < 4; ++j) w[r][j] = __builtin_nontemporal_load(&i8[64 * j]); }
#pragma unroll
            for (int r = 0; r < 4; ++r) { f32x4* orow = (f32x4*)(a.out + (size_t)(m0 + r) * DM) + lane; const float rr = __builtin_amdgcn_rsqf(r3[r] * (1.f / DM) + NORM_EPS);
#pragma unroll
                for (int j = 0; j < 4; ++j) { const unsigned lo = (unsigned)w[r][j], hi = (unsigned)(w[r][j] >> 32);
                    __builtin_nontemporal_store((f32x4){bf_lo(lo), bf_hi(lo), bf_lo(hi), bf_hi(hi)} * wv[j] * rr, &orow[64 * j]); } }
        }
    }
#undef GSYNC
#undef XSYNC
}
#undef Win_t
#undef Wp_t
#undef Wout_t
#undef Wgu_t
#undef Wdn_t
#undef QO
#undef CB
#undef U
#undef SGA
#undef SGB
#undef KB
#undef VB
#undef MG
#undef H2B
#undef ACT
#undef H3B
#undef ss2
#undef ss3
#undef rs1
#undef PM

extern "C" void kernel_launch(void* const* d_in, const int* in_sizes, int n_in, void* d_out, int out_size, void* d_ws, size_t ws_size, hipStream_t stream) {
    static int grid = 0;
    if (grid == 0) {
        if (n_in != 17 || in_sizes[0] != MTOK * DM || out_size != MTOK * DM || ws_size < WS_END) { fprintf(stderr, "kernel_launch: unexpected shapes / workspace (n_in %d, ws %zu)\n", n_in, ws_size); grid = -1; return; }
        int dev = 0, cus = 0, per_cu = 0;
        if (hipGetDevice(&dev) != hipSuccess || hipDeviceGetAttribute(&cus, hipDeviceAttributeMultiprocessorCount, dev) != hipSuccess) { grid = -1; return; }
        if (hipFuncSetAttribute((const void*)fwd_kernel, hipFuncAttributeMaxDynamicSharedMemorySize, LDS_BYTES) != hipSuccess) { fprintf(stderr, "kernel_launch: hipFuncSetAttribute failed\n"); grid = -1; return; }
        if (hipOccupancyMaxActiveBlocksPerMultiprocessor(&per_cu, (const void*)fwd_kernel, 512, LDS_BYTES) != hipSuccess || per_cu < 1) per_cu = 1;
        (void)hipGetLastError();
        grid = cus * per_cu;
    }
    if (grid < 0) return;
    Args a{};
    for (int i = 0; i < 17; ++i) a.in[i] = (const float*)d_in[i];
    a.out = (float*)d_out; a.ws = (unsigned char*)d_ws;
    void* args[] = {&a};
    hipError_t e = hipLaunchCooperativeKernel((const void*)fwd_kernel, dim3(grid), dim3(512), args, LDS_BYTES, stream);
    if (e != hipSuccess) fprintf(stderr, "kernel_launch: cooperative launch failed: %s (grid %d)\n", hipGetErrorString(e), grid);
}
```
